# Optimizing an MI355X kernel written in HIP

```python
import jax, jax.numpy as jnp
from jax import lax
import numpy as np

D_MODEL = 1024
BATCH = 8
SEQ = 4096
DEPTH = 2

CHUNK = 64
MIX_W = D_MODEL
GLA_HEADS = 4
GLA_DV = MIX_W // 2 // GLA_HEADS
GLA_DK = GLA_DV // 2
GLA_QK_W = GLA_HEADS * GLA_DK
GLA_V_W = GLA_HEADS * GLA_DV
GLA_RANK = 16
GLA_GATE_NORM = 16.0
ATT_HEADS = 8
ATT_DH = (MIX_W - GLA_V_W) // ATT_HEADS
ATT_W = ATT_HEADS * ATT_DH
BAND_CHUNKS = 8
BAND = (BAND_CHUNKS + 1) * CHUNK
REL_CLIP = 128
PEER_HEADS = 8
N_KEYS = 128
N_EXPERTS = N_KEYS * N_KEYS
PEER_DK = 256
PEER_TOPK = 16
PEER_BLOCK = 128
PLE_DIM = 256
RMS_EPS = 1e-6
SPLIT_SIZES = (GLA_QK_W, GLA_QK_W, GLA_V_W, GLA_RANK, GLA_V_W, ATT_W, ATT_W, ATT_W)
SPLIT_POINTS = tuple(int(v) for v in np.cumsum(SPLIT_SIZES)[:-1])
IN_W = sum(SPLIT_SIZES)

kernel_name = 'hybrid_gla_bandattn_peer_ple'


def rms_norm(x, g):
    xf = x.astype(jnp.float32)
    y = xf * lax.rsqrt(jnp.mean(xf * xf, axis=-1, keepdims=True) + RMS_EPS)
    return (y * g.astype(jnp.float32)).astype(x.dtype)


def gla_group(q, k, v, g_lr, g_w2, g_b, head_norm, out_gate):
    b, s, _ = q.shape
    nc = s // CHUNK
    f32 = jnp.float32

    def heads(t, d):
        return t.astype(f32).reshape(b, nc, CHUNK, GLA_HEADS, d).transpose(0, 3, 1, 2, 4)

    q = heads(q, GLA_DK) * (GLA_DK ** -0.5)
    k = heads(k, GLA_DK)
    v = heads(v, GLA_DV)
    g = jax.nn.log_sigmoid((g_lr @ g_w2 + g_b).astype(f32)) / GLA_GATE_NORM
    g = heads(g, GLA_DK)
    cum = jnp.cumsum(g, axis=3)
    last = cum[:, :, :, -1:, :]
    mid = cum[:, :, :, CHUNK // 2:CHUNK // 2 + 1, :]
    a = jnp.einsum('bhnid,bhnjd->bhnij', q * jnp.exp(cum - mid), k * jnp.exp(mid - cum))
    causal = jnp.tril(jnp.ones((CHUNK, CHUNK), dtype=bool))
    o_intra = jnp.einsum('bhnij,bhnje->bhnie', jnp.where(causal, a, 0.0), v)
    k_state = k * jnp.exp(last - cum)
    decay = jnp.exp(last[:, :, :, 0, :])

    def step(state, inp):
        kc, vc, dc = inp
        new = dc[..., None] * state + jnp.einsum('bhcd,bhce->bhde', kc, vc)
        return new, state

    xs = (k_state.transpose(2, 0, 1, 3, 4), v.transpose(2, 0, 1, 3, 4), decay.transpose(2, 0, 1, 3))
    init = jnp.zeros((b, GLA_HEADS, GLA_DK, GLA_DV), f32)
    _, prev = lax.scan(step, init, xs)
    o_inter = jnp.einsum('bhnid,nbhde->bhnie', q * jnp.exp(cum), prev)
    o = o_intra + o_inter
    o = o * lax.rsqrt(jnp.mean(o * o, axis=-1, keepdims=True) + RMS_EPS) * head_norm.astype(f32)
    o = o.transpose(0, 2, 3, 1, 4).reshape(b, s, GLA_V_W)
    return (o * jax.nn.silu(out_gate.astype(f32))).astype(out_gate.dtype)


def band_attention(q, k, v, rel_table):
    b, s, _ = q.shape
    nc = s // CHUNK
    pad = BAND_CHUNKS * CHUNK
    f32 = jnp.float32

    def heads(t):
        return t.reshape(b, s, ATT_HEADS, ATT_DH).transpose(0, 2, 1, 3)

    q, k, v = heads(q), heads(k), heads(v)
    kp = jnp.pad(k, ((0, 0), (0, 0), (pad, 0), (0, 0)))
    vp = jnp.pad(v, ((0, 0), (0, 0), (pad, 0), (0, 0)))
    rel = jnp.arange(CHUNK)[:, None] + pad - jnp.arange(BAND)[None, :]
    bias = rel_table.astype(f32)[:, jnp.clip(rel, -REL_CLIP, REL_CLIP) + REL_CLIP]
    scale = ATT_DH ** -0.5
    key_off = jnp.arange(BAND)

    def one_chunk(c):
        start = c * CHUNK
        qc = lax.dynamic_slice_in_dim(q, start, CHUNK, axis=2)
        kc = lax.dynamic_slice_in_dim(kp, start, BAND, axis=2)
        vc = lax.dynamic_slice_in_dim(vp, start, BAND, axis=2)
        sc = jnp.einsum('bhqd,bhkd->bhqk', qc, kc).astype(f32) * scale + bias
        valid = (start - pad + key_off) >= 0
        sc = jnp.where(valid, sc, -1e30)
        pr = jax.nn.softmax(sc, axis=-1).astype(vc.dtype)
        return jnp.einsum('bhqk,bhkd->bhqd', pr, vc)

    out = lax.map(one_chunk, jnp.arange(nc))
    return out.transpose(1, 0, 3, 2, 4).reshape(b, s, ATT_W)


def peer_ffn(xn, w_q, subkeys, u_tab, v_tab):
    b, s, d = xn.shape
    xt = xn.reshape(b * s // PEER_BLOCK, PEER_BLOCK, d)

    def block(xb):
        qh = (xb @ w_q).reshape(PEER_BLOCK, PEER_HEADS, 2, PEER_DK // 2)
        sc = jnp.einsum('thpd,hpnd->thpn', qh, subkeys).astype(jnp.float32)
        s1, i1 = lax.top_k(sc[:, :, 0], PEER_TOPK)
        s2, i2 = lax.top_k(sc[:, :, 1], PEER_TOPK)
        comb = (s1[..., :, None] + s2[..., None, :]).reshape(PEER_BLOCK, PEER_HEADS, PEER_TOPK * PEER_TOPK)
        top, pos = lax.top_k(comb, PEER_TOPK)
        e = (jnp.take_along_axis(i1, pos // PEER_TOPK, axis=-1) * N_KEYS
             + jnp.take_along_axis(i2, pos % PEER_TOPK, axis=-1))
        gate = jax.nn.softmax(top, axis=-1)
        act = jnp.einsum('thkd,td->thk', u_tab[e], xb).astype(jnp.float32)
        hid = (gate * jax.nn.gelu(act, approximate=False)).astype(xb.dtype)
        return jnp.einsum('thk,thkd->td', hid, v_tab[e])

    return lax.map(block, xt).reshape(b, s, d)


def setup_inputs(seed: int = 0) -> dict:
    key = jax.random.key(seed)
    ks = jax.random.split(key, 20)
    nrm = jax.random.normal
    D = D_MODEL
    return {
        'x': nrm(ks[0], (BATCH, SEQ, D), jnp.float32),
        'p': nrm(ks[1], (DEPTH, BATCH, SEQ, PLE_DIM), jnp.float32),
        'norm_mix': 1.0 + 0.02 * nrm(ks[2], (DEPTH, D), jnp.float32),
        'w_in': nrm(ks[3], (DEPTH, D, IN_W), jnp.float32) * D ** -0.5,
        'gla_gate_w2': nrm(ks[4], (DEPTH, GLA_RANK, GLA_QK_W), jnp.float32) * GLA_RANK ** -0.5,
        'gla_gate_b': 0.1 * nrm(ks[5], (DEPTH, GLA_QK_W), jnp.float32),
        'gla_head_norm': 1.0 + 0.02 * nrm(ks[6], (DEPTH, GLA_DV), jnp.float32),
        'rel_bias': 0.1 * nrm(ks[7], (DEPTH, ATT_HEADS, 2 * REL_CLIP + 1), jnp.float32),
        'w_out': nrm(ks[8], (DEPTH, MIX_W, D), jnp.float32) * MIX_W ** -0.5,
        'norm_ffn': 1.0 + 0.02 * nrm(ks[9], (DEPTH, D), jnp.float32),
        'peer_wq': nrm(ks[10], (DEPTH, D, PEER_HEADS * PEER_DK), jnp.float32) * D ** -0.5,
        'peer_subkeys': nrm(ks[11], (DEPTH, PEER_HEADS, 2, N_KEYS, PEER_DK // 2), jnp.float32) * (PEER_DK // 2) ** -0.5,
        'peer_u': nrm(ks[12], (DEPTH, N_EXPERTS, D), jnp.float32) * D ** -0.5,
        'peer_v': nrm(ks[13], (DEPTH, N_EXPERTS, D), jnp.float32) * PEER_HEADS ** -0.5,
        'norm_ple': 1.0 + 0.02 * nrm(ks[14], (DEPTH, D), jnp.float32),
        'w_ple_gate': nrm(ks[15], (DEPTH, D, D), jnp.float32) * D ** -0.5,
        'w_ple': nrm(ks[16], (DEPTH, PLE_DIM, D), jnp.float32) * PLE_DIM ** -0.5,
        'final_norm': 1.0 + 0.02 * nrm(ks[17], (D,), jnp.float32),
    }


def reference(x, p, norm_mix, w_in, gla_gate_w2, gla_gate_b, gla_head_norm, rel_bias, w_out,
              norm_ffn, peer_wq, peer_subkeys, peer_u, peer_v, norm_ple, w_ple_gate, w_ple, final_norm):
    h = x
    for i in range(DEPTH):
        hn = rms_norm(h, norm_mix[i])
        proj = hn @ w_in[i]
        gq, gk, gv, glr, gog, aq, ak, av = jnp.split(proj, SPLIT_POINTS, axis=-1)
        o_gla = gla_group(gq, gk, gv, glr, gla_gate_w2[i], gla_gate_b[i], gla_head_norm[i], gog)
        o_att = band_attention(aq, ak, av, rel_bias[i])
        h = h + jnp.concatenate([o_gla, o_att], axis=-1) @ w_out[i]
        h = h + peer_ffn(rms_norm(h, norm_ffn[i]), peer_wq[i], peer_subkeys[i], peer_u[i], peer_v[i])
        gate = jax.nn.sigmoid(rms_norm(h, norm_ple[i]) @ w_ple_gate[i])
        h = h + (p[i] @ w_ple[i]) * gate
    return rms_norm(h, final_norm)
```

```cpp
#include <hip/hip_runtime.h>
#include <hip/hip_cooperative_groups.h>
#include <cstdio>
#include <cstdint>
namespace cg = cooperative_groups;
#define MK_N_LAUNCHES 1
namespace pg8 {
#define PG8_LAS __attribute__((address_space(3)))
typedef unsigned short bf16_t;
typedef short bf16x8 __attribute__((ext_vector_type(8)));
typedef float f32x4 __attribute__((ext_vector_type(4)));
typedef unsigned u32x4 __attribute__((ext_vector_type(4)));
constexpr int BM = 256, BK = 64, HALF = 128, HTB = HALF * BK * 2  , STAGE_BYTES = 8 * HTB, NXCD = 8, WGM = 8;

__host__ __device__ __forceinline__ int lds_byte(int r, int c) { const int st = (r >> 4) * 2 + (c >> 5), rr = r & 15, cc = c & 31, ob = rr * 64 + cc * 2; return st * 1024 + (ob ^ (((ob >> 9) & 1) << 5)); }
__host__ __device__ __forceinline__ void stage_rc(int b, int& R, int& C) { const int st = b / 1024, sb = b % 1024, swz = sb ^ (((sb >> 9) & 1) << 5); R = (st >> 1) * 16 + swz / 64; C = (st & 1) * 32 + (swz % 64) / 2; }
__host__ __device__ __forceinline__ int perm32(int rho) { const int n = rho >> 4, i = rho & 15; return 8 * (i >> 2) + 4 * n + (i & 3); }

struct Unit { int pm, pn; };
struct Gemm { const bf16_t* A; const bf16_t* Bt; int M, N, K; };

struct StaticOrder {
    int nM, nN, nwg, G, c;
    __host__ __device__ void init(int M, int N, int G_, int c_) { nM = M / BM; nN = N / BM; nwg = nM * nN; G = G_; c = c_; }
    __host__ __device__ bool next(int i, Unit& u) const {
        const long L = (long)i * G + c; if (L >= nwg) return false;
        int wgid = (int)L; { const int q = nwg / NXCD, r = nwg % NXCD, xcd = wgid % NXCD, off = wgid / NXCD; wgid = (xcd < r ? xcd * (q + 1) : r * (q + 1) + (xcd - r) * q) + off; }
        const int nig = WGM * nN, gid = wgid / nig, fm = gid * WGM, gsz = (nM - fm) < WGM ? (nM - fm) : WGM;
        u.pm = fm + ((wgid % nig) % gsz); u.pn = (wgid % nig) / gsz; return true;
    }
    __device__ __forceinline__ void a_ready(const Unit&) const {}
    __device__ __forceinline__ void done(const Unit&) const {}
};

__device__ __forceinline__ unsigned cvt_pk_bf16(float lo, float hi) { unsigned r; asm volatile("v_cvt_pk_bf16_f32 %0, %1, %2" : "=v"(r) : "v"(lo), "v"(hi)); return r; }
typedef float f32x2 __attribute__((ext_vector_type(2)));
__device__ __forceinline__ f32x2 gelu_pk(f32x2 v) {
    const f32x2 av = __builtin_elementwise_abs(v), d = av * 0.2316418882f + 1.0f;
    f32x2 t; t.x = __builtin_amdgcn_rcpf(d.x); t.y = __builtin_amdgcn_rcpf(d.y);
    f32x2 q = t * 0.5307027145f + (-0.7265760135f); q = q * t + 0.7107068705f; q = q * t + (-0.142248368f); q = q * t + 0.127414796f; q = q * t;
    const f32x2 s = (v * v) * (-0.72134752044f);
    f32x2 e; e.x = __builtin_amdgcn_exp2f(s.x); e.y = __builtin_amdgcn_exp2f(s.y);
    const f32x2 m = v * (q * e), r = v - m;
    f32x2 o; o.x = v.x < 0.f ? m.x : r.x; o.y = v.y < 0.f ? m.y : r.y; return o;
}

template <int ACT  > struct EpiBf16 {
    static constexpr bool PERM = true, AFTER_DRAIN = false; static_assert(ACT == 0 || ACT == 1, "EpiBf16: ACT is 0 (none) or 1 (gelu_pk)");
    bf16_t* O; int ldc; const float* bias; int split_cols; size_t split_stride; float scale0;
    __device__ __forceinline__ void operator()(const f32x4 (&acc)[2][2][4][2], const Unit& u, int wr, int wc, int fr, int fq) const {
        const int row0 = u.pm * BM + wr * 64 + fr; int colt = u.pn * BM; bf16_t* base = O;
        float sc = 1.f; if (split_cols) { const int t = colt / split_cols; base += (size_t)t * split_stride; colt -= t * split_cols; if (t == 0) sc = scale0; }
        const int col0 = colt + wc * 32 + 8 * fq, bcol0 = u.pn * BM + wc * 32 + 8 * fq;
        f32x4 bv[2][2];
#pragma unroll
        for (int bj = 0; bj < 2; ++bj)
#pragma unroll
            for (int n = 0; n < 2; ++n) bv[bj][n] = bias ? *(const f32x4*)(bias + bcol0 + bj * HALF + 4 * n) : (f32x4){0.f, 0.f, 0.f, 0.f};
#pragma unroll
        for (int ai = 0; ai < 2; ++ai)
#pragma unroll
            for (int m = 0; m < 4; ++m) { bf16_t* rowp = base + (size_t)(row0 + ai * HALF + m * 16) * ldc + col0;
#pragma unroll
                for (int bj = 0; bj < 2; ++bj) { f32x4 v0 = acc[ai][bj][m][0] + bv[bj][0], v1 = acc[ai][bj][m][1] + bv[bj][1];
                    if (ACT == 1) { f32x2 a = gelu_pk((f32x2){v0[0], v0[1]}), b = gelu_pk((f32x2){v0[2], v0[3]}), c = gelu_pk((f32x2){v1[0], v1[1]}), d = gelu_pk((f32x2){v1[2], v1[3]});
                        v0 = (f32x4){a.x, a.y, b.x, b.y}; v1 = (f32x4){c.x, c.y, d.x, d.y}; }
                    v0 = v0 * sc; v1 = v1 * sc; u32x4 w; w.x = cvt_pk_bf16(v0[0], v0[1]); w.y = cvt_pk_bf16(v0[2], v0[3]); w.z = cvt_pk_bf16(v1[0], v1[1]); w.w = cvt_pk_bf16(v1[2], v1[3]);
                    *(u32x4*)(rowp + bj * HALF) = w; } }
    }
};

struct EpiF32Store {
    static constexpr bool PERM = false, AFTER_DRAIN = false;
    float* C; int ldc;
    __device__ __forceinline__ void operator()(const f32x4 (&acc)[2][2][4][2], const Unit& u, int wr, int wc, int fr, int fq) const {
        const int row0 = u.pm * BM + wr * 64 + fr, col0 = u.pn * BM + wc * 32 + 4 * fq;
#pragma unroll
        for (int ai = 0; ai < 2; ++ai)
#pragma unroll
            for (int m = 0; m < 4; ++m) { float* rowp = C + (size_t)(row0 + ai * HALF + m * 16) * ldc + col0;
#pragma unroll
                for (int bj = 0; bj < 2; ++bj)
#pragma unroll
                    for (int n = 0; n < 2; ++n) *(f32x4*)(rowp + bj * HALF + n * 16) = acc[ai][bj][m][n]; }
    }
};
struct EpiResid {
    static constexpr bool PERM = false, AFTER_DRAIN = false;
    const float* base; float* out; int ldc;
    __device__ __forceinline__ void operator()(const f32x4 (&acc)[2][2][4][2], const Unit& u, int wr, int wc, int fr, int fq) const {
        const int row0 = u.pm * BM + wr * 64 + fr, col0 = u.pn * BM + wc * 32 + 4 * fq;
#pragma unroll
        for (int ai = 0; ai < 2; ++ai)
#pragma unroll
            for (int m = 0; m < 4; ++m) { const size_t off = (size_t)(row0 + ai * HALF + m * 16) * ldc + col0;
                f32x4 bs[2][2];
#pragma unroll
                for (int bj = 0; bj < 2; ++bj)
#pragma unroll
                    for (int n = 0; n < 2; ++n) bs[bj][n] = *(const f32x4*)(base + off + bj * HALF + n * 16);
#pragma unroll
                for (int bj = 0; bj < 2; ++bj)
#pragma unroll
                    for (int n = 0; n < 2; ++n) *(f32x4*)(out + off + bj * HALF + n * 16) = bs[bj][n] + acc[ai][bj][m][n];
                asm volatile("" ::: "memory"); }
    }
};
struct EpiPle {
    static constexpr bool PERM = false, AFTER_DRAIN = false;
    const float* base; float* out; const bf16_t* pw; int ldc;
    __device__ __forceinline__ void operator()(const f32x4 (&acc)[2][2][4][2], const Unit& u, int wr, int wc, int fr, int fq) const {
        typedef unsigned u32x2v __attribute__((ext_vector_type(2)));
        const int row0 = u.pm * BM + wr * 64 + fr, col0 = u.pn * BM + wc * 32 + 4 * fq;
#pragma unroll
        for (int ai = 0; ai < 2; ++ai)
#pragma unroll
            for (int m = 0; m < 4; ++m) { const size_t off = (size_t)(row0 + ai * HALF + m * 16) * ldc + col0;
                f32x4 bs[2][2]; u32x2v pv[2][2];
#pragma unroll
                for (int bj = 0; bj < 2; ++bj)
#pragma unroll
                    for (int n = 0; n < 2; ++n) { bs[bj][n] = *(const f32x4*)(base + off + bj * HALF + n * 16); pv[bj][n] = *(const u32x2v*)(pw + off + bj * HALF + n * 16); }
#pragma unroll
                for (int bj = 0; bj < 2; ++bj)
#pragma unroll
                    for (int n = 0; n < 2; ++n) { const f32x4 a = acc[ai][bj][m][n]; f32x4 o;
                        const float p0 = __uint_as_float(pv[bj][n].x << 16), p1 = __uint_as_float(pv[bj][n].x & 0xffff0000u), p2 = __uint_as_float(pv[bj][n].y << 16), p3 = __uint_as_float(pv[bj][n].y & 0xffff0000u);
                        o[0] = bs[bj][n][0] + p0 / (1.0f + __expf(-a[0])); o[1] = bs[bj][n][1] + p1 / (1.0f + __expf(-a[1]));
                        o[2] = bs[bj][n][2] + p2 / (1.0f + __expf(-a[2])); o[3] = bs[bj][n][3] + p3 / (1.0f + __expf(-a[3]));
                        *(f32x4*)(out + off + bj * HALF + n * 16) = o; }
                asm volatile("" ::: "memory"); }
    }
};
template <class Epi, class Sched, bool ALIGN_EPI = false, bool SP2 = false>
__device__ __forceinline__ void gemm_phase(PG8_LAS unsigned char* lds, const Gemm g, const Sched& S, const Epi& E, const int tid_in) {
    const int tid = tid_in, wid = __builtin_amdgcn_readfirstlane(tid >> 6), lane = tid & 63, wr = wid >> 2, wc = wid & 3, fr = lane & 15, fq = lane >> 4;
    const int K = g.K, nt = K / BK;
    unsigned voffA[2], voffB[2];
#pragma unroll
    for (int i = 0; i < 2; ++i) { int R, C; stage_rc(tid * 16 + i * 8192, R, C); const int Rb = Epi::PERM ? ((R & ~31) + perm32(R & 31)) : R;
        voffA[i] = (unsigned)(R * K + C) * 2u; voffB[i] = (unsigned)(Rb * K + C) * 2u; }
    const size_t kstep = (size_t)(BK * 2);
    const size_t hstep = (size_t)HALF * K * 2;
    const size_t tstep = 2 * hstep;
    const unsigned ldsw = (unsigned)wid * 1024u;
    const int aoff = lds_byte(wr * 64 + fr, fq * 8), boff = lds_byte(wc * 32 + fr, fq * 8);
#define PG8_SA(b, h) (((b) * 2 + (h)) * HTB)
#define PG8_SB(b, h) ((4 + (b) * 2 + (h)) * HTB)
#define PG8_STAGE(bufoff, gbase, voff) do { _Pragma("unroll") for (int _i = 0; _i < 2; ++_i) \
        __builtin_amdgcn_global_load_lds((const unsigned*)((const char*)(gbase) + (voff)[_i]), (PG8_LAS unsigned*)(lds + (bufoff) + ldsw + _i * 8192), 16, 0, 0); } while (0)
#define PG8_LDA(dst, b, h) do { _Pragma("unroll") for (int m = 0; m < 4; ++m) _Pragma("unroll") for (int k = 0; k < 2; ++k) dst[m][k] = *(const PG8_LAS bf16x8*)(lds + PG8_SA(b, h) + aoff + m * 2048 + k * 1024); } while (0)
#define PG8_LDB(dst, b, h) do { _Pragma("unroll") for (int n = 0; n < 2; ++n) _Pragma("unroll") for (int k = 0; k < 2; ++k) dst[n][k] = *(const PG8_LAS bf16x8*)(lds + PG8_SB(b, h) + boff + n * 2048 + k * 1024); } while (0)
#define PG8_MMA(ai, bj, At, Bt) do { __builtin_amdgcn_s_setprio(1); _Pragma("unroll") for (int m = 0; m < 4; ++m) _Pragma("unroll") for (int n = 0; n < 2; ++n) _Pragma("unroll") for (int k = 0; k < 2; ++k) \
        acc[ai][bj][m][n] = __builtin_amdgcn_mfma_f32_16x16x32_bf16(Bt[n][k], At[m][k], acc[ai][bj][m][n], 0, 0, 0); __builtin_amdgcn_s_setprio(0); } while (0)
#define PG8_WAIT_V(n) asm volatile("s_waitcnt vmcnt(" #n ")" ::: "memory")
#define PG8_WAIT_L(n) asm volatile("s_waitcnt lgkmcnt(" #n ")" ::: "memory")
#define PG8_BAR __builtin_amdgcn_s_barrier()
#define PG8_SCHED __builtin_amdgcn_sched_barrier(0)
    Unit cur, nxt; int ui = 0;
    if (!S.next(0, cur)) return;
    f32x4 acc[2][2][4][2];
#pragma unroll
    for (int a = 0; a < 2; ++a)
#pragma unroll
        for (int b = 0; b < 2; ++b)
#pragma unroll
            for (int m = 0; m < 4; ++m)
#pragma unroll
                for (int n = 0; n < 2; ++n) acc[a][b][m][n] = (f32x4){0.f, 0.f, 0.f, 0.f};
    bf16x8 At[4][2], B0[2][2], B1[2][2];
    const char* cA = (const char*)g.A + (size_t)cur.pm * tstep; const char* cB = (const char*)g.Bt + (size_t)cur.pn * tstep;
    S.a_ready(cur);
    if constexpr (SP2) {
        PG8_STAGE(PG8_SB(0, 0), cB, voffB); PG8_STAGE(PG8_SB(0, 1), cB + hstep, voffB); PG8_STAGE(PG8_SA(0, 0), cA, voffA); PG8_STAGE(PG8_SA(0, 1), cA + hstep, voffA);
        if (wr == 1) PG8_BAR;
        PG8_WAIT_V(2); PG8_BAR;
        PG8_STAGE(PG8_SB(1, 0), cB + kstep, voffB); PG8_STAGE(PG8_SA(1, 0), cA + kstep, voffA); PG8_STAGE(PG8_SB(1, 1), cB + hstep + kstep, voffB);
        PG8_WAIT_V(6); PG8_BAR;
    } else {
        PG8_STAGE(PG8_SB(0, 0), cB, voffB); PG8_STAGE(PG8_SA(0, 0), cA, voffA); PG8_STAGE(PG8_SB(0, 1), cB + hstep, voffB); PG8_STAGE(PG8_SA(0, 1), cA + hstep, voffA);
        if (wr == 1) PG8_BAR;
        PG8_WAIT_V(4); PG8_BAR;
        PG8_STAGE(PG8_SB(1, 0), cB + kstep, voffB); PG8_STAGE(PG8_SA(1, 0), cA + kstep, voffA); PG8_STAGE(PG8_SB(1, 1), cB + hstep + kstep, voffB);
        PG8_WAIT_V(6); PG8_BAR;
    }
    for (;;) {
        const bool has_next = S.next(ui + 1, nxt);
        const char* nA = has_next ? (const char*)g.A + (size_t)nxt.pm * tstep : cA; const char* nB = has_next ? (const char*)g.Bt + (size_t)nxt.pn * tstep : cB;
        for (int t = 0; t < nt; t += 2) {
            const bool last = (t == nt - 2);
            const char* a1 = cA + (size_t)(t + 1) * kstep;
            const char* a2 = last ? nA : cA + (size_t)(t + 2) * kstep; const char* b2 = last ? nB : cB + (size_t)(t + 2) * kstep;
            const char* a3 = a2 + kstep; const char* b3 = b2 + kstep;
            if (last && has_next) S.a_ready(nxt);
            if constexpr (SP2) {
            PG8_LDB(B0, 0, 0); PG8_LDB(B1, 0, 1); PG8_SCHED; PG8_LDA(At, 0, 0); PG8_STAGE(PG8_SA(1, 1), a1 + hstep, voffA);
            PG8_WAIT_V(8); PG8_WAIT_L(0); PG8_BAR; PG8_MMA(0, 0, At, B0); PG8_MMA(0, 1, At, B1); PG8_BAR; PG8_SCHED;
            PG8_LDA(At, 0, 1); PG8_STAGE(PG8_SB(0, 0), b2, voffB); PG8_STAGE(PG8_SB(0, 1), b2 + hstep, voffB); PG8_STAGE(PG8_SA(0, 0), a2, voffA);
            PG8_WAIT_V(8); PG8_WAIT_L(0); PG8_BAR; PG8_MMA(1, 0, At, B0); PG8_MMA(1, 1, At, B1); PG8_BAR; PG8_SCHED;
            PG8_LDB(B0, 1, 0); PG8_LDB(B1, 1, 1); PG8_SCHED; PG8_LDA(At, 1, 0); PG8_STAGE(PG8_SA(0, 1), a2 + hstep, voffA);
            PG8_WAIT_V(8); PG8_WAIT_L(0); PG8_BAR; PG8_MMA(0, 0, At, B0); PG8_MMA(0, 1, At, B1); PG8_BAR; PG8_SCHED;
            PG8_LDA(At, 1, 1); PG8_STAGE(PG8_SB(1, 0), b3, voffB); PG8_STAGE(PG8_SB(1, 1), b3 + hstep, voffB); PG8_STAGE(PG8_SA(1, 0), a3, voffA);
            PG8_WAIT_V(8); PG8_WAIT_L(0); PG8_BAR; PG8_MMA(1, 0, At, B0); PG8_MMA(1, 1, At, B1); PG8_BAR; PG8_SCHED;
            } else {
            PG8_LDB(B0, 0, 0); PG8_SCHED; PG8_LDA(At, 0, 0); PG8_STAGE(PG8_SA(1, 1), a1 + hstep, voffA);
            PG8_WAIT_L(8); PG8_BAR; PG8_WAIT_L(0); PG8_MMA(0, 0, At, B0); PG8_BAR; PG8_SCHED;
            PG8_LDB(B1, 0, 1); PG8_STAGE(PG8_SB(0, 0), b2, voffB);
            PG8_BAR; PG8_WAIT_L(0); PG8_MMA(0, 1, At, B1); PG8_BAR;
            PG8_LDA(At, 0, 1); PG8_STAGE(PG8_SA(0, 0), a2, voffA);
            PG8_BAR; PG8_WAIT_L(0); PG8_MMA(1, 0, At, B0); PG8_BAR; PG8_SCHED;
            PG8_STAGE(PG8_SB(0, 1), b2 + hstep, voffB);
            PG8_WAIT_V(6); PG8_BAR; PG8_MMA(1, 1, At, B1); PG8_BAR;
            PG8_LDB(B0, 1, 0); PG8_SCHED; PG8_LDA(At, 1, 0); PG8_STAGE(PG8_SA(0, 1), a2 + hstep, voffA);
            PG8_WAIT_L(8); PG8_BAR; PG8_WAIT_L(0); PG8_MMA(0, 0, At, B0); PG8_BAR; PG8_SCHED;
            PG8_LDB(B1, 1, 1); PG8_STAGE(PG8_SB(1, 0), b3, voffB);
            PG8_BAR; PG8_WAIT_L(0); PG8_MMA(0, 1, At, B1); PG8_BAR;
            PG8_LDA(At, 1, 1); PG8_STAGE(PG8_SA(1, 0), a3, voffA);
            PG8_BAR; PG8_WAIT_L(0); PG8_MMA(1, 0, At, B0); PG8_BAR; PG8_SCHED;
            PG8_STAGE(PG8_SB(1, 1), b3 + hstep, voffB);
            PG8_WAIT_V(6); PG8_BAR; PG8_MMA(1, 1, At, B1); PG8_BAR;
            }
        }
        if constexpr (ALIGN_EPI) { if (wr == 0) PG8_BAR; }
        if constexpr (!Epi::AFTER_DRAIN) { E(acc, cur, wr, wc, fr, fq); S.done(cur); }
        if (!has_next) break;
#pragma unroll
        for (int a = 0; a < 2; ++a)
#pragma unroll
            for (int b = 0; b < 2; ++b)
#pragma unroll
                for (int m = 0; m < 4; ++m)
#pragma unroll
                    for (int n = 0; n < 2; ++n) acc[a][b][m][n] = (f32x4){0.f, 0.f, 0.f, 0.f};
        cur = nxt; cA = nA; cB = nB; ++ui;
        if constexpr (ALIGN_EPI) { if (wr == 1) PG8_BAR; }
    }
    PG8_WAIT_V(0);
    if constexpr (!ALIGN_EPI) { if (wr == 0) PG8_BAR; }
    PG8_BAR;
    if constexpr (Epi::AFTER_DRAIN) { E.fused(acc, cur, wr, wc, fr, fq, lds, wid, lane); S.done(cur); }
#undef PG8_SA
#undef PG8_SB
#undef PG8_STAGE
#undef PG8_LDA
#undef PG8_LDB
#undef PG8_MMA
#undef PG8_WAIT_V
#undef PG8_WAIT_L
#undef PG8_BAR
#undef PG8_SCHED
}
}

#ifndef MK_N_LAUNCHES
#define MK_N_LAUNCHES 1
#endif
constexpr int NB = 8, SEQ = 4096, DM = 1024, DEPTH = 2, NT = NB * SEQ;
constexpr int PW = 3328;
constexpr int C_GQ = 0, C_GK = 256, C_GV = 512, C_GOG = 1024, C_AQ = 1536, C_AK = 2048, C_AV = 2560, C_GLR = 3072;
constexpr int IN_W = 3088, NEXP = 16384;
constexpr float RMS_EPS = 1e-6f;
constexpr int NWAVES = 8, NTHR = 512;
constexpr int LDS_BYTES = 147456;

constexpr size_t MiB = 1u << 20;
constexpr size_t WS_W = 1 * MiB, W_LAYER = 15 * MiB;
constexpr size_t WO_WIN = 0, WO_WOUT = 6656 * 1024, WO_WQ2 = WO_WOUT + 2 * MiB, WO_WG = WO_WQ2 + 4 * MiB, WO_WP = WO_WG + 2 * MiB;
static_assert(WO_WP + 512 * 1024 <= W_LAYER, "weights per layer");
constexpr size_t WS_A = 32 * MiB;
constexpr size_t WS_XN = 288 * MiB;
constexpr size_t WS_C = 352 * MiB;
constexpr size_t WS_D = 416 * MiB;
constexpr size_t WS_PB = 480 * MiB;
constexpr size_t WS_DEC = 496 * MiB;
constexpr size_t WS_END = 497 * MiB;

#define DI __device__ __forceinline__
typedef unsigned short bf16;
typedef short bf16x8 __attribute__((ext_vector_type(8)));
typedef float f32x4 __attribute__((ext_vector_type(4)));
typedef float f32x16 __attribute__((ext_vector_type(16)));
typedef unsigned u32x4 __attribute__((ext_vector_type(4)));
typedef unsigned u32x2 __attribute__((ext_vector_type(2)));
#define MFMA32(a, b, c) __builtin_amdgcn_mfma_f32_32x32x16_bf16((a), (b), (c), 0, 0, 0)
DI float bf2f(unsigned v) { return __uint_as_float(v << 16); }
DI unsigned f2bf(float f) { unsigned u = __float_as_uint(f); return (u + 0x7fffu + ((u >> 16) & 1u)) >> 16; }
DI unsigned pk2(float lo, float hi) { return f2bf(lo) | (f2bf(hi) << 16); }
DI int crow(int reg, int h) { return (reg & 3) + 8 * (reg >> 2) + 4 * h; }
DI float wave_sum(float v) {
#pragma unroll
    for (int o = 1; o < 64; o <<= 1) v += __shfl_xor(v, o);
    return v;
}
DI bf16x8 pack8(const f32x16& x, int s) {
    u32x4 p; p.x = pk2(x[8 * s + 0], x[8 * s + 1]); p.y = pk2(x[8 * s + 2], x[8 * s + 3]); p.z = pk2(x[8 * s + 4], x[8 * s + 5]); p.w = pk2(x[8 * s + 6], x[8 * s + 7]);
    return __builtin_bit_cast(bf16x8, p);
}

struct Args { const float* in[18]; float* out; unsigned char* ws; int ph_lo, ph_hi; };
struct Frame {
    unsigned char* lds; int tid, lane, wave, G, bid;
    const float *x, *p, *norm_mix, *w_in, *g_w2, *g_b, *head_norm, *rel_bias, *w_out, *norm_ffn, *peer_wq, *peer_sk, *peer_u, *peer_v, *norm_ple, *w_ple_gate, *w_ple, *final_norm;
    float* out; unsigned char* ws;
};

DI void win_map(int n, int& src, float& sc) {
    sc = 1.f;
    if (n < 256) { src = n; sc = 0.125f; }
    else if (n < 1024) src = n;
    else if (n < 1536) src = n + 16;
    else if (n < 2048) { src = n + 16; sc = 0.125f; }
    else if (n < 3072) src = n + 16;
    else if (n < 3088) src = n - 3072 + 1024;
    else src = -1;
}
DI void transpose_item(const float* W, int N, int K, bf16* WT, int n0, int k0, bool winmap, float* tile, int tid) {
    const int nl = tid & 63, kq = tid >> 6;
    int src = n0 + nl; float sc = 1.f;
    if (winmap) win_map(n0 + nl, src, sc);
#pragma unroll
    for (int kk = 0; kk < 8; ++kk) { const int k = kq * 8 + kk; tile[k * 65 + nl] = src >= 0 ? W[(size_t)(k0 + k) * N + src] * sc : 0.f; }
    __syncthreads();
    const int r = tid >> 3, c = tid & 7;
    u32x4 o;
    o.x = pk2(tile[(c * 8 + 0) * 65 + r], tile[(c * 8 + 1) * 65 + r]); o.y = pk2(tile[(c * 8 + 2) * 65 + r], tile[(c * 8 + 3) * 65 + r]);
    o.z = pk2(tile[(c * 8 + 4) * 65 + r], tile[(c * 8 + 5) * 65 + r]); o.w = pk2(tile[(c * 8 + 6) * 65 + r], tile[(c * 8 + 7) * 65 + r]);
    *(u32x4*)(WT + (size_t)(n0 + r) * K + k0 + c * 8) = o;
    __syncthreads();
}
DI void wq2_item(const float* wq, const float* sk, bf16* WT, int hp, int k0, float* lds, int tid) {
    float* s_sk = lds;
    float* s_wq = lds + 128 * 132;
#pragma unroll
    for (int i = 0; i < 8; ++i) { const int idx = tid + i * 512, n = idx >> 5, d4 = idx & 31; *(f32x4*)(s_sk + n * 132 + d4 * 4) = *(const f32x4*)(sk + (size_t)hp * 16384 + n * 128 + d4 * 4); }
#pragma unroll
    for (int i = 0; i < 4; ++i) { const int idx = tid + i * 512, k = idx >> 5, d4 = idx & 31; *(f32x4*)(s_wq + k * 132 + d4 * 4) = *(const f32x4*)(wq + (size_t)(k0 + k) * 2048 + hp * 128 + d4 * 4); }
    __syncthreads();
    const int tn = tid & 31, tk = tid >> 5;
    float acc[4][4];
#pragma unroll
    for (int a = 0; a < 4; ++a)
#pragma unroll
        for (int b = 0; b < 4; ++b) acc[a][b] = 0.f;
    for (int d4 = 0; d4 < 32; ++d4) {
        f32x4 av[4], bv[4];
#pragma unroll
        for (int a = 0; a < 4; ++a) av[a] = *(const f32x4*)(s_sk + (tn * 4 + a) * 132 + d4 * 4);
#pragma unroll
        for (int b = 0; b < 4; ++b) bv[b] = *(const f32x4*)(s_wq + (tk * 4 + b) * 132 + d4 * 4);
#pragma unroll
        for (int a = 0; a < 4; ++a)
#pragma unroll
            for (int b = 0; b < 4; ++b) acc[a][b] += av[a][0] * bv[b][0] + av[a][1] * bv[b][1] + av[a][2] * bv[b][2] + av[a][3] * bv[b][3];
    }
#pragma unroll
    for (int a = 0; a < 4; ++a) { u32x2 o; o.x = pk2(acc[a][0], acc[a][1]); o.y = pk2(acc[a][2], acc[a][3]);
        *(u32x2*)(WT + (size_t)(hp * 128 + tn * 4 + a) * 1024 + k0 + tk * 4) = o; }
    __syncthreads();
}
DI void phase_prep(Frame& F) {
    float* tile = (float*)F.lds;
    constexpr int I_WIN = 832, I_WOUT = 256, I_WG = 256, I_WP = 64, I_WQ2 = 256, I_L = I_WIN + I_WOUT + I_WG + I_WP + I_WQ2;
    for (int it = F.bid; it < DEPTH * I_L; it += F.G) {
        const int l = it / I_L; int r = it % I_L;
        bf16* wl = (bf16*)(F.ws + WS_W + (size_t)l * W_LAYER);
        if (r < I_WIN) { transpose_item(F.w_in + (size_t)l * DM * IN_W, IN_W, DM, wl + WO_WIN / 2, (r >> 4) * 64, (r & 15) * 64, true, tile, F.tid); continue; } r -= I_WIN;
        if (r < I_WOUT) { transpose_item(F.w_out + (size_t)l * DM * DM, DM, DM, wl + WO_WOUT / 2, (r >> 4) * 64, (r & 15) * 64, false, tile, F.tid); continue; } r -= I_WOUT;
        if (r < I_WG) { transpose_item(F.w_ple_gate + (size_t)l * DM * DM, DM, DM, wl + WO_WG / 2, (r >> 4) * 64, (r & 15) * 64, false, tile, F.tid); continue; } r -= I_WG;
        if (r < I_WP) { transpose_item(F.w_ple + (size_t)l * 256 * DM, DM, 256, wl + WO_WP / 2, (r >> 2) * 64, (r & 3) * 64, false, tile, F.tid); continue; } r -= I_WP;
        wq2_item(F.peer_wq + (size_t)l * DM * 2048, F.peer_sk + (size_t)l * 16 * 16384, wl + WO_WQ2 / 2, r >> 4, (r & 15) * 64, tile, F.tid);
    }
}

DI void rms_row_to_bf16(const float* xrow, const float* g, bf16* orow, int lane) {
    const f32x4* xr = (const f32x4*)xrow + lane; const f32x4* gr = (const f32x4*)g + lane;
    f32x4 v[4]; float s = 0.f;
#pragma unroll
    for (int j = 0; j < 4; ++j) { v[j] = xr[64 * j]; s += (v[j].x * v[j].x + v[j].y * v[j].y) + (v[j].z * v[j].z + v[j].w * v[j].w); }
    const float rs = rsqrtf(wave_sum(s) * (1.f / DM) + RMS_EPS);
    u32x2* o8 = (u32x2*)orow + lane;
#pragma unroll
    for (int j = 0; j < 4; ++j) { const f32x4 gg = gr[64 * j]; u32x2 o; o.x = pk2(v[j].x * rs * gg.x, v[j].y * rs * gg.y); o.y = pk2(v[j].z * rs * gg.z, v[j].w * rs * gg.w); o8[64 * j] = o; }
}
DI void phase_norm(Frame& F, const float* src, const float* g, bf16* dst) {
    for (int m = F.bid * NWAVES + F.wave; m < NT; m += F.G * NWAVES) rms_row_to_bf16(src + (size_t)m * DM, g, dst + (size_t)m * DM, F.lane);
}
DI void phase_final_norm(Frame& F, const float* g) {
    for (int m = F.bid * NWAVES + F.wave; m < NT; m += F.G * NWAVES) {
        f32x4* xr = (f32x4*)(F.out + (size_t)m * DM) + F.lane; const f32x4* gr = (const f32x4*)g + F.lane;
        f32x4 v[4]; float s = 0.f;
#pragma unroll
        for (int j = 0; j < 4; ++j) { v[j] = xr[64 * j]; s += (v[j].x * v[j].x + v[j].y * v[j].y) + (v[j].z * v[j].z + v[j].w * v[j].w); }
        const float rs = rsqrtf(wave_sum(s) * (1.f / DM) + RMS_EPS);
#pragma unroll
        for (int j = 0; j < 4; ++j) { const f32x4 gg = gr[64 * j]; xr[64 * j] = v[j] * rs * gg; }
    }
}
DI void convert_bf16(Frame& F, const float* src, bf16* dst, size_t n) {
    const size_t n8 = n >> 3;
    for (size_t i = (size_t)F.bid * NTHR + F.tid; i < n8; i += (size_t)F.G * NTHR) {
        const f32x4 a = ((const f32x4*)src)[2 * i], b = ((const f32x4*)src)[2 * i + 1];
        u32x4 o; o.x = pk2(a.x, a.y); o.y = pk2(a.z, a.w); o.z = pk2(b.x, b.y); o.w = pk2(b.z, b.w);
        ((u32x4*)dst)[i] = o;
    }
}

DI void att_unit(Frame& F, int l, int b, int h, int c, const bf16* proj, bf16* ocat) {
    const int tid = F.tid, lane = F.lane, w = F.wave, r = lane & 31, h2 = lane >> 5, qh = w & 1, kg = w >> 1;
    float* tab = (float*)F.lds;
    float* Ot = (float*)(F.lds + 2048);
    float* ML = (float*)(F.lds + 2048 + 8 * 64 * 33 * 4);
    if (tid < 257) tab[tid] = F.rel_bias[(size_t)l * 8 * 257 + h * 257 + tid];
    __syncthreads();
    const int m0 = b * SEQ + c * 64;
    const bf16* qp = proj + (size_t)(m0 + qh * 32 + r) * PW + C_AQ + h * 64 + h2 * 8;
    bf16x8 qf[4];
#pragma unroll
    for (int s = 0; s < 4; ++s) qf[s] = *(const bf16x8*)(qp + s * 16);
    const int nvc = (c < 8 ? c : 8) + 1, kt0 = 18 - 2 * nvc;
    f32x16 o0, o1;
#pragma unroll
    for (int i = 0; i < 16; ++i) { o0[i] = 0.f; o1[i] = 0.f; }
    float mrun = -1e30f, lrun = 0.f;
    const int iq = qh * 32 + r;
    for (int kt = kt0 + kg; kt < 18; kt += 4) {
        const int krow0 = b * SEQ + (c - 8) * 64 + kt * 32;
        const bf16* kp = proj + (size_t)(krow0 + r) * PW + C_AK + h * 64 + h2 * 8;
        bf16x8 kf[4];
#pragma unroll
        for (int s = 0; s < 4; ++s) kf[s] = *(const bf16x8*)(kp + s * 16);
        const bf16* vp = proj + (size_t)krow0 * PW + C_AV + h * 64 + r;
        bf16x8 vf[2][2];
#pragma unroll
        for (int s = 0; s < 2; ++s)
#pragma unroll
            for (int dt = 0; dt < 2; ++dt)
#pragma unroll
                for (int j = 0; j < 8; ++j) vf[s][dt][j] = (short)vp[(size_t)(16 * s + 8 * (j >> 2) + 4 * h2 + (j & 3)) * PW + dt * 32];
        f32x16 sacc;
#pragma unroll
        for (int i = 0; i < 16; ++i) sacc[i] = 0.f;
#pragma unroll
        for (int s = 0; s < 4; ++s) sacc = MFMA32(kf[s], qf[s], sacc);
        const int jb = kt * 32 + 4 * h2;
        float tmax = -1e30f;
#pragma unroll
        for (int i = 0; i < 16; ++i) { const int j = jb + (i & 3) + 8 * (i >> 2); int rel = iq + 512 - j; rel = rel < -128 ? -128 : (rel > 128 ? 128 : rel);
            sacc[i] += tab[rel + 128]; tmax = fmaxf(tmax, sacc[i]); }
        tmax = fmaxf(tmax, __shfl_xor(tmax, 32));
        const float mnew = fmaxf(mrun, tmax), alpha = __expf(mrun - mnew);
        float psum = 0.f;
#pragma unroll
        for (int i = 0; i < 16; ++i) { const float p = __expf(sacc[i] - mnew); sacc[i] = p; psum += p; }
        lrun = lrun * alpha + psum; mrun = mnew;
#pragma unroll
        for (int i = 0; i < 16; ++i) { o0[i] *= alpha; o1[i] *= alpha; }
#pragma unroll
        for (int s = 0; s < 2; ++s) { const bf16x8 pf = pack8(sacc, s); o0 = MFMA32(vf[s][0], pf, o0); o1 = MFMA32(vf[s][1], pf, o1); }
    }
    lrun += __shfl_xor(lrun, 32);
#pragma unroll
    for (int i = 0; i < 16; ++i) { const int d = crow(i, h2); Ot[(w * 64 + d) * 33 + r] = o0[i]; Ot[(w * 64 + 32 + d) * 33 + r] = o1[i]; }
    if (h2 == 0) { ML[w * 64 + r] = mrun; ML[w * 64 + 32 + r] = lrun; }
    __syncthreads();
    {
        const int q = tid >> 3, dg = tid & 7, qq = q & 31, qhh = q >> 5;
        float mg[4], lg[4], ms = -1e30f;
#pragma unroll
        for (int g = 0; g < 4; ++g) { const int ww = g * 2 + qhh; mg[g] = ML[ww * 64 + qq]; lg[g] = ML[ww * 64 + 32 + qq]; ms = fmaxf(ms, mg[g]); }
        float L = 0.f, wg[4];
#pragma unroll
        for (int g = 0; g < 4; ++g) { wg[g] = __expf(mg[g] - ms); L += wg[g] * lg[g]; }
        const float inv = 1.f / L;
        float ov[8];
#pragma unroll
        for (int dd = 0; dd < 8; ++dd) { float a = 0.f;
#pragma unroll
            for (int g = 0; g < 4; ++g) a += wg[g] * Ot[((g * 2 + qhh) * 64 + dg * 8 + dd) * 33 + qq];
            ov[dd] = a * inv; }
        u32x4 o; o.x = pk2(ov[0], ov[1]); o.y = pk2(ov[2], ov[3]); o.z = pk2(ov[4], ov[5]); o.w = pk2(ov[6], ov[7]);
        *(u32x4*)(ocat + (size_t)(m0 + q) * DM + 512 + h * 64 + dg * 8) = o;
    }
    __syncthreads();
}

constexpr int GL_GLR = 0, GL_W2 = 4096, GL_B2 = 8192, GL_CUM = 8448, GL_TOT = GL_CUM + 16384, GL_VT = GL_TOT + 2048, GL_KS = GL_VT + 128 * 72 * 2, GL_QE = GL_KS + 64 * 72 * 2, GL_KE = GL_QE + 64 * 72 * 2,
              GL_QG = GL_KE + 64 * 72 * 2, GL_OS = GL_QG + 64 * 72 * 2, GL_SSQ = GL_OS + 64 * 132 * 4, GL_END = GL_SSQ + 1024;
static_assert(GL_END <= LDS_BYTES && GL_VT % 16 == 0 && GL_KS % 16 == 0 && GL_QE % 16 == 0 && GL_OS % 16 == 0, "GLA LDS map");
DI float log_sigmoid(float x) { return fminf(x, 0.f) - log1pf(__expf(-fabsf(x))); }
DI void gla_cum(Frame& F, int l, int h, int m0, const bf16* proj) {
    const int tid = F.tid;
    float* Gl = (float*)(F.lds + GL_GLR); float* W2 = (float*)(F.lds + GL_W2); float* B2 = (float*)(F.lds + GL_B2); float* CUM = (float*)(F.lds + GL_CUM); float* TOT = (float*)(F.lds + GL_TOT);
    if (tid < 128) { const int t = tid >> 1, hf = tid & 1; const u32x4 v = *(const u32x4*)(proj + (size_t)(m0 + t) * PW + C_GLR + hf * 8);
        float* g = Gl + t * 16 + hf * 8; g[0] = bf2f(v.x & 0xffffu); g[1] = bf2f(v.x >> 16); g[2] = bf2f(v.y & 0xffffu); g[3] = bf2f(v.y >> 16); g[4] = bf2f(v.z & 0xffffu); g[5] = bf2f(v.z >> 16); g[6] = bf2f(v.w & 0xffffu); g[7] = bf2f(v.w >> 16); }
#pragma unroll
    for (int i = 0; i < 2; ++i) { const int idx = tid + i * 512, rr = idx >> 6, d = idx & 63; W2[idx] = F.g_w2[(size_t)l * 16 * 256 + rr * 256 + h * 64 + d]; }
    if (tid < 64) B2[tid] = F.g_b[(size_t)l * 256 + h * 64 + tid];
    __syncthreads();
    const int d = tid & 63, tq = tid >> 6;
    float w2r[16];
#pragma unroll
    for (int rr = 0; rr < 16; ++rr) w2r[rr] = W2[rr * 64 + d];
    const float bb = B2[d];
    float run = 0.f;
#pragma unroll
    for (int tt = 0; tt < 8; ++tt) { const int t = tq * 8 + tt; float x = bb;
#pragma unroll
        for (int rr = 0; rr < 16; ++rr) x += Gl[t * 16 + rr] * w2r[rr];
        run += log_sigmoid(x) * (1.f / 16.f); CUM[t * 64 + d] = run; }
    TOT[tq * 64 + d] = run;
    __syncthreads();
    float off = 0.f;
    for (int q = 0; q < tq; ++q) off += TOT[q * 64 + d];
#pragma unroll
    for (int tt = 0; tt < 8; ++tt) CUM[(tq * 8 + tt) * 64 + d] += off;
    __syncthreads();
}
DI void gla_stage_vt(Frame& F, int h, int m0, const bf16* proj) {
    const int tid = F.tid, e = tid & 127, cq = tid >> 7;
    bf16* Vt = (bf16*)(F.lds + GL_VT);
    unsigned short v[16];
#pragma unroll
    for (int i = 0; i < 16; ++i) v[i] = proj[(size_t)(m0 + cq * 16 + i) * PW + C_GV + h * 128 + e];
    u32x4 a, b2;
    a.x = v[0] | ((unsigned)v[1] << 16); a.y = v[2] | ((unsigned)v[3] << 16); a.z = v[4] | ((unsigned)v[5] << 16); a.w = v[6] | ((unsigned)v[7] << 16);
    b2.x = v[8] | ((unsigned)v[9] << 16); b2.y = v[10] | ((unsigned)v[11] << 16); b2.z = v[12] | ((unsigned)v[13] << 16); b2.w = v[14] | ((unsigned)v[15] << 16);
    *(u32x4*)(Vt + e * 72 + cq * 16) = a; *(u32x4*)(Vt + e * 72 + cq * 16 + 8) = b2;
}
DI void gla_kv_unit(Frame& F, int l, int b, int h, int c, const bf16* proj, float* KVt, float* dec) {
    const int tid = F.tid, lane = F.lane, w = F.wave, r = lane & 31, h2 = lane >> 5;
    const int m0 = b * SEQ + c * 64, unit = (b * 4 + h) * 64 + c;
    float* CUM = (float*)(F.lds + GL_CUM); bf16* Vt = (bf16*)(F.lds + GL_VT); bf16* Ks = (bf16*)(F.lds + GL_KS);
    gla_cum(F, l, h, m0, proj);
    {
        const int d = tid & 63, tq = tid >> 6; const float last = CUM[63 * 64 + d];
        float kv[8];
#pragma unroll
        for (int tt = 0; tt < 8; ++tt) { const int t = tq * 8 + tt; kv[tt] = bf2f(proj[(size_t)(m0 + t) * PW + C_GK + h * 64 + d]) * __expf(last - CUM[t * 64 + d]); }
        u32x4 o; o.x = pk2(kv[0], kv[1]); o.y = pk2(kv[2], kv[3]); o.z = pk2(kv[4], kv[5]); o.w = pk2(kv[6], kv[7]);
        *(u32x4*)(Ks + d * 72 + tq * 8) = o;
        if (tid < 64) dec[(size_t)unit * 64 + tid] = __expf(last);
    }
    gla_stage_vt(F, h, m0, proj);
    __syncthreads();
    {
        const int et = w >> 1, dt = w & 1;
        f32x16 acc;
#pragma unroll
        for (int i = 0; i < 16; ++i) acc[i] = 0.f;
#pragma unroll
        for (int s = 0; s < 4; ++s) { const bf16x8 a = *(const bf16x8*)(Vt + (et * 32 + r) * 72 + 16 * s + 8 * h2); const bf16x8 bb = *(const bf16x8*)(Ks + (dt * 32 + r) * 72 + 16 * s + 8 * h2); acc = MFMA32(a, bb, acc); }
        float* o = KVt + (size_t)unit * 8192;
#pragma unroll
        for (int i = 0; i < 16; ++i) o[(et * 32 + crow(i, h2)) * 64 + dt * 32 + r] = acc[i];
    }
    __syncthreads();
}
DI void phase_scan(Frame& F, float* KVt, const float* dec) {
    for (int idx = F.bid * NTHR + F.tid; idx < 32 * 8192; idx += F.G * NTHR) {
        const int bh = idx >> 13, ed = idx & 8191, d = ed & 63;
        float* p = KVt + (size_t)bh * 64 * 8192 + ed; const float* dc = dec + (size_t)bh * 64 * 64 + d;
        float S = 0.f;
#pragma unroll 8
        for (int n = 0; n < 64; ++n) { const float kv = p[(size_t)n * 8192], dcy = dc[n * 64]; p[(size_t)n * 8192] = S; S = dcy * S + kv; }
    }
}
DI void gla_out_unit(Frame& F, int l, int b, int h, int c, const bf16* proj, const float* prevT, bf16* ocat) {
    const int tid = F.tid, lane = F.lane, w = F.wave, r = lane & 31, h2 = lane >> 5;
    const int m0 = b * SEQ + c * 64, unit = (b * 4 + h) * 64 + c;
    float* CUM = (float*)(F.lds + GL_CUM); bf16* Vt = (bf16*)(F.lds + GL_VT); bf16* Qe = (bf16*)(F.lds + GL_QE); bf16* Ke = (bf16*)(F.lds + GL_KE); bf16* Qg = (bf16*)(F.lds + GL_QG);
    float* Os = (float*)(F.lds + GL_OS);
    gla_cum(F, l, h, m0, proj);
    {
        const int d = tid & 63, tq = tid >> 6; const float mid = CUM[32 * 64 + d];
#pragma unroll
        for (int tt = 0; tt < 8; ++tt) { const int t = tq * 8 + tt; const float cm = CUM[t * 64 + d];
            const float q = bf2f(proj[(size_t)(m0 + t) * PW + C_GQ + h * 64 + d]), k = bf2f(proj[(size_t)(m0 + t) * PW + C_GK + h * 64 + d]);
            Qe[t * 72 + d] = (bf16)f2bf(q * __expf(cm - mid)); Ke[t * 72 + d] = (bf16)f2bf(k * __expf(mid - cm)); Qg[t * 72 + d] = (bf16)f2bf(q * __expf(cm)); }
    }
    gla_stage_vt(F, h, m0, proj);
    __syncthreads();
    {
        const int et = w >> 1, it = w & 1;
        f32x16 o;
#pragma unroll
        for (int i = 0; i < 16; ++i) o[i] = 0.f;
        const float* pp = prevT + (size_t)unit * 8192 + (et * 32 + r) * 64 + 8 * h2;
#pragma unroll
        for (int s = 0; s < 4; ++s) { const f32x4 p0 = *(const f32x4*)(pp + 16 * s), p1 = *(const f32x4*)(pp + 16 * s + 4);
            u32x4 pa; pa.x = pk2(p0.x, p0.y); pa.y = pk2(p0.z, p0.w); pa.z = pk2(p1.x, p1.y); pa.w = pk2(p1.z, p1.w);
            const bf16x8 bq = *(const bf16x8*)(Qg + (it * 32 + r) * 72 + 16 * s + 8 * h2);
            o = MFMA32(__builtin_bit_cast(bf16x8, pa), bq, o); }
        for (int jt = 0; jt <= it; ++jt) {
            f32x16 X;
#pragma unroll
            for (int i = 0; i < 16; ++i) X[i] = 0.f;
#pragma unroll
            for (int s = 0; s < 4; ++s) { const bf16x8 a = *(const bf16x8*)(Ke + (jt * 32 + r) * 72 + 16 * s + 8 * h2); const bf16x8 bb = *(const bf16x8*)(Qe + (it * 32 + r) * 72 + 16 * s + 8 * h2); X = MFMA32(a, bb, X); }
            if (jt == it) {
#pragma unroll
                for (int i = 0; i < 16; ++i) if (crow(i, h2) > r) X[i] = 0.f;
            }
#pragma unroll
            for (int s = 0; s < 2; ++s) { const bf16x8 pf = pack8(X, s);
                const u32x2 lo = *(const u32x2*)(Vt + (et * 32 + r) * 72 + jt * 32 + 16 * s + 4 * h2), hi = *(const u32x2*)(Vt + (et * 32 + r) * 72 + jt * 32 + 16 * s + 8 + 4 * h2);
                u32x4 va; va.x = lo.x; va.y = lo.y; va.z = hi.x; va.w = hi.y;
                o = MFMA32(__builtin_bit_cast(bf16x8, va), pf, o); }
        }
#pragma unroll
        for (int i = 0; i < 16; ++i) Os[(it * 32 + r) * 132 + et * 32 + crow(i, h2)] = o[i];
    }
    __syncthreads();
    {
        const int i = tid >> 3, ec = tid & 7, e0 = ec * 16;
        float v[16]; float ss = 0.f;
#pragma unroll
        for (int k = 0; k < 4; ++k) { const f32x4 t = *(const f32x4*)(Os + i * 132 + e0 + 4 * k); v[4 * k] = t.x; v[4 * k + 1] = t.y; v[4 * k + 2] = t.z; v[4 * k + 3] = t.w; ss += (t.x * t.x + t.y * t.y) + (t.z * t.z + t.w * t.w); }
        ss += __shfl_xor(ss, 1); ss += __shfl_xor(ss, 2); ss += __shfl_xor(ss, 4);
        const float rs = rsqrtf(ss * (1.f / 128.f) + RMS_EPS);
        const u32x4 g0 = *(const u32x4*)(proj + (size_t)(m0 + i) * PW + C_GOG + h * 128 + e0), g1 = *(const u32x4*)(proj + (size_t)(m0 + i) * PW + C_GOG + h * 128 + e0 + 8);
        const unsigned gw[8] = {g0.x, g0.y, g0.z, g0.w, g1.x, g1.y, g1.z, g1.w};
        const float* hn = F.head_norm + (size_t)l * 128 + e0;
        unsigned ow[8];
#pragma unroll
        for (int k = 0; k < 8; ++k) { const float ga = bf2f(gw[k] & 0xffffu), gb = bf2f(gw[k] >> 16);
            const float a = v[2 * k] * rs * hn[2 * k] * (ga / (1.f + __expf(-ga))), bq = v[2 * k + 1] * rs * hn[2 * k + 1] * (gb / (1.f + __expf(-gb)));
            ow[k] = pk2(a, bq); }
        u32x4 o0, o1; o0.x = ow[0]; o0.y = ow[1]; o0.z = ow[2]; o0.w = ow[3]; o1.x = ow[4]; o1.y = ow[5]; o1.z = ow[6]; o1.w = ow[7];
        *(u32x4*)(ocat + (size_t)(m0 + i) * DM + h * 128 + e0) = o0; *(u32x4*)(ocat + (size_t)(m0 + i) * DM + h * 128 + e0 + 8) = o1;
    }
    __syncthreads();
}

DI unsigned ord_f32(float v) { const unsigned b = __float_as_uint(v); return (b & 0x80000000u) ? ~b : (b | 0x80000000u); }
DI void topk_tile(Frame& F, int tile, const float* sc, int* eout, float* gout) {
    const int tid = F.tid;
    float* S = (float*)F.lds;
    const float* src = sc + (size_t)tile * 32768;
#pragma unroll 4
    for (int i = 0; i < 16; ++i) { const int idx = tid + i * 512, R = idx >> 5, c4 = idx & 31; const f32x4 v = *(const f32x4*)(src + (size_t)idx * 4);
        float* d = S + R * 129 + c4 * 4; d[0] = v.x; d[1] = v.y; d[2] = v.z; d[3] = v.w; }
    __syncthreads();
    float tv[16]; int ti[16];
    if (tid < 256) {
        unsigned tk[16];
#pragma unroll
        for (int k = 0; k < 16; ++k) tk[k] = 0u;
        const float* row = S + tid * 129;
#pragma unroll 4
        for (int n = 0; n < 128; ++n) { unsigned key = (ord_f32(row[n]) & ~127u) | (unsigned)(127 - n);
#pragma unroll
            for (int k = 0; k < 16; ++k) { const unsigned hi = tk[k] > key ? tk[k] : key; key = tk[k] > key ? key : tk[k]; tk[k] = hi; } }
#pragma unroll
        for (int k = 0; k < 16; ++k) { ti[k] = 127 - (int)(tk[k] & 127u); tv[k] = row[ti[k]]; }
    }
    __syncthreads();
    float* LV = (float*)F.lds; int* LI = (int*)(F.lds + 16384);
    if (tid < 256) {
#pragma unroll
        for (int k = 0; k < 16; ++k) { LV[tid * 16 + k] = tv[k]; LI[tid * 16 + k] = ti[k]; }
    }
    __syncthreads();
    if (tid < 128) {
        const int R1 = 2 * tid, R2 = 2 * tid + 1;
        float s1[16], s2[16];
#pragma unroll
        for (int k = 0; k < 16; ++k) { s1[k] = LV[R1 * 16 + k]; s2[k] = LV[R2 * 16 + k]; }
        unsigned tk[16];
#pragma unroll
        for (int k = 0; k < 16; ++k) tk[k] = 0u;
#pragma unroll
        for (int i = 0; i < 16; ++i)
#pragma unroll
            for (int j = 0; j < 16; ++j)
                if ((i + 1) * (j + 1) <= 16) { unsigned key = (ord_f32(s1[i] + s2[j]) & ~255u) | (unsigned)(255 - (i * 16 + j));
#pragma unroll
                    for (int k = 0; k < 16; ++k) { const unsigned hi = tk[k] > key ? tk[k] : key; key = tk[k] > key ? key : tk[k]; tk[k] = hi; } }
        float top[16]; int ee[16]; float mx = -1e30f;
#pragma unroll
        for (int k = 0; k < 16; ++k) { const int cid = 255 - (int)(tk[k] & 255u), i = cid >> 4, j = cid & 15;
            top[k] = LV[R1 * 16 + i] + LV[R2 * 16 + j]; ee[k] = LI[R1 * 16 + i] * 128 + LI[R2 * 16 + j]; mx = fmaxf(mx, top[k]); }
        float sum = 0.f;
#pragma unroll
        for (int k = 0; k < 16; ++k) { top[k] = __expf(top[k] - mx); sum += top[k]; }
        const float inv = 1.f / sum;
        const int t = tile * 16 + (tid >> 3), hh = tid & 7;
        int* eo = eout + (size_t)t * 128 + hh * 16; float* go = gout + (size_t)t * 128 + hh * 16;
#pragma unroll
        for (int k = 0; k < 16; ++k) { eo[k] = ee[k]; go[k] = top[k] * inv; }
    }
    __syncthreads();
}

DI void peer_token(Frame& F, int t, const bf16* xn, const int* E, const float* Gt, const bf16* U, const bf16* V) {
    const int lane = F.lane;
    float xf[16];
    {
        const u32x4 a = *(const u32x4*)(xn + (size_t)t * DM + lane * 8), b = *(const u32x4*)(xn + (size_t)t * DM + 512 + lane * 8);
        const unsigned wv[8] = {a.x, a.y, a.z, a.w, b.x, b.y, b.z, b.w};
#pragma unroll
        for (int k = 0; k < 8; ++k) { xf[2 * k] = bf2f(wv[k] & 0xffffu); xf[2 * k + 1] = __uint_as_float(wv[k] & 0xffff0000u); }
    }
    const int ea = E[(size_t)t * 128 + lane], eb = E[(size_t)t * 128 + 64 + lane];
    const float ga = Gt[(size_t)t * 128 + lane], gb = Gt[(size_t)t * 128 + 64 + lane];
    float acta = 0.f, actb = 0.f;
    for (int g = 0; g < 16; ++g) {
        const int esel = g < 8 ? ea : eb;
        u32x4 u0[8], u1[8];
#pragma unroll
        for (int i = 0; i < 8; ++i) { const int ek = __shfl(esel, (g * 8 + i) & 63); const bf16* up = U + (size_t)ek * DM + lane * 8; u0[i] = *(const u32x4*)up; u1[i] = *(const u32x4*)(up + 512); }
#pragma unroll
        for (int i = 0; i < 8; ++i) {
            const unsigned wv[8] = {u0[i].x, u0[i].y, u0[i].z, u0[i].w, u1[i].x, u1[i].y, u1[i].z, u1[i].w};
            float s = 0.f;
#pragma unroll
            for (int k = 0; k < 8; ++k) { s += bf2f(wv[k] & 0xffffu) * xf[2 * k]; s += __uint_as_float(wv[k] & 0xffff0000u) * xf[2 * k + 1]; }
            s = wave_sum(s);
            if (lane == ((g * 8 + i) & 63)) { if (g < 8) acta = s; else actb = s; }
        }
    }
    const float hida = ga * (0.5f * acta * (1.f + erff(acta * 0.70710678118654752f))), hidb = gb * (0.5f * actb * (1.f + erff(actb * 0.70710678118654752f)));
    float o[16];
#pragma unroll
    for (int k = 0; k < 16; ++k) o[k] = 0.f;
    for (int g = 0; g < 16; ++g) {
        const int esel = g < 8 ? ea : eb; const float hsel = g < 8 ? hida : hidb;
        u32x4 v0[8], v1[8]; float hk[8];
#pragma unroll
        for (int i = 0; i < 8; ++i) { const int ek = __shfl(esel, (g * 8 + i) & 63); hk[i] = __shfl(hsel, (g * 8 + i) & 63); const bf16* vp = V + (size_t)ek * DM + lane * 8; v0[i] = *(const u32x4*)vp; v1[i] = *(const u32x4*)(vp + 512); }
#pragma unroll
        for (int i = 0; i < 8; ++i) {
            const unsigned wv[8] = {v0[i].x, v0[i].y, v0[i].z, v0[i].w, v1[i].x, v1[i].y, v1[i].z, v1[i].w};
#pragma unroll
            for (int k = 0; k < 8; ++k) { o[2 * k] += hk[i] * bf2f(wv[k] & 0xffffu); o[2 * k + 1] += hk[i] * __uint_as_float(wv[k] & 0xffff0000u); }
        }
    }
    float* hp = F.out + (size_t)t * DM + lane * 8;
    f32x4 h0 = *(f32x4*)hp, h1 = *(f32x4*)(hp + 4), h2 = *(f32x4*)(hp + 512), h3 = *(f32x4*)(hp + 516);
    h0.x += o[0]; h0.y += o[1]; h0.z += o[2]; h0.w += o[3]; h1.x += o[4]; h1.y += o[5]; h1.z += o[6]; h1.w += o[7];
    h2.x += o[8]; h2.y += o[9]; h2.z += o[10]; h2.w += o[11]; h3.x += o[12]; h3.y += o[13]; h3.z += o[14]; h3.w += o[15];
    *(f32x4*)hp = h0; *(f32x4*)(hp + 4) = h1; *(f32x4*)(hp + 512) = h2; *(f32x4*)(hp + 516) = h3;
}

#ifndef PHMASK
#define PHMASK 0xFFFF
#endif
#define EN(n) if constexpr (((PHMASK) >> (n)) & 1)
constexpr int PH_PER_LAYER = 12, NPH = 2 + DEPTH * PH_PER_LAYER;

__global__ void __launch_bounds__(NTHR, 2) hybrid_fwd(Args args) {
    extern __shared__ __attribute__((aligned(16))) unsigned char lds[];
    unsigned char* ws = args.ws;
    bf16* proj = (bf16*)(ws + WS_A); float* sc = (float*)(ws + WS_A);
    bf16* xn = (bf16*)(ws + WS_XN);
    bf16* ocat = (bf16*)(ws + WS_C); int* eids = (int*)(ws + WS_C); float* gates = (float*)(ws + WS_C + 16 * MiB); bf16* pw = (bf16*)(ws + WS_C);
    float* kvt = (float*)(ws + WS_D); bf16* ub = (bf16*)(ws + WS_D); bf16* vb = (bf16*)(ws + WS_D + 32 * MiB);
    bf16* pb = (bf16*)(ws + WS_PB); float* dec = (float*)(ws + WS_DEC);
    cg::grid_group grid = cg::this_grid();
    PG8_LAS unsigned char* gl = (PG8_LAS unsigned char*)lds;

    for (int ph = args.ph_lo; ph < args.ph_hi; ++ph) {
        int tid_ = threadIdx.x; asm volatile("" : "+v"(tid_));
    Frame F;
        F.lds = lds; F.tid = tid_; F.lane = F.tid & 63; F.wave = __builtin_amdgcn_readfirstlane(F.tid >> 6); F.G = gridDim.x; F.bid = blockIdx.x;
        F.x = args.in[0]; F.p = args.in[1]; F.norm_mix = args.in[2]; F.w_in = args.in[3]; F.g_w2 = args.in[4]; F.g_b = args.in[5]; F.head_norm = args.in[6]; F.rel_bias = args.in[7]; F.w_out = args.in[8];
        F.norm_ffn = args.in[9]; F.peer_wq = args.in[10]; F.peer_sk = args.in[11]; F.peer_u = args.in[12]; F.peer_v = args.in[13]; F.norm_ple = args.in[14]; F.w_ple_gate = args.in[15]; F.w_ple = args.in[16]; F.final_norm = args.in[17];
        F.out = args.out; F.ws = args.ws;
        if (ph == 0) { EN(12) phase_prep(F); }
        else if (ph == NPH - 1) { EN(13) phase_final_norm(F, F.final_norm); }
        else {
            const int l = (ph - 1) / PH_PER_LAYER, sp = (ph - 1) % PH_PER_LAYER;
            const pg8::bf16_t* wl = (const pg8::bf16_t*)(ws + WS_W + (size_t)l * W_LAYER);
            const float* hsrc = (l == 0) ? F.x : F.out;
            switch (sp) {
            case 0: EN(0) {
                phase_norm(F, hsrc, F.norm_mix + (size_t)l * DM, xn);
                convert_bf16(F, F.p + (size_t)l * NT * 256, pb, (size_t)NT * 256);
            } break;
            case 1: EN(1) {
                pg8::Gemm g{(const pg8::bf16_t*)xn, wl + WO_WIN / 2, NT, PW, DM}; pg8::StaticOrder S; S.init(NT, PW, F.G, F.bid);
                pg8::EpiBf16<0> E{(pg8::bf16_t*)proj, PW, nullptr, 0, 0, 1.f};
                pg8::gemm_phase<pg8::EpiBf16<0>, pg8::StaticOrder, true, true>(gl, g, S, E, F.tid);
            } break;
            case 2: EN(2) {
                for (int u = F.bid; u < NB * 8 * 64; u += F.G) { const int c = ((u & 63) + (u >> 6)) & 63, h = (u >> 6) & 7, b = u >> 9; att_unit(F, l, b, h, c, proj, ocat); }
                for (int u = F.bid; u < NB * 4 * 64; u += F.G) { const int c = u & 63, h = (u >> 6) & 3, b = u >> 8; gla_kv_unit(F, l, b, h, c, proj, kvt, dec); }
            } break;
            case 3: EN(3) { phase_scan(F, kvt, dec); } break;
            case 4: EN(4) {
                for (int u = F.bid; u < NB * 4 * 64; u += F.G) { const int c = u & 63, h = (u >> 6) & 3, b = u >> 8; gla_out_unit(F, l, b, h, c, proj, kvt, ocat); }
            } break;
            case 5: EN(5) {
                pg8::Gemm g{(const pg8::bf16_t*)ocat, wl + WO_WOUT / 2, NT, DM, DM}; pg8::StaticOrder S; S.init(NT, DM, F.G, F.bid);
                pg8::EpiResid E{hsrc, F.out, DM};
                pg8::gemm_phase<pg8::EpiResid, pg8::StaticOrder, true, true>(gl, g, S, E, F.tid);
            } break;
            case 6: EN(6) {
                phase_norm(F, F.out, F.norm_ffn + (size_t)l * DM, xn);
                convert_bf16(F, F.peer_u + (size_t)l * NEXP * DM, ub, (size_t)NEXP * DM);
                convert_bf16(F, F.peer_v + (size_t)l * NEXP * DM, vb, (size_t)NEXP * DM);
            } break;
            case 7: EN(7) {
                pg8::Gemm g{(const pg8::bf16_t*)xn, wl + WO_WQ2 / 2, NT, 2048, DM}; pg8::StaticOrder S; S.init(NT, 2048, F.G, F.bid);
                pg8::EpiF32Store E{sc, 2048};
                pg8::gemm_phase<pg8::EpiF32Store, pg8::StaticOrder, true, true>(gl, g, S, E, F.tid);
            } break;
            case 8: EN(8) { for (int tl = F.bid; tl < NT / 16; tl += F.G) topk_tile(F, tl, sc, eids, gates); } break;
            case 9: EN(9) { for (int t = F.bid * NWAVES + F.wave; t < NT; t += F.G * NWAVES) peer_token(F, t, xn, eids, gates, ub, vb); } break;
            case 10: EN(10) {
                phase_norm(F, F.out, F.norm_ple + (size_t)l * DM, xn);
                pg8::Gemm g{(const pg8::bf16_t*)pb, wl + WO_WP / 2, NT, DM, 256}; pg8::StaticOrder S; S.init(NT, DM, F.G, F.bid);
                pg8::EpiBf16<0> E{(pg8::bf16_t*)pw, DM, nullptr, 0, 0, 1.f};
                pg8::gemm_phase<pg8::EpiBf16<0>, pg8::StaticOrder, true, true>(gl, g, S, E, F.tid);
            } break;
            case 11: EN(11) {
                pg8::Gemm g{(const pg8::bf16_t*)xn, wl + WO_WG / 2, NT, DM, DM}; pg8::StaticOrder S; S.init(NT, DM, F.G, F.bid);
                pg8::EpiPle E{F.out, F.out, (const pg8::bf16_t*)pw, DM};
                pg8::gemm_phase<pg8::EpiPle, pg8::StaticOrder, true, true>(gl, g, S, E, F.tid);
            } break;
            }
        }
        if (ph + 1 < args.ph_hi) grid.sync();
    }
}

extern "C" void kernel_launch(void* const* d_in, const int* in_sizes, int n_in, void* d_out, int out_size, void* d_ws, size_t ws_size, hipStream_t stream) {
    static int grid = 0;
    if (grid == 0) {
        if (n_in != 18 || in_sizes[0] != NT * DM || out_size != NT * DM || ws_size < WS_END) { fprintf(stderr, "kernel_launch: unexpected shapes (n_in %d, in0 %d, out %d, ws %zu); nothing launched\n", n_in, n_in > 0 ? in_sizes[0] : -1, out_size, ws_size); grid = -1; return; }
        int dev = 0, cus = 0, per_cu = 0;
        if (hipGetDevice(&dev) != hipSuccess || hipDeviceGetAttribute(&cus, hipDeviceAttributeMultiprocessorCount, dev) != hipSuccess) { fprintf(stderr, "kernel_launch: device query failed\n"); grid = -1; return; }
        if (hipFuncSetAttribute((const void*)hybrid_fwd, hipFuncAttributeMaxDynamicSharedMemorySize, LDS_BYTES) != hipSuccess) { fprintf(stderr, "kernel_launch: hipFuncSetAttribute failed\n"); grid = -1; return; }
        if (hipOccupancyMaxActiveBlocksPerMultiprocessor(&per_cu, (const void*)hybrid_fwd, NTHR, LDS_BYTES) != hipSuccess || per_cu < 1) { fprintf(stderr, "kernel_launch: occupancy query says %d blocks per CU\n", per_cu); (void)hipGetLastError(); grid = -1; return; }
        grid = cus * 1;
    }
    if (grid < 0) return;
    Args a{};
    for (int i = 0; i < 18; ++i) a.in[i] = (const float*)d_in[i];
    a.out = (float*)d_out; a.ws = (unsigned char*)d_ws;
#if MK_N_LAUNCHES == 1
    a.ph_lo = 0; a.ph_hi = NPH;
    void* kargs[] = {&a};
    hipError_t e = hipLaunchCooperativeKernel((const void*)hybrid_fwd, dim3(grid), dim3(NTHR), kargs, LDS_BYTES, stream);
    if (e != hipSuccess) fprintf(stderr, "kernel_launch: cooperative launch failed: %s (grid %d)\n", hipGetErrorString(e), grid);
#else
    for (int ph = 0; ph < NPH; ++ph) { a.ph_lo = ph; a.ph_hi = ph + 1; hipLaunchKernelGGL(hybrid_fwd, dim3(grid), dim3(NTHR), LDS_BYTES, stream, a); }
#endif
}
```

```cpp
#include <hip/hip_runtime.h>
#include <hip/hip_cooperative_groups.h>
#include <cstdio>
#include <cstdint>
namespace cg = cooperative_groups;
#define MK_N_LAUNCHES 1
namespace pg8 {
#define PG8_LAS __attribute__((address_space(3)))
typedef unsigned short bf16_t;
typedef short bf16x8 __attribute__((ext_vector_type(8)));
typedef float f32x4 __attribute__((ext_vector_type(4)));
typedef unsigned u32x4 __attribute__((ext_vector_type(4)));
constexpr int BM = 256, BK = 64, HALF = 128, HTB = HALF * BK * 2  , STAGE_BYTES = 8 * HTB, NXCD = 8, WGM = 8;

__host__ __device__ __forceinline__ int lds_byte(int r, int c) { const int st = (r >> 4) * 2 + (c >> 5), rr = r & 15, cc = c & 31, ob = rr * 64 + cc * 2; return st * 1024 + (ob ^ (((ob >> 9) & 1) << 5)); }
__host__ __device__ __forceinline__ void stage_rc(int b, int& R, int& C) { const int st = b / 1024, sb = b % 1024, swz = sb ^ (((sb >> 9) & 1) << 5); R = (st >> 1) * 16 + swz / 64; C = (st & 1) * 32 + (swz % 64) / 2; }
__host__ __device__ __forceinline__ int perm32(int rho) { const int n = rho >> 4, i = rho & 15; return 8 * (i >> 2) + 4 * n + (i & 3); }

struct Unit { int pm, pn; };
struct Gemm { const bf16_t* A; const bf16_t* Bt; int M, N, K; };

struct StaticOrder {
    int nM, nN, nwg, G, c;
    __host__ __device__ void init(int M, int N, int G_, int c_) { nM = M / BM; nN = N / BM; nwg = nM * nN; G = G_; c = c_; }
    __host__ __device__ bool next(int i, Unit& u) const {
        const long L = (long)i * G + c; if (L >= nwg) return false;
        int wgid = (int)L; { const int q = nwg / NXCD, r = nwg % NXCD, xcd = wgid % NXCD, off = wgid / NXCD; wgid = (xcd < r ? xcd * (q + 1) : r * (q + 1) + (xcd - r) * q) + off; }
        const int nig = WGM * nN, gid = wgid / nig, fm = gid * WGM, gsz = (nM - fm) < WGM ? (nM - fm) : WGM;
        u.pm = fm + ((wgid % nig) % gsz); u.pn = (wgid % nig) / gsz; return true;
    }
    __device__ __forceinline__ void a_ready(const Unit&) const {}
    __device__ __forceinline__ void done(const Unit&) const {}
};

__device__ __forceinline__ unsigned cvt_pk_bf16(float lo, float hi) { unsigned r; asm volatile("v_cvt_pk_bf16_f32 %0, %1, %2" : "=v"(r) : "v"(lo), "v"(hi)); return r; }
typedef float f32x2 __attribute__((ext_vector_type(2)));
__device__ __forceinline__ f32x2 gelu_pk(f32x2 v) {
    const f32x2 av = __builtin_elementwise_abs(v), d = av * 0.2316418882f + 1.0f;
    f32x2 t; t.x = __builtin_amdgcn_rcpf(d.x); t.y = __builtin_amdgcn_rcpf(d.y);
    f32x2 q = t * 0.5307027145f + (-0.7265760135f); q = q * t + 0.7107068705f; q = q * t + (-0.142248368f); q = q * t + 0.127414796f; q = q * t;
    const f32x2 s = (v * v) * (-0.72134752044f);
    f32x2 e; e.x = __builtin_amdgcn_exp2f(s.x); e.y = __builtin_amdgcn_exp2f(s.y);
    const f32x2 m = v * (q * e), r = v - m;
    f32x2 o; o.x = v.x < 0.f ? m.x : r.x; o.y = v.y < 0.f ? m.y : r.y; return o;
}

template <int ACT  > struct EpiBf16 {
    static constexpr bool PERM = true, AFTER_DRAIN = false; static_assert(ACT == 0 || ACT == 1, "EpiBf16: ACT is 0 (none) or 1 (gelu_pk)");
    bf16_t* O; int ldc; const float* bias; int split_cols; size_t split_stride; float scale0;
    __device__ __forceinline__ void operator()(const f32x4 (&acc)[2][2][4][2], const Unit& u, int wr, int wc, int fr, int fq) const {
        const int row0 = u.pm * BM + wr * 64 + fr; int colt = u.pn * BM; bf16_t* base = O;
        float sc = 1.f; if (split_cols) { const int t = colt / split_cols; base += (size_t)t * split_stride; colt -= t * split_cols; if (t == 0) sc = scale0; }
        const int col0 = colt + wc * 32 + 8 * fq, bcol0 = u.pn * BM + wc * 32 + 8 * fq;
        f32x4 bv[2][2];
#pragma unroll
        for (int bj = 0; bj < 2; ++bj)
#pragma unroll
            for (int n = 0; n < 2; ++n) bv[bj][n] = bias ? *(const f32x4*)(bias + bcol0 + bj * HALF + 4 * n) : (f32x4){0.f, 0.f, 0.f, 0.f};
#pragma unroll
        for (int ai = 0; ai < 2; ++ai)
#pragma unroll
            for (int m = 0; m < 4; ++m) { bf16_t* rowp = base + (size_t)(row0 + ai * HALF + m * 16) * ldc + col0;
#pragma unroll
                for (int bj = 0; bj < 2; ++bj) { f32x4 v0 = acc[ai][bj][m][0] + bv[bj][0], v1 = acc[ai][bj][m][1] + bv[bj][1];
                    if (ACT == 1) { f32x2 a = gelu_pk((f32x2){v0[0], v0[1]}), b = gelu_pk((f32x2){v0[2], v0[3]}), c = gelu_pk((f32x2){v1[0], v1[1]}), d = gelu_pk((f32x2){v1[2], v1[3]});
                        v0 = (f32x4){a.x, a.y, b.x, b.y}; v1 = (f32x4){c.x, c.y, d.x, d.y}; }
                    v0 = v0 * sc; v1 = v1 * sc; u32x4 w; w.x = cvt_pk_bf16(v0[0], v0[1]); w.y = cvt_pk_bf16(v0[2], v0[3]); w.z = cvt_pk_bf16(v1[0], v1[1]); w.w = cvt_pk_bf16(v1[2], v1[3]);
                    *(u32x4*)(rowp + bj * HALF) = w; } }
    }
};

struct EpiF32Store {
    static constexpr bool PERM = false, AFTER_DRAIN = false;
    float* C; int ldc;
    __device__ __forceinline__ void operator()(const f32x4 (&acc)[2][2][4][2], const Unit& u, int wr, int wc, int fr, int fq) const {
        const int row0 = u.pm * BM + wr * 64 + fr, col0 = u.pn * BM + wc * 32 + 4 * fq;
#pragma unroll
        for (int ai = 0; ai < 2; ++ai)
#pragma unroll
            for (int m = 0; m < 4; ++m) { float* rowp = C + (size_t)(row0 + ai * HALF + m * 16) * ldc + col0;
#pragma unroll
                for (int bj = 0; bj < 2; ++bj)
#pragma unroll
                    for (int n = 0; n < 2; ++n) *(f32x4*)(rowp + bj * HALF + n * 16) = acc[ai][bj][m][n]; }
    }
};
struct EpiResid {
    static constexpr bool PERM = false, AFTER_DRAIN = false;
    const float* base; float* out; int ldc;
    __device__ __forceinline__ void operator()(const f32x4 (&acc)[2][2][4][2], const Unit& u, int wr, int wc, int fr, int fq) const {
        const int row0 = u.pm * BM + wr * 64 + fr, col0 = u.pn * BM + wc * 32 + 4 * fq;
#pragma unroll
        for (int ai = 0; ai < 2; ++ai)
#pragma unroll
            for (int m = 0; m < 4; ++m) { const size_t off = (size_t)(row0 + ai * HALF + m * 16) * ldc + col0;
                f32x4 bs[2][2];
#pragma unroll
                for (int bj = 0; bj < 2; ++bj)
#pragma unroll
                    for (int n = 0; n < 2; ++n) bs[bj][n] = *(const f32x4*)(base + off + bj * HALF + n * 16);
#pragma unroll
                for (int bj = 0; bj < 2; ++bj)
#pragma unroll
                    for (int n = 0; n < 2; ++n) *(f32x4*)(out + off + bj * HALF + n * 16) = bs[bj][n] + acc[ai][bj][m][n];
                asm volatile("" ::: "memory"); }
    }
};
struct EpiPle {
    static constexpr bool PERM = false, AFTER_DRAIN = false;
    const float* base; float* out; const bf16_t* pw; int ldc;
    __device__ __forceinline__ void operator()(const f32x4 (&acc)[2][2][4][2], const Unit& u, int wr, int wc, int fr, int fq) const {
        typedef unsigned u32x2v __attribute__((ext_vector_type(2)));
        const int row0 = u.pm * BM + wr * 64 + fr, col0 = u.pn * BM + wc * 32 + 4 * fq;
#pragma unroll
        for (int ai = 0; ai < 2; ++ai)
#pragma unroll
            for (int m = 0; m < 4; ++m) { const size_t off = (size_t)(row0 + ai * HALF + m * 16) * ldc + col0;
                f32x4 bs[2][2]; u32x2v pv[2][2];
#pragma unroll
                for (int bj = 0; bj < 2; ++bj)
#pragma unroll
                    for (int n = 0; n < 2; ++n) { bs[bj][n] = *(const f32x4*)(base + off + bj * HALF + n * 16); pv[bj][n] = *(const u32x2v*)(pw + off + bj * HALF + n * 16); }
#pragma unroll
                for (int bj = 0; bj < 2; ++bj)
#pragma unroll
                    for (int n = 0; n < 2; ++n) { const f32x4 a = acc[ai][bj][m][n]; f32x4 o;
                        const float p0 = __uint_as_float(pv[bj][n].x << 16), p1 = __uint_as_float(pv[bj][n].x & 0xffff0000u), p2 = __uint_as_float(pv[bj][n].y << 16), p3 = __uint_as_float(pv[bj][n].y & 0xffff0000u);
                        o[0] = bs[bj][n][0] + p0 / (1.0f + __expf(-a[0])); o[1] = bs[bj][n][1] + p1 / (1.0f + __expf(-a[1]));
                        o[2] = bs[bj][n][2] + p2 / (1.0f + __expf(-a[2])); o[3] = bs[bj][n][3] + p3 / (1.0f + __expf(-a[3]));
                        *(f32x4*)(out + off + bj * HALF + n * 16) = o; }
                asm volatile("" ::: "memory"); }
    }
};
template <class Epi, class Sched, bool ALIGN_EPI = false, bool SP2 = false>
__device__ __forceinline__ void gemm_phase(PG8_LAS unsigned char* lds, const Gemm g, const Sched& S, const Epi& E, const int tid_in) {
    const int tid = tid_in, wid = __builtin_amdgcn_readfirstlane(tid >> 6), lane = tid & 63, wr = wid >> 2, wc = wid & 3, fr = lane & 15, fq = lane >> 4;
    const int K = g.K, nt = K / BK;
    unsigned voffA[2], voffB[2];
#pragma unroll
    for (int i = 0; i < 2; ++i) { int R, C; stage_rc(tid * 16 + i * 8192, R, C); const int Rb = Epi::PERM ? ((R & ~31) + perm32(R & 31)) : R;
        voffA[i] = (unsigned)(R * K + C) * 2u; voffB[i] = (unsigned)(Rb * K + C) * 2u; }
    const size_t kstep = (size_t)(BK * 2);
    const size_t hstep = (size_t)HALF * K * 2;
    const size_t tstep = 2 * hstep;
    const unsigned ldsw = (unsigned)wid * 1024u;
    const int aoff = lds_byte(wr * 64 + fr, fq * 8), boff = lds_byte(wc * 32 + fr, fq * 8);
#define PG8_SA(b, h) (((b) * 2 + (h)) * HTB)
#define PG8_SB(b, h) ((4 + (b) * 2 + (h)) * HTB)
#define PG8_STAGE(bufoff, gbase, voff) do { _Pragma("unroll") for (int _i = 0; _i < 2; ++_i) \
        __builtin_amdgcn_global_load_lds((const unsigned*)((const char*)(gbase) + (voff)[_i]), (PG8_LAS unsigned*)(lds + (bufoff) + ldsw + _i * 8192), 16, 0, 0); } while (0)
#define PG8_LDA(dst, b, h) do { _Pragma("unroll") for (int m = 0; m < 4; ++m) _Pragma("unroll") for (int k = 0; k < 2; ++k) dst[m][k] = *(const PG8_LAS bf16x8*)(lds + PG8_SA(b, h) + aoff + m * 2048 + k * 1024); } while (0)
#define PG8_LDB(dst, b, h) do { _Pragma("unroll") for (int n = 0; n < 2; ++n) _Pragma("unroll") for (int k = 0; k < 2; ++k) dst[n][k] = *(const PG8_LAS bf16x8*)(lds + PG8_SB(b, h) + boff + n * 2048 + k * 1024); } while (0)
#define PG8_MMA(ai, bj, At, Bt) do { __builtin_amdgcn_s_setprio(1); _Pragma("unroll") for (int m = 0; m < 4; ++m) _Pragma("unroll") for (int n = 0; n < 2; ++n) _Pragma("unroll") for (int k = 0; k < 2; ++k) \
        acc[ai][bj][m][n] = __builtin_amdgcn_mfma_f32_16x16x32_bf16(Bt[n][k], At[m][k], acc[ai][bj][m][n], 0, 0, 0); __builtin_amdgcn_s_setprio(0); } while (0)
#define PG8_WAIT_V(n) asm volatile("s_waitcnt vmcnt(" #n ")" ::: "memory")
#define PG8_WAIT_L(n) asm volatile("s_waitcnt lgkmcnt(" #n ")" ::: "memory")
#define PG8_BAR __builtin_amdgcn_s_barrier()
#define PG8_SCHED __builtin_amdgcn_sched_barrier(0)
    Unit cur, nxt; int ui = 0;
    if (!S.next(0, cur)) return;
    f32x4 acc[2][2][4][2];
#pragma unroll
    for (int a = 0; a < 2; ++a)
#pragma unroll
        for (int b = 0; b < 2; ++b)
#pragma unroll
            for (int m = 0; m < 4; ++m)
#pragma unroll
                for (int n = 0; n < 2; ++n) acc[a][b][m][n] = (f32x4){0.f, 0.f, 0.f, 0.f};
    bf16x8 At[4][2], B0[2][2], B1[2][2];
    const char* cA = (const char*)g.A + (size_t)cur.pm * tstep; const char* cB = (const char*)g.Bt + (size_t)cur.pn * tstep;
    S.a_ready(cur);
    if constexpr (SP2) {
        PG8_STAGE(PG8_SB(0, 0), cB, voffB); PG8_STAGE(PG8_SB(0, 1), cB + hstep, voffB); PG8_STAGE(PG8_SA(0, 0), cA, voffA); PG8_STAGE(PG8_SA(0, 1), cA + hstep, voffA);
        if (wr == 1) PG8_BAR;
        PG8_WAIT_V(2); PG8_BAR;
        PG8_STAGE(PG8_SB(1, 0), cB + kstep, voffB); PG8_STAGE(PG8_SA(1, 0), cA + kstep, voffA); PG8_STAGE(PG8_SB(1, 1), cB + hstep + kstep, voffB);
        PG8_WAIT_V(6); PG8_BAR;
    } else {
        PG8_STAGE(PG8_SB(0, 0), cB, voffB); PG8_STAGE(PG8_SA(0, 0), cA, voffA); PG8_STAGE(PG8_SB(0, 1), cB + hstep, voffB); PG8_STAGE(PG8_SA(0, 1), cA + hstep, voffA);
        if (wr == 1) PG8_BAR;
        PG8_WAIT_V(4); PG8_BAR;
        PG8_STAGE(PG8_SB(1, 0), cB + kstep, voffB); PG8_STAGE(PG8_SA(1, 0), cA + kstep, voffA); PG8_STAGE(PG8_SB(1, 1), cB + hstep + kstep, voffB);
        PG8_WAIT_V(6); PG8_BAR;
    }
    for (;;) {
        const bool has_next = S.next(ui + 1, nxt);
        const char* nA = has_next ? (const char*)g.A + (size_t)nxt.pm * tstep : cA; const char* nB = has_next ? (const char*)g.Bt + (size_t)nxt.pn * tstep : cB;
        for (int t = 0; t < nt; t += 2) {
            const bool last = (t == nt - 2);
            const char* a1 = cA + (size_t)(t + 1) * kstep;
            const char* a2 = last ? nA : cA + (size_t)(t + 2) * kstep; const char* b2 = last ? nB : cB + (size_t)(t + 2) * kstep;
            const char* a3 = a2 + kstep; const char* b3 = b2 + kstep;
            if (last && has_next) S.a_ready(nxt);
            if constexpr (SP2) {
            PG8_LDB(B0, 0, 0); PG8_LDB(B1, 0, 1); PG8_SCHED; PG8_LDA(At, 0, 0); PG8_STAGE(PG8_SA(1, 1), a1 + hstep, voffA);
            PG8_WAIT_V(8); PG8_WAIT_L(0); PG8_BAR; PG8_MMA(0, 0, At, B0); PG8_MMA(0, 1, At, B1); PG8_BAR; PG8_SCHED;
            PG8_LDA(At, 0, 1); PG8_STAGE(PG8_SB(0, 0), b2, voffB); PG8_STAGE(PG8_SB(0, 1), b2 + hstep, voffB); PG8_STAGE(PG8_SA(0, 0), a2, voffA);
            PG8_WAIT_V(8); PG8_WAIT_L(0); PG8_BAR; PG8_MMA(1, 0, At, B0); PG8_MMA(1, 1, At, B1); PG8_BAR; PG8_SCHED;
            PG8_LDB(B0, 1, 0); PG8_LDB(B1, 1, 1); PG8_SCHED; PG8_LDA(At, 1, 0); PG8_STAGE(PG8_SA(0, 1), a2 + hstep, voffA);
            PG8_WAIT_V(8); PG8_WAIT_L(0); PG8_BAR; PG8_MMA(0, 0, At, B0); PG8_MMA(0, 1, At, B1); PG8_BAR; PG8_SCHED;
            PG8_LDA(At, 1, 1); PG8_STAGE(PG8_SB(1, 0), b3, voffB); PG8_STAGE(PG8_SB(1, 1), b3 + hstep, voffB); PG8_STAGE(PG8_SA(1, 0), a3, voffA);
            PG8_WAIT_V(8); PG8_WAIT_L(0); PG8_BAR; PG8_MMA(1, 0, At, B0); PG8_MMA(1, 1, At, B1); PG8_BAR; PG8_SCHED;
            } else {
            PG8_LDB(B0, 0, 0); PG8_SCHED; PG8_LDA(At, 0, 0); PG8_STAGE(PG8_SA(1, 1), a1 + hstep, voffA);
            PG8_WAIT_L(8); PG8_BAR; PG8_WAIT_L(0); PG8_MMA(0, 0, At, B0); PG8_BAR; PG8_SCHED;
            PG8_LDB(B1, 0, 1); PG8_STAGE(PG8_SB(0, 0), b2, voffB);
            PG8_BAR; PG8_WAIT_L(0); PG8_MMA(0, 1, At, B1); PG8_BAR;
            PG8_LDA(At, 0, 1); PG8_STAGE(PG8_SA(0, 0), a2, voffA);
            PG8_BAR; PG8_WAIT_L(0); PG8_MMA(1, 0, At, B0); PG8_BAR; PG8_SCHED;
            PG8_STAGE(PG8_SB(0, 1), b2 + hstep, voffB);
            PG8_WAIT_V(6); PG8_BAR; PG8_MMA(1, 1, At, B1); PG8_BAR;
            PG8_LDB(B0, 1, 0); PG8_SCHED; PG8_LDA(At, 1, 0); PG8_STAGE(PG8_SA(0, 1), a2 + hstep, voffA);
            PG8_WAIT_L(8); PG8_BAR; PG8_WAIT_L(0); PG8_MMA(0, 0, At, B0); PG8_BAR; PG8_SCHED;
            PG8_LDB(B1, 1, 1); PG8_STAGE(PG8_SB(1, 0), b3, voffB);
            PG8_BAR; PG8_WAIT_L(0); PG8_MMA(0, 1, At, B1); PG8_BAR;
            PG8_LDA(At, 1, 1); PG8_STAGE(PG8_SA(1, 0), a3, voffA);
            PG8_BAR; PG8_WAIT_L(0); PG8_MMA(1, 0, At, B0); PG8_BAR; PG8_SCHED;
            PG8_STAGE(PG8_SB(1, 1), b3 + hstep, voffB);
            PG8_WAIT_V(6); PG8_BAR; PG8_MMA(1, 1, At, B1); PG8_BAR;
            }
        }
        if constexpr (ALIGN_EPI) { if (wr == 0) PG8_BAR; }
        if constexpr (!Epi::AFTER_DRAIN) { E(acc, cur, wr, wc, fr, fq); S.done(cur); }
        if (!has_next) break;
#pragma unroll
        for (int a = 0; a < 2; ++a)
#pragma unroll
            for (int b = 0; b < 2; ++b)
#pragma unroll
                for (int m = 0; m < 4; ++m)
#pragma unroll
                    for (int n = 0; n < 2; ++n) acc[a][b][m][n] = (f32x4){0.f, 0.f, 0.f, 0.f};
        cur = nxt; cA = nA; cB = nB; ++ui;
        if constexpr (ALIGN_EPI) { if (wr == 1) PG8_BAR; }
    }
    PG8_WAIT_V(0);
    if constexpr (!ALIGN_EPI) { if (wr == 0) PG8_BAR; }
    PG8_BAR;
    if constexpr (Epi::AFTER_DRAIN) { E.fused(acc, cur, wr, wc, fr, fq, lds, wid, lane); S.done(cur); }
#undef PG8_SA
#undef PG8_SB
#undef PG8_STAGE
#undef PG8_LDA
#undef PG8_LDB
#undef PG8_MMA
#undef PG8_WAIT_V
#undef PG8_WAIT_L
#undef PG8_BAR
#undef PG8_SCHED
}
}

#ifndef MK_N_LAUNCHES
#define MK_N_LAUNCHES 1
#endif
constexpr int NB = 8, SEQ = 4096, DM = 1024, DEPTH = 2, NT = NB * SEQ;
constexpr int PW = 3328;
constexpr int C_GQ = 0, C_GK = 256, C_GV = 512, C_GOG = 1024, C_AQ = 1536, C_AK = 2048, C_AV = 2560, C_GLR = 3072;
constexpr int IN_W = 3088, NEXP = 16384;
constexpr float RMS_EPS = 1e-6f;
constexpr int NWAVES = 8, NTHR = 512;
constexpr int LDS_BYTES = 147456;

constexpr size_t MiB = 1u << 20;
constexpr size_t WS_W = 1 * MiB, W_LAYER = 15 * MiB;
constexpr size_t WO_WIN = 0, WO_WOUT = 6656 * 1024, WO_WQ2 = WO_WOUT + 2 * MiB, WO_WG = WO_WQ2 + 4 * MiB, WO_WP = WO_WG + 2 * MiB;
static_assert(WO_WP + 512 * 1024 <= W_LAYER, "weights per layer");
constexpr size_t WS_A = 32 * MiB;
constexpr size_t WS_XN = 288 * MiB;
constexpr size_t WS_C = 352 * MiB;
constexpr size_t WS_D = 416 * MiB;
constexpr size_t WS_PB = 480 * MiB;
constexpr size_t WS_DEC = 496 * MiB;
constexpr size_t WS_END = 497 * MiB;

#define DI __device__ __forceinline__
typedef unsigned short bf16;
typedef short bf16x8 __attribute__((ext_vector_type(8)));
typedef float f32x4 __attribute__((ext_vector_type(4)));
typedef float f32x16 __attribute__((ext_vector_type(16)));
typedef unsigned u32x4 __attribute__((ext_vector_type(4)));
typedef unsigned u32x2 __attribute__((ext_vector_type(2)));
#define MFMA32(a, b, c) __builtin_amdgcn_mfma_f32_32x32x16_bf16((a), (b), (c), 0, 0, 0)
DI float bf2f(unsigned v) { return __uint_as_float(v << 16); }
DI unsigned f2bf(float f) { unsigned u = __float_as_uint(f); return (u + 0x7fffu + ((u >> 16) & 1u)) >> 16; }
DI unsigned pk2(float lo, float hi) { return f2bf(lo) | (f2bf(hi) << 16); }
DI int crow(int reg, int h) { return (reg & 3) + 8 * (reg >> 2) + 4 * h; }
DI float wave_sum(float v) {
#pragma unroll
    for (int o = 1; o < 64; o <<= 1) v += __shfl_xor(v, o);
    return v;
}
DI bf16x8 pack8(const f32x16& x, int s) {
    u32x4 p; p.x = pk2(x[8 * s + 0], x[8 * s + 1]); p.y = pk2(x[8 * s + 2], x[8 * s + 3]); p.z = pk2(x[8 * s + 4], x[8 * s + 5]); p.w = pk2(x[8 * s + 6], x[8 * s + 7]);
    return __builtin_bit_cast(bf16x8, p);
}

struct Args { const float* in[18]; float* out; unsigned char* ws; int ph_lo, ph_hi; };
struct Frame {
    unsigned char* lds; int tid, lane, wave, G, bid;
    const float *x, *p, *norm_mix, *w_in, *g_w2, *g_b, *head_norm, *rel_bias, *w_out, *norm_ffn, *peer_wq, *peer_sk, *peer_u, *peer_v, *norm_ple, *w_ple_gate, *w_ple, *final_norm;
    float* out; unsigned char* ws;
};

DI void win_map(int n, int& src, float& sc) {
    sc = 1.f;
    if (n < 256) { src = n; sc = 0.125f; }
    else if (n < 1024) src = n;
    else if (n < 1536) src = n + 16;
    else if (n < 2048) { src = n + 16; sc = 0.125f; }
    else if (n < 3072) src = n + 16;
    else if (n < 3088) src = n - 3072 + 1024;
    else src = -1;
}
DI void transpose_item(const float* W, int N, int K, bf16* WT, int n0, int k0, bool winmap, float* tile, int tid) {
    const int nl = tid & 63, kq = tid >> 6;
    int src = n0 + nl; float sc = 1.f;
    if (winmap) win_map(n0 + nl, src, sc);
#pragma unroll
    for (int kk = 0; kk < 8; ++kk) { const int k = kq * 8 + kk; tile[k * 65 + nl] = src >= 0 ? W[(size_t)(k0 + k) * N + src] * sc : 0.f; }
    __syncthreads();
    const int r = tid >> 3, c = tid & 7;
    u32x4 o;
    o.x = pk2(tile[(c * 8 + 0) * 65 + r], tile[(c * 8 + 1) * 65 + r]); o.y = pk2(tile[(c * 8 + 2) * 65 + r], tile[(c * 8 + 3) * 65 + r]);
    o.z = pk2(tile[(c * 8 + 4) * 65 + r], tile[(c * 8 + 5) * 65 + r]); o.w = pk2(tile[(c * 8 + 6) * 65 + r], tile[(c * 8 + 7) * 65 + r]);
    *(u32x4*)(WT + (size_t)(n0 + r) * K + k0 + c * 8) = o;
    __syncthreads();
}
DI void wq2_item(const float* wq, const float* sk, bf16* WT, int hp, int k0, float* lds, int tid) {
    float* s_sk = lds;
    float* s_wq = lds + 128 * 132;
#pragma unroll
    for (int i = 0; i < 8; ++i) { const int idx = tid + i * 512, n = idx >> 5, d4 = idx & 31; *(f32x4*)(s_sk + n * 132 + d4 * 4) = *(const f32x4*)(sk + (size_t)hp * 16384 + n * 128 + d4 * 4); }
#pragma unroll
    for (int i = 0; i < 4; ++i) { const int idx = tid + i * 512, k = idx >> 5, d4 = idx & 31; *(f32x4*)(s_wq + k * 132 + d4 * 4) = *(const f32x4*)(wq + (size_t)(k0 + k) * 2048 + hp * 128 + d4 * 4); }
    __syncthreads();
    const int tn = tid & 31, tk = tid >> 5;
    float acc[4][4];
#pragma unroll
    for (int a = 0; a < 4; ++a)
#pragma unroll
        for (int b = 0; b < 4; ++b) acc[a][b] = 0.f;
    for (int d4 = 0; d4 < 32; ++d4) {
        f32x4 av[4], bv[4];
#pragma unroll
        for (int a = 0; a < 4; ++a) av[a] = *(const f32x4*)(s_sk + (tn * 4 + a) * 132 + d4 * 4);
#pragma unroll
        for (int b = 0; b < 4; ++b) bv[b] = *(const f32x4*)(s_wq + (tk * 4 + b) * 132 + d4 * 4);
#pragma unroll
        for (int a = 0; a < 4; ++a)
#pragma unroll
            for (int b = 0; b < 4; ++b) acc[a][b] += av[a][0] * bv[b][0] + av[a][1] * bv[b][1] + av[a][2] * bv[b][2] + av[a][3] * bv[b][3];
    }
#pragma unroll
    for (int a = 0; a < 4; ++a) { u32x2 o; o.x = pk2(acc[a][0], acc[a][1]); o.y = pk2(acc[a][2], acc[a][3]);
        *(u32x2*)(WT + (size_t)(hp * 128 + tn * 4 + a) * 1024 + k0 + tk * 4) = o; }
    __syncthreads();
}
DI void phase_prep(Frame& F) {
    float* tile = (float*)F.lds;
    constexpr int I_WIN = 832, I_WOUT = 256, I_WG = 256, I_WP = 64, I_WQ2 = 256, I_L = I_WIN + I_WOUT + I_WG + I_WP + I_WQ2;
    for (int it = F.bid; it < DEPTH * I_L; it += F.G) {
        const int l = it / I_L; int r = it % I_L;
        bf16* wl = (bf16*)(F.ws + WS_W + (size_t)l * W_LAYER);
        if (r < I_WIN) { transpose_item(F.w_in + (size_t)l * DM * IN_W, IN_W, DM, wl + WO_WIN / 2, (r >> 4) * 64, (r & 15) * 64, true, tile, F.tid); continue; } r -= I_WIN;
        if (r < I_WOUT) { transpose_item(F.w_out + (size_t)l * DM * DM, DM, DM, wl + WO_WOUT / 2, (r >> 4) * 64, (r & 15) * 64, false, tile, F.tid); continue; } r -= I_WOUT;
        if (r < I_WG) { transpose_item(F.w_ple_gate + (size_t)l * DM * DM, DM, DM, wl + WO_WG / 2, (r >> 4) * 64, (r & 15) * 64, false, tile, F.tid); continue; } r -= I_WG;
        if (r < I_WP) { transpose_item(F.w_ple + (size_t)l * 256 * DM, DM, 256, wl + WO_WP / 2, (r >> 2) * 64, (r & 3) * 64, false, tile, F.tid); continue; } r -= I_WP;
        wq2_item(F.peer_wq + (size_t)l * DM * 2048, F.peer_sk + (size_t)l * 16 * 16384, wl + WO_WQ2 / 2, r >> 4, (r & 15) * 64, tile, F.tid);
    }
}

DI void rms_row_to_bf16(const float* xrow, const float* g, bf16* orow, int lane) {
    const f32x4* xr = (const f32x4*)xrow + lane; const f32x4* gr = (const f32x4*)g + lane;
    f32x4 v[4]; float s = 0.f;
#pragma unroll
    for (int j = 0; j < 4; ++j) { v[j] = xr[64 * j]; s += (v[j].x * v[j].x + v[j].y * v[j].y) + (v[j].z * v[j].z + v[j].w * v[j].w); }
    const float rs = rsqrtf(wave_sum(s) * (1.f / DM) + RMS_EPS);
    u32x2* o8 = (u32x2*)orow + lane;
#pragma unroll
    for (int j = 0; j < 4; ++j) { const f32x4 gg = gr[64 * j]; u32x2 o; o.x = pk2(v[j].x * rs * gg.x, v[j].y * rs * gg.y); o.y = pk2(v[j].z * rs * gg.z, v[j].w * rs * gg.w); o8[64 * j] = o; }
}
DI void phase_norm(Frame& F, const float* src, const float* g, bf16* dst) {
    for (int m = F.bid * NWAVES + F.wave; m < NT; m += F.G * NWAVES) rms_row_to_bf16(src + (size_t)m * DM, g, dst + (size_t)m * DM, F.lane);
}
DI void phase_final_norm(Frame& F, const float* g) {
    for (int m = F.bid * NWAVES + F.wave; m < NT; m += F.G * NWAVES) {
        f32x4* xr = (f32x4*)(F.out + (size_t)m * DM) + F.lane; const f32x4* gr = (const f32x4*)g + F.lane;
        f32x4 v[4]; float s = 0.f;
#pragma unroll
        for (int j = 0; j < 4; ++j) { v[j] = xr[64 * j]; s += (v[j].x * v[j].x + v[j].y * v[j].y) + (v[j].z * v[j].z + v[j].w * v[j].w); }
        const float rs = rsqrtf(wave_sum(s) * (1.f / DM) + RMS_EPS);
#pragma unroll
        for (int j = 0; j < 4; ++j) { const f32x4 gg = gr[64 * j]; xr[64 * j] = v[j] * rs * gg; }
    }
}
DI void convert_bf16(Frame& F, const float* src, bf16* dst, size_t n) {
    const size_t n8 = n >> 3;
    for (size_t i = (size_t)F.bid * NTHR + F.tid; i < n8; i += (size_t)F.G * NTHR) {
        const f32x4 a = ((const f32x4*)src)[2 * i], b = ((const f32x4*)src)[2 * i + 1];
        u32x4 o; o.x = pk2(a.x, a.y); o.y = pk2(a.z, a.w); o.z = pk2(b.x, b.y); o.w = pk2(b.z, b.w);
        ((u32x4*)dst)[i] = o;
    }
}

DI void att_unit(Frame& F, int l, int b, int h, int c, const bf16* proj, bf16* ocat) {
    const int tid = F.tid, lane = F.lane, w = F.wave, r = lane & 31, h2 = lane >> 5, qh = w & 1, kg = w >> 1;
    float* tab = (float*)F.lds;
    float* Ot = (float*)(F.lds + 2048);
    float* ML = (float*)(F.lds + 2048 + 8 * 64 * 33 * 4);
    if (tid < 257) tab[tid] = F.rel_bias[(size_t)l * 8 * 257 + h * 257 + tid];
    __syncthreads();
    const int m0 = b * SEQ + c * 64;
    const bf16* qp = proj + (size_t)(m0 + qh * 32 + r) * PW + C_AQ + h * 64 + h2 * 8;
    bf16x8 qf[4];
#pragma unroll
    for (int s = 0; s < 4; ++s) qf[s] = *(const bf16x8*)(qp + s * 16);
    const int nvc = (c < 8 ? c : 8) + 1, kt0 = 18 - 2 * nvc;
    f32x16 o0, o1;
#pragma unroll
    for (int i = 0; i < 16; ++i) { o0[i] = 0.f; o1[i] = 0.f; }
    float mrun = -1e30f, lrun = 0.f;
    const int iq = qh * 32 + r;
    for (int kt = kt0 + kg; kt < 18; kt += 4) {
        const int krow0 = b * SEQ + (c - 8) * 64 + kt * 32;
        const bf16* kp = proj + (size_t)(krow0 + r) * PW + C_AK + h * 64 + h2 * 8;
        bf16x8 kf[4];
#pragma unroll
        for (int s = 0; s < 4; ++s) kf[s] = *(const bf16x8*)(kp + s * 16);
        const bf16* vp = proj + (size_t)krow0 * PW + C_AV + h * 64 + r;
        bf16x8 vf[2][2];
#pragma unroll
        for (int s = 0; s < 2; ++s)
#pragma unroll
            for (int dt = 0; dt < 2; ++dt)
#pragma unroll
                for (int j = 0; j < 8; ++j) vf[s][dt][j] = (short)vp[(size_t)(16 * s + 8 * (j >> 2) + 4 * h2 + (j & 3)) * PW + dt * 32];
        f32x16 sacc;
#pragma unroll
        for (int i = 0; i < 16; ++i) sacc[i] = 0.f;
#pragma unroll
        for (int s = 0; s < 4; ++s) sacc = MFMA32(kf[s], qf[s], sacc);
        const int jb = kt * 32 + 4 * h2;
        float tmax = -1e30f;
#pragma unroll
        for (int i = 0; i < 16; ++i) { const int j = jb + (i & 3) + 8 * (i >> 2); int rel = iq + 512 - j; rel = rel < -128 ? -128 : (rel > 128 ? 128 : rel);
            sacc[i] += tab[rel + 128]; tmax = fmaxf(tmax, sacc[i]); }
        tmax = fmaxf(tmax, __shfl_xor(tmax, 32));
        const float mnew = fmaxf(mrun, tmax), alpha = __expf(mrun - mnew);
        float psum = 0.f;
#pragma unroll
        for (int i = 0; i < 16; ++i) { const float p = __expf(sacc[i] - mnew); sacc[i] = p; psum += p; }
        lrun = lrun * alpha + psum; mrun = mnew;
#pragma unroll
        for (int i = 0; i < 16; ++i) { o0[i] *= alpha; o1[i] *= alpha; }
#pragma unroll
        for (int s = 0; s < 2; ++s) { const bf16x8 pf = pack8(sacc, s); o0 = MFMA32(vf[s][0], pf, o0); o1 = MFMA32(vf[s][1], pf, o1); }
    }
    lrun += __shfl_xor(lrun, 32);
#pragma unroll
    for (int i = 0; i < 16; ++i) { const int d = crow(i, h2); Ot[(w * 64 + d) * 33 + r] = o0[i]; Ot[(w * 64 + 32 + d) * 33 + r] = o1[i]; }
    if (h2 == 0) { ML[w * 64 + r] = mrun; ML[w * 64 + 32 + r] = lrun; }
    __syncthreads();
    {
        const int q = tid >> 3, dg = tid & 7, qq = q & 31, qhh = q >> 5;
        float mg[4], lg[4], ms = -1e30f;
#pragma unroll
        for (int g = 0; g < 4; ++g) { const int ww = g * 2 + qhh; mg[g] = ML[ww * 64 + qq]; lg[g] = ML[ww * 64 + 32 + qq]; ms = fmaxf(ms, mg[g]); }
        float L = 0.f, wg[4];
#pragma unroll
        for (int g = 0; g < 4; ++g) { wg[g] = __expf(mg[g] - ms); L += wg[g] * lg[g]; }
        const float inv = 1.f / L;
        float ov[8];
#pragma unroll
        for (int dd = 0; dd < 8; ++dd) { float a = 0.f;
#pragma unroll
            for (int g = 0; g < 4; ++g) a += wg[g] * Ot[((g * 2 + qhh) * 64 + dg * 8 + dd) * 33 + qq];
            ov[dd] = a * inv; }
        u32x4 o; o.x = pk2(ov[0], ov[1]); o.y = pk2(ov[2], ov[3]); o.z = pk2(ov[4], ov[5]); o.w = pk2(ov[6], ov[7]);
        *(u32x4*)(ocat + (size_t)(m0 + q) * DM + 512 + h * 64 + dg * 8) = o;
    }
    __syncthreads();
}

constexpr int GL_GLR = 0, GL_W2 = 4096, GL_B2 = 8192, GL_CUM = 8448, GL_TOT = GL_CUM + 16384, GL_VT = GL_TOT + 2048, GL_KS = GL_VT + 128 * 72 * 2, GL_QE = GL_KS + 64 * 72 * 2, GL_KE = GL_QE + 64 * 72 * 2,
              GL_QG = GL_KE + 64 * 72 * 2, GL_OS = GL_QG + 64 * 72 * 2, GL_SSQ = GL_OS + 64 * 132 * 4, GL_END = GL_SSQ + 1024;
static_assert(GL_END <= LDS_BYTES && GL_VT % 16 == 0 && GL_KS % 16 == 0 && GL_QE % 16 == 0 && GL_OS % 16 == 0, "GLA LDS map");
DI float log_sigmoid(float x) { return fminf(x, 0.f) - log1pf(__expf(-fabsf(x))); }
DI void gla_cum(Frame& F, int l, int h, int m0, const bf16* proj) {
    const int tid = F.tid;
    float* Gl = (float*)(F.lds + GL_GLR); float* W2 = (float*)(F.lds + GL_W2); float* B2 = (float*)(F.lds + GL_B2); float* CUM = (float*)(F.lds + GL_CUM); float* TOT = (float*)(F.lds + GL_TOT);
    if (tid < 128) { const int t = tid >> 1, hf = tid & 1; const u32x4 v = *(const u32x4*)(proj + (size_t)(m0 + t) * PW + C_GLR + hf * 8);
        float* g = Gl + t * 16 + hf * 8; g[0] = bf2f(v.x & 0xffffu); g[1] = bf2f(v.x >> 16); g[2] = bf2f(v.y & 0xffffu); g[3] = bf2f(v.y >> 16); g[4] = bf2f(v.z & 0xffffu); g[5] = bf2f(v.z >> 16); g[6] = bf2f(v.w & 0xffffu); g[7] = bf2f(v.w >> 16); }
#pragma unroll
    for (int i = 0; i < 2; ++i) { const int idx = tid + i * 512, rr = idx >> 6, d = idx & 63; W2[idx] = F.g_w2[(size_t)l * 16 * 256 + rr * 256 + h * 64 + d]; }
    if (tid < 64) B2[tid] = F.g_b[(size_t)l * 256 + h * 64 + tid];
    __syncthreads();
    const int d = tid & 63, tq = tid >> 6;
    float w2r[16];
#pragma unroll
    for (int rr = 0; rr < 16; ++rr) w2r[rr] = W2[rr * 64 + d];
    const float bb = B2[d];
    float run = 0.f;
#pragma unroll
    for (int tt = 0; tt < 8; ++tt) { const int t = tq * 8 + tt; float x = bb;
#pragma unroll
        for (int rr = 0; rr < 16; ++rr) x += Gl[t * 16 + rr] * w2r[rr];
        run += log_sigmoid(x) * (1.f / 16.f); CUM[t * 64 + d] = run; }
    TOT[tq * 64 + d] = run;
    __syncthreads();
    float off = 0.f;
    for (int q = 0; q < tq; ++q) off += TOT[q * 64 + d];
#pragma unroll
    for (int tt = 0; tt < 8; ++tt) CUM[(tq * 8 + tt) * 64 + d] += off;
    __syncthreads();
}
DI void gla_stage_vt(Frame& F, int h, int m0, const bf16* proj) {
    const int tid = F.tid, e = tid & 127, cq = tid >> 7;
    bf16* Vt = (bf16*)(F.lds + GL_VT);
    unsigned short v[16];
#pragma unroll
    for (int i = 0; i < 16; ++i) v[i] = proj[(size_t)(m0 + cq * 16 + i) * PW + C_GV + h * 128 + e];
    u32x4 a, b2;
    a.x = v[0] | ((unsigned)v[1] << 16); a.y = v[2] | ((unsigned)v[3] << 16); a.z = v[4] | ((unsigned)v[5] << 16); a.w = v[6] | ((unsigned)v[7] << 16);
    b2.x = v[8] | ((unsigned)v[9] << 16); b2.y = v[10] | ((unsigned)v[11] << 16); b2.z = v[12] | ((unsigned)v[13] << 16); b2.w = v[14] | ((unsigned)v[15] << 16);
    *(u32x4*)(Vt + e * 72 + cq * 16) = a; *(u32x4*)(Vt + e * 72 + cq * 16 + 8) = b2;
}
DI void gla_kv_unit(Frame& F, int l, int b, int h, int c, const bf16* proj, float* KVt, float* dec) {
    const int tid = F.tid, lane = F.lane, w = F.wave, r = lane & 31, h2 = lane >> 5;
    const int m0 = b * SEQ + c * 64, unit = (b * 4 + h) * 64 + c;
    float* CUM = (float*)(F.lds + GL_CUM); bf16* Vt = (bf16*)(F.lds + GL_VT); bf16* Ks = (bf16*)(F.lds + GL_KS);
    gla_cum(F, l, h, m0, proj);
    {
        const int d = tid & 63, tq = tid >> 6; const float last = CUM[63 * 64 + d];
        float kv[8];
#pragma unroll
        for (int tt = 0; tt < 8; ++tt) { const int t = tq * 8 + tt; kv[tt] = bf2f(proj[(size_t)(m0 + t) * PW + C_GK + h * 64 + d]) * __expf(last - CUM[t * 64 + d]); }
        u32x4 o; o.x = pk2(kv[0], kv[1]); o.y = pk2(kv[2], kv[3]); o.z = pk2(kv[4], kv[5]); o.w = pk2(kv[6], kv[7]);
        *(u32x4*)(Ks + d * 72 + tq * 8) = o;
        if (tid < 64) dec[(size_t)unit * 64 + tid] = __expf(last);
    }
    gla_stage_vt(F, h, m0, proj);
    __syncthreads();
    {
        const int et = w >> 1, dt = w & 1;
        f32x16 acc;
#pragma unroll
        for (int i = 0; i < 16; ++i) acc[i] = 0.f;
#pragma unroll
        for (int s = 0; s < 4; ++s) { const bf16x8 a = *(const bf16x8*)(Vt + (et * 32 + r) * 72 + 16 * s + 8 * h2); const bf16x8 bb = *(const bf16x8*)(Ks + (dt * 32 + r) * 72 + 16 * s + 8 * h2); acc = MFMA32(a, bb, acc); }
        float* o = KVt + (size_t)unit * 8192;
#pragma unroll
        for (int i = 0; i < 16; ++i) o[(et * 32 + crow(i, h2)) * 64 + dt * 32 + r] = acc[i];
    }
    __syncthreads();
}
DI void phase_scan(Frame& F, float* KVt, const float* dec) {
    for (int idx = F.bid * NTHR + F.tid; idx < 32 * 8192; idx += F.G * NTHR) {
        const int bh = idx >> 13, ed = idx & 8191, d = ed & 63;
        float* p = KVt + (size_t)bh * 64 * 8192 + ed; const float* dc = dec + (size_t)bh * 64 * 64 + d;
        float S = 0.f;
#pragma unroll 8
        for (int n = 0; n < 64; ++n) { const float kv = p[(size_t)n * 8192], dcy = dc[n * 64]; p[(size_t)n * 8192] = S; S = dcy * S + kv; }
    }
}
DI void gla_out_unit(Frame& F, int l, int b, int h, int c, const bf16* proj, const float* prevT, bf16* ocat) {
    const int tid = F.tid, lane = F.lane, w = F.wave, r = lane & 31, h2 = lane >> 5;
    const int m0 = b * SEQ + c * 64, unit = (b * 4 + h) * 64 + c;
    float* CUM = (float*)(F.lds + GL_CUM); bf16* Vt = (bf16*)(F.lds + GL_VT); bf16* Qe = (bf16*)(F.lds + GL_QE); bf16* Ke = (bf16*)(F.lds + GL_KE); bf16* Qg = (bf16*)(F.lds + GL_QG);
    float* Os = (float*)(F.lds + GL_OS);
    gla_cum(F, l, h, m0, proj);
    {
        const int d = tid & 63, tq = tid >> 6; const float mid = CUM[32 * 64 + d];
#pragma unroll
        for (int tt = 0; tt < 8; ++tt) { const int t = tq * 8 + tt; const float cm = CUM[t * 64 + d];
            const float q = bf2f(proj[(size_t)(m0 + t) * PW + C_GQ + h * 64 + d]), k = bf2f(proj[(size_t)(m0 + t) * PW + C_GK + h * 64 + d]);
            Qe[t * 72 + d] = (bf16)f2bf(q * __expf(cm - mid)); Ke[t * 72 + d] = (bf16)f2bf(k * __expf(mid - cm)); Qg[t * 72 + d] = (bf16)f2bf(q * __expf(cm)); }
    }
    gla_stage_vt(F, h, m0, proj);
    __syncthreads();
    {
        const int et = w >> 1, it = w & 1;
        f32x16 o;
#pragma unroll
        for (int i = 0; i < 16; ++i) o[i] = 0.f;
        const float* pp = prevT + (size_t)unit * 8192 + (et * 32 + r) * 64 + 8 * h2;
#pragma unroll
        for (int s = 0; s < 4; ++s) { const f32x4 p0 = *(const f32x4*)(pp + 16 * s), p1 = *(const f32x4*)(pp + 16 * s + 4);
            u32x4 pa; pa.x = pk2(p0.x, p0.y); pa.y = pk2(p0.z, p0.w); pa.z = pk2(p1.x, p1.y); pa.w = pk2(p1.z, p1.w);
            const bf16x8 bq = *(const bf16x8*)(Qg + (it * 32 + r) * 72 + 16 * s + 8 * h2);
            o = MFMA32(__builtin_bit_cast(bf16x8, pa), bq, o); }
        for (int jt = 0; jt <= it; ++jt) {
            f32x16 X;
#pragma unroll
            for (int i = 0; i < 16; ++i) X[i] = 0.f;
#pragma unroll
            for (int s = 0; s < 4; ++s) { const bf16x8 a = *(const bf16x8*)(Ke + (jt * 32 + r) * 72 + 16 * s + 8 * h2); const bf16x8 bb = *(const bf16x8*)(Qe + (it * 32 + r) * 72 + 16 * s + 8 * h2); X = MFMA32(a, bb, X); }
            if (jt == it) {
#pragma unroll
                for (int i = 0; i < 16; ++i) if (crow(i, h2) > r) X[i] = 0.f;
            }
#pragma unroll
            for (int s = 0; s < 2; ++s) { const bf16x8 pf = pack8(X, s);
                const u32x2 lo = *(const u32x2*)(Vt + (et * 32 + r) * 72 + jt * 32 + 16 * s + 4 * h2), hi = *(const u32x2*)(Vt + (et * 32 + r) * 72 + jt * 32 + 16 * s + 8 + 4 * h2);
                u32x4 va; va.x = lo.x; va.y = lo.y; va.z = hi.x; va.w = hi.y;
                o = MFMA32(__builtin_bit_cast(bf16x8, va), pf, o); }
        }
#pragma unroll
        for (int i = 0; i < 16; ++i) Os[(it * 32 + r) * 132 + et * 32 + crow(i, h2)] = o[i];
    }
    __syncthreads();
    {
        const int i = tid >> 3, ec = tid & 7, e0 = ec * 16;
        float v[16]; float ss = 0.f;
#pragma unroll
        for (int k = 0; k < 4; ++k) { const f32x4 t = *(const f32x4*)(Os + i * 132 + e0 + 4 * k); v[4 * k] = t.x; v[4 * k + 1] = t.y; v[4 * k + 2] = t.z; v[4 * k + 3] = t.w; ss += (t.x * t.x + t.y * t.y) + (t.z * t.z + t.w * t.w); }
        ss += __shfl_xor(ss, 1); ss += __shfl_xor(ss, 2); ss += __shfl_xor(ss, 4);
        const float rs = rsqrtf(ss * (1.f / 128.f) + RMS_EPS);
        const u32x4 g0 = *(const u32x4*)(proj + (size_t)(m0 + i) * PW + C_GOG + h * 128 + e0), g1 = *(const u32x4*)(proj + (size_t)(m0 + i) * PW + C_GOG + h * 128 + e0 + 8);
        const unsigned gw[8] = {g0.x, g0.y, g0.z, g0.w, g1.x, g1.y, g1.z, g1.w};
        const float* hn = F.head_norm + (size_t)l * 128 + e0;
        unsigned ow[8];
#pragma unroll
        for (int k = 0; k < 8; ++k) { const float ga = bf2f(gw[k] & 0xffffu), gb = bf2f(gw[k] >> 16);
            const float a = v[2 * k] * rs * hn[2 * k] * (ga / (1.f + __expf(-ga))), bq = v[2 * k + 1] * rs * hn[2 * k + 1] * (gb / (1.f + __expf(-gb)));
            ow[k] = pk2(a, bq); }
        u32x4 o0, o1; o0.x = ow[0]; o0.y = ow[1]; o0.z = ow[2]; o0.w = ow[3]; o1.x = ow[4]; o1.y = ow[5]; o1.z = ow[6]; o1.w = ow[7];
        *(u32x4*)(ocat + (size_t)(m0 + i) * DM + h * 128 + e0) = o0; *(u32x4*)(ocat + (size_t)(m0 + i) * DM + h * 128 + e0 + 8) = o1;
    }
    __syncthreads();
}

DI unsigned ord_f32(float v) { const unsigned b = __float_as_uint(v); return (b & 0x80000000u) ? ~b : (b | 0x80000000u); }
DI void topk_tile(Frame& F, int tile, const float* sc, int* eout, float* gout) {
    const int tid = F.tid;
    float* S = (float*)F.lds;
    const float* src = sc + (size_t)tile * 32768;
#pragma unroll 4
    for (int i = 0; i < 16; ++i) { const int idx = tid + i * 512, R = idx >> 5, c4 = idx & 31; const f32x4 v = *(const f32x4*)(src + (size_t)idx * 4);
        float* d = S + R * 129 + c4 * 4; d[0] = v.x; d[1] = v.y; d[2] = v.z; d[3] = v.w; }
    __syncthreads();
    float tv[16]; int ti[16];
    if (tid < 256) {
        unsigned tk[16];
#pragma unroll
        for (int k = 0; k < 16; ++k) tk[k] = 0u;
        const float* row = S + tid * 129;
#pragma unroll 4
        for (int n = 0; n < 128; ++n) { unsigned key = (ord_f32(row[n]) & ~127u) | (unsigned)(127 - n);
#pragma unroll
            for (int k = 0; k < 16; ++k) { const unsigned hi = tk[k] > key ? tk[k] : key; key = tk[k] > key ? key : tk[k]; tk[k] = hi; } }
#pragma unroll
        for (int k = 0; k < 16; ++k) { ti[k] = 127 - (int)(tk[k] & 127u); tv[k] = row[ti[k]]; }
    }
    __syncthreads();
    float* LV = (float*)F.lds; int* LI = (int*)(F.lds + 16384);
    if (tid < 256) {
#pragma unroll
        for (int k = 0; k < 16; ++k) { LV[tid * 16 + k] = tv[k]; LI[tid * 16 + k] = ti[k]; }
    }
    __syncthreads();
    if (tid < 128) {
        const int R1 = 2 * tid, R2 = 2 * tid + 1;
        float s1[16], s2[16];
#pragma unroll
        for (int k = 0; k < 16; ++k) { s1[k] = LV[R1 * 16 + k]; s2[k] = LV[R2 * 16 + k]; }
        unsigned tk[16];
#pragma unroll
        for (int k = 0; k < 16; ++k) tk[k] = 0u;
#pragma unroll
        for (int i = 0; i < 16; ++i)
#pragma unroll
            for (int j = 0; j < 16; ++j)
                if ((i + 1) * (j + 1) <= 16) { unsigned key = (ord_f32(s1[i] + s2[j]) & ~255u) | (unsigned)(255 - (i * 16 + j));
#pragma unroll
                    for (int k = 0; k < 16; ++k) { const unsigned hi = tk[k] > key ? tk[k] : key; key = tk[k] > key ? key : tk[k]; tk[k] = hi; } }
        float top[16]; int ee[16]; float mx = -1e30f;
#pragma unroll
        for (int k = 0; k < 16; ++k) { const int cid = 255 - (int)(tk[k] & 255u), i = cid >> 4, j = cid & 15;
            top[k] = LV[R1 * 16 + i] + LV[R2 * 16 + j]; ee[k] = LI[R1 * 16 + i] * 128 + LI[R2 * 16 + j]; mx = fmaxf(mx, top[k]); }
        float sum = 0.f;
#pragma unroll
        for (int k = 0; k < 16; ++k) { top[k] = __expf(top[k] - mx); sum += top[k]; }
        const float inv = 1.f / sum;
        const int t = tile * 16 + (tid >> 3), hh = tid & 7;
        int* eo = eout + (size_t)t * 128 + hh * 16; float* go = gout + (size_t)t * 128 + hh * 16;
#pragma unroll
        for (int k = 0; k < 16; ++k) { eo[k] = ee[k]; go[k] = top[k] * inv; }
    }
    __syncthreads();
}

typedef float f32x2 __attribute__((ext_vector_type(2)));
DI unsigned pack4_fp8(float a, float b, float c, float d) { int w = 0; w = __builtin_amdgcn_cvt_pk_fp8_f32(a, b, w, false); w = __builtin_amdgcn_cvt_pk_fp8_f32(c, d, w, true); return (unsigned)w; }
DI float wave_max(float v) {
#pragma unroll
    for (int o = 1; o < 64; o <<= 1) v = fmaxf(v, __shfl_xor(v, o));
    return v;
}
DI void convert_rows_fp8(Frame& F, const float* src, unsigned char* dst, float* rscale, bool vslice) {
    const int lane = F.lane;
    for (int e = F.bid * NWAVES + F.wave; e < NEXP; e += F.G * NWAVES) {
        const f32x4* r = (const f32x4*)(src + (size_t)e * DM) + lane * 4;
        f32x4 v[4]; float mx = 0.f;
#pragma unroll
        for (int j = 0; j < 4; ++j) { v[j] = r[j]; mx = fmaxf(mx, fmaxf(fmaxf(fabsf(v[j].x), fabsf(v[j].y)), fmaxf(fabsf(v[j].z), fabsf(v[j].w)))); }
        mx = wave_max(mx);
        const float s = mx > 0.f ? 240.f / mx : 1.f, inv = mx > 0.f ? mx * (1.f / 240.f) : 1.f;
        u32x4 o; o.x = pack4_fp8(v[0].x * s, v[0].y * s, v[0].z * s, v[0].w * s); o.y = pack4_fp8(v[1].x * s, v[1].y * s, v[1].z * s, v[1].w * s);
        o.z = pack4_fp8(v[2].x * s, v[2].y * s, v[2].z * s, v[2].w * s); o.w = pack4_fp8(v[3].x * s, v[3].y * s, v[3].z * s, v[3].w * s);
        if (!vslice) *(u32x4*)(dst + (size_t)e * DM + lane * 16) = o;
        else *(u32x4*)(dst + ((size_t)(lane >> 3) * NEXP + e) * 128 + (lane & 7) * 16) = o;
        if (lane == 0) rscale[e] = inv;
    }
}
DI void peer_token(Frame& F, int t, const bf16* xn, const int* E, const float* Gt, const unsigned char* U8, const float* usc, const unsigned char* V8, const float* vsc, const float* hsrc, float* hdst) {
    const int lane = F.lane;
    f32x2 xp[8];
    {
        const u32x4 a = *(const u32x4*)(xn + (size_t)t * DM + lane * 16), b = *(const u32x4*)(xn + (size_t)t * DM + lane * 16 + 8);
        const unsigned wv[8] = {a.x, a.y, a.z, a.w, b.x, b.y, b.z, b.w};
#pragma unroll
        for (int k = 0; k < 8; ++k) { xp[k].x = bf2f(wv[k] & 0xffffu); xp[k].y = __uint_as_float(wv[k] & 0xffff0000u); }
    }
    const int ea = E[(size_t)t * 128 + lane], eb = E[(size_t)t * 128 + 64 + lane];
    const float ga = Gt[(size_t)t * 128 + lane], gb = Gt[(size_t)t * 128 + 64 + lane];
    const float usa = usc[ea], usb = usc[eb], vsa = vsc[ea], vsb = vsc[eb];
    float acta = 0.f, actb = 0.f;
    for (int g = 0; g < 16; ++g) {
        const int esel = g < 8 ? ea : eb;
        u32x4 uw[8];
#pragma unroll
        for (int i = 0; i < 8; ++i) { const int ek = __shfl(esel, (g * 8 + i) & 63); uw[i] = *(const u32x4*)(U8 + (size_t)ek * DM + lane * 16); }
#pragma unroll
        for (int i = 0; i < 8; ++i) {
            const unsigned wv[4] = {uw[i].x, uw[i].y, uw[i].z, uw[i].w};
            f32x2 s2 = {0.f, 0.f};
#pragma unroll
            for (int k = 0; k < 4; ++k) { s2 = __builtin_amdgcn_cvt_pk_f32_fp8((int)wv[k], false) * xp[2 * k] + s2; s2 = __builtin_amdgcn_cvt_pk_f32_fp8((int)wv[k], true) * xp[2 * k + 1] + s2; }
            const float s = wave_sum(s2.x + s2.y);
            if (lane == ((g * 8 + i) & 63)) { if (g < 8) acta = s; else actb = s; }
        }
    }
    acta *= usa; actb *= usb;
    const float hida = ga * (0.5f * acta * (1.f + erff(acta * 0.70710678118654752f))) * vsa, hidb = gb * (0.5f * actb * (1.f + erff(actb * 0.70710678118654752f))) * vsb;
    f32x2 o[8];
#pragma unroll
    for (int k = 0; k < 8; ++k) o[k] = (f32x2){0.f, 0.f};
    for (int g = 0; g < 16; ++g) {
        const int esel = g < 8 ? ea : eb; const float hsel = g < 8 ? hida : hidb;
        u32x4 vw[8]; float hk[8];
#pragma unroll
        for (int i = 0; i < 8; ++i) { const int ek = __shfl(esel, (g * 8 + i) & 63); hk[i] = __shfl(hsel, (g * 8 + i) & 63); vw[i] = *(const u32x4*)(V8 + (size_t)ek * DM + lane * 16); }
#pragma unroll
        for (int i = 0; i < 8; ++i) {
            const unsigned wv[4] = {vw[i].x, vw[i].y, vw[i].z, vw[i].w}; const f32x2 h2 = {hk[i], hk[i]};
#pragma unroll
            for (int k = 0; k < 4; ++k) { o[2 * k] = __builtin_amdgcn_cvt_pk_f32_fp8((int)wv[k], false) * h2 + o[2 * k]; o[2 * k + 1] = __builtin_amdgcn_cvt_pk_f32_fp8((int)wv[k], true) * h2 + o[2 * k + 1]; }
        }
    }
    const float* hs = hsrc + (size_t)t * DM + lane * 16; float* hp = hdst + (size_t)t * DM + lane * 16;
#pragma unroll
    for (int k = 0; k < 4; ++k) { f32x4 hv = *(const f32x4*)(hs + 4 * k); hv.x += o[2 * k].x; hv.y += o[2 * k].y; hv.z += o[2 * k + 1].x; hv.w += o[2 * k + 1].y; *(f32x4*)(hp + 4 * k) = hv; }
}

#ifndef PHMASK
#define PHMASK 0xFFFF
#endif
#define EN(n) if constexpr (((PHMASK) >> (n)) & 1)
#ifndef PROBE_DUP
#define PROBE_DUP -1
#endif
constexpr int PH_PER_LAYER = 12, NPH = 2 + DEPTH * PH_PER_LAYER;

__global__ void __launch_bounds__(NTHR, 2) hybrid_fwd(Args args) {
    extern __shared__ __attribute__((aligned(16))) unsigned char lds[];
    unsigned char* ws = args.ws;
    bf16* proj = (bf16*)(ws + WS_A); float* sc = (float*)(ws + WS_A);
    bf16* xn = (bf16*)(ws + WS_XN);
    bf16* ocat = (bf16*)(ws + WS_C); int* eids = (int*)(ws + WS_C); float* gates = (float*)(ws + WS_C + 16 * MiB); bf16* pw = (bf16*)(ws + WS_C);
    float* kvt = (float*)(ws + WS_D); unsigned char* u8 = ws + WS_D; unsigned char* v8 = ws + WS_D + 16 * MiB; float* usc = (float*)(ws + WS_D + 32 * MiB); float* vsc = (float*)(ws + WS_D + 33 * MiB);
    bf16* pb = (bf16*)(ws + WS_PB); float* dec = (float*)(ws + WS_DEC);
    cg::grid_group grid = cg::this_grid();
    PG8_LAS unsigned char* gl = (PG8_LAS unsigned char*)lds;

    for (int ph = args.ph_lo, rep = 0; ph < args.ph_hi;) {
        int tid_ = threadIdx.x; asm volatile("" : "+v"(tid_));
    Frame F;
        F.lds = lds; F.tid = tid_; F.lane = F.tid & 63; F.wave = __builtin_amdgcn_readfirstlane(F.tid >> 6); F.G = gridDim.x; F.bid = blockIdx.x;
        F.x = args.in[0]; F.p = args.in[1]; F.norm_mix = args.in[2]; F.w_in = args.in[3]; F.g_w2 = args.in[4]; F.g_b = args.in[5]; F.head_norm = args.in[6]; F.rel_bias = args.in[7]; F.w_out = args.in[8];
        F.norm_ffn = args.in[9]; F.peer_wq = args.in[10]; F.peer_sk = args.in[11]; F.peer_u = args.in[12]; F.peer_v = args.in[13]; F.norm_ple = args.in[14]; F.w_ple_gate = args.in[15]; F.w_ple = args.in[16]; F.final_norm = args.in[17];
        F.out = args.out; F.ws = args.ws;
        if (ph == 0) { EN(12) phase_prep(F); }
        else if (ph == NPH - 1) { EN(13) phase_final_norm(F, F.final_norm); }
        else {
            const int l = (ph - 1) / PH_PER_LAYER, sp = (ph - 1) % PH_PER_LAYER;
            const pg8::bf16_t* wl = (const pg8::bf16_t*)(ws + WS_W + (size_t)l * W_LAYER);
            const float* hsrc = (l == 0) ? F.x : F.out;
            switch (sp) {
            case 0: EN(0) {
                phase_norm(F, hsrc, F.norm_mix + (size_t)l * DM, xn);
                convert_bf16(F, F.p + (size_t)l * NT * 256, pb, (size_t)NT * 256);
            } break;
            case 1: EN(1) {
                pg8::Gemm g{(const pg8::bf16_t*)xn, wl + WO_WIN / 2, NT, PW, DM}; pg8::StaticOrder S; S.init(NT, PW, F.G, F.bid);
                pg8::EpiBf16<0> E{(pg8::bf16_t*)proj, PW, nullptr, 0, 0, 1.f};
                pg8::gemm_phase<pg8::EpiBf16<0>, pg8::StaticOrder, true, true>(gl, g, S, E, F.tid);
            } break;
            case 2: EN(2) {
                for (int u = F.bid; u < NB * 8 * 64; u += F.G) { const int c = ((u & 63) + (u >> 6)) & 63, h = (u >> 6) & 7, b = u >> 9; att_unit(F, l, b, h, c, proj, ocat); }
                for (int u = F.bid; u < NB * 4 * 64; u += F.G) { const int c = u & 63, h = (u >> 6) & 3, b = u >> 8; gla_kv_unit(F, l, b, h, c, proj, kvt, dec); }
            } break;
            case 3: EN(3) { phase_scan(F, kvt, dec); } break;
            case 4: EN(4) {
                for (int u = F.bid; u < NB * 4 * 64; u += F.G) { const int c = u & 63, h = (u >> 6) & 3, b = u >> 8; gla_out_unit(F, l, b, h, c, proj, kvt, ocat); }
            } break;
            case 5: EN(5) {
                pg8::Gemm g{(const pg8::bf16_t*)ocat, wl + WO_WOUT / 2, NT, DM, DM}; pg8::StaticOrder S; S.init(NT, DM, F.G, F.bid);
                pg8::EpiResid E{hsrc, F.out, DM};
                pg8::gemm_phase<pg8::EpiResid, pg8::StaticOrder, true, true>(gl, g, S, E, F.tid);
            } break;
            case 6: EN(6) {
                phase_norm(F, F.out, F.norm_ffn + (size_t)l * DM, xn);
                convert_rows_fp8(F, F.peer_u + (size_t)l * NEXP * DM, u8, usc, false);
                convert_rows_fp8(F, F.peer_v + (size_t)l * NEXP * DM, v8, vsc, false);
            } break;
            case 7: EN(7) {
                pg8::Gemm g{(const pg8::bf16_t*)xn, wl + WO_WQ2 / 2, NT, 2048, DM}; pg8::StaticOrder S; S.init(NT, 2048, F.G, F.bid);
                pg8::EpiF32Store E{sc, 2048};
                pg8::gemm_phase<pg8::EpiF32Store, pg8::StaticOrder, true, true>(gl, g, S, E, F.tid);
            } break;
            case 8: EN(8) { for (int tl = F.bid; tl < NT / 16; tl += F.G) topk_tile(F, tl, sc, eids, gates); } break;
            case 9: EN(9) { for (int t = F.bid * NWAVES + F.wave; t < NT; t += F.G * NWAVES) peer_token(F, t, xn, eids, gates, u8, usc, v8, vsc, F.out, rep ? (float*)(ws + WS_A) : F.out); } break;
            case 10: EN(10) {
                phase_norm(F, F.out, F.norm_ple + (size_t)l * DM, xn);
                pg8::Gemm g{(const pg8::bf16_t*)pb, wl + WO_WP / 2, NT, DM, 256}; pg8::StaticOrder S; S.init(NT, DM, F.G, F.bid);
                pg8::EpiBf16<0> E{(pg8::bf16_t*)pw, DM, nullptr, 0, 0, 1.f};
                pg8::gemm_phase<pg8::EpiBf16<0>, pg8::StaticOrder, true, true>(gl, g, S, E, F.tid);
            } break;
            case 11: EN(11) {
                pg8::Gemm g{(const pg8::bf16_t*)xn, wl + WO_WG / 2, NT, DM, DM}; pg8::StaticOrder S; S.init(NT, DM, F.G, F.bid);
                pg8::EpiPle E{F.out, F.out, (const pg8::bf16_t*)pw, DM};
                pg8::gemm_phase<pg8::EpiPle, pg8::StaticOrder, true, true>(gl, g, S, E, F.tid);
            } break;
            }
        }
        bool adv = true;
        if (PROBE_DUP >= 0 && ph > 0 && ph < NPH - 1 && (ph - 1) % PH_PER_LAYER == PROBE_DUP && rep == 0) { rep = 1; adv = false; }
        if (adv) { rep = 0; ++ph; }
        if (ph < args.ph_hi) grid.sync();
    }
}

extern "C" void kernel_launch(void* const* d_in, const int* in_sizes, int n_in, void* d_out, int out_size, void* d_ws, size_t ws_size, hipStream_t stream) {
    static int grid = 0;
    if (grid == 0) {
        if (n_in != 18 || in_sizes[0] != NT * DM || out_size != NT * DM || ws_size < WS_END) { fprintf(stderr, "kernel_launch: unexpected shapes (n_in %d, in0 %d, out %d, ws %zu); nothing launched\n", n_in, n_in > 0 ? in_sizes[0] : -1, out_size, ws_size); grid = -1; return; }
        int dev = 0, cus = 0, per_cu = 0;
        if (hipGetDevice(&dev) != hipSuccess || hipDeviceGetAttribute(&cus, hipDeviceAttributeMultiprocessorCount, dev) != hipSuccess) { fprintf(stderr, "kernel_launch: device query failed\n"); grid = -1; return; }
        if (hipFuncSetAttribute((const void*)hybrid_fwd, hipFuncAttributeMaxDynamicSharedMemorySize, LDS_BYTES) != hipSuccess) { fprintf(stderr, "kernel_launch: hipFuncSetAttribute failed\n"); grid = -1; return; }
        if (hipOccupancyMaxActiveBlocksPerMultiprocessor(&per_cu, (const void*)hybrid_fwd, NTHR, LDS_BYTES) != hipSuccess || per_cu < 1) { fprintf(stderr, "kernel_launch: occupancy query says %d blocks per CU\n", per_cu); (void)hipGetLastError(); grid = -1; return; }
        grid = cus * 1;
    }
    if (grid < 0) return;
    Args a{};
    for (int i = 0; i < 18; ++i) a.in[i] = (const float*)d_in[i];
    a.out = (float*)d_out; a.ws = (unsigned char*)d_ws;
#if MK_N_LAUNCHES == 1
    a.ph_lo = 0; a.ph_hi = NPH;
    void* kargs[] = {&a};
    hipError_t e = hipLaunchCooperativeKernel((const void*)hybrid_fwd, dim3(grid), dim3(NTHR), kargs, LDS_BYTES, stream);
    if (e != hipSuccess) fprintf(stderr, "kernel_launch: cooperative launch failed: %s (grid %d)\n", hipGetErrorString(e), grid);
#else
    for (int ph = 0; ph < NPH; ++ph) { a.ph_lo = ph; a.ph_hi = ph + 1; hipLaunchKernelGGL(hybrid_fwd, dim3(grid), dim3(NTHR), LDS_BYTES, stream, a); }
#endif
}
```

```cpp
#include <hip/hip_runtime.h>
#include <hip/hip_cooperative_groups.h>
#include <cstdio>
#include <cstdint>
namespace cg = cooperative_groups;
#define MK_N_LAUNCHES 1
namespace pg8 {
#define PG8_LAS __attribute__((address_space(3)))
typedef unsigned short bf16_t;
typedef short bf16x8 __attribute__((ext_vector_type(8)));
typedef float f32x4 __attribute__((ext_vector_type(4)));
typedef unsigned u32x4 __attribute__((ext_vector_type(4)));
constexpr int BM = 256, BK = 64, HALF = 128, HTB = HALF * BK * 2  , STAGE_BYTES = 8 * HTB, NXCD = 8, WGM = 8;

__host__ __device__ __forceinline__ int lds_byte(int r, int c) { const int st = (r >> 4) * 2 + (c >> 5), rr = r & 15, cc = c & 31, ob = rr * 64 + cc * 2; return st * 1024 + (ob ^ (((ob >> 9) & 1) << 5)); }
__host__ __device__ __forceinline__ void stage_rc(int b, int& R, int& C) { const int st = b / 1024, sb = b % 1024, swz = sb ^ (((sb >> 9) & 1) << 5); R = (st >> 1) * 16 + swz / 64; C = (st & 1) * 32 + (swz % 64) / 2; }
__host__ __device__ __forceinline__ int perm32(int rho) { const int n = rho >> 4, i = rho & 15; return 8 * (i >> 2) + 4 * n + (i & 3); }

struct Unit { int pm, pn; };
struct Gemm { const bf16_t* A; const bf16_t* Bt; int M, N, K; };

struct StaticOrder {
    int nM, nN, nwg, G, c;
    __host__ __device__ void init(int M, int N, int G_, int c_) { nM = M / BM; nN = N / BM; nwg = nM * nN; G = G_; c = c_; }
    __host__ __device__ bool next(int i, Unit& u) const {
        const long L = (long)i * G + c; if (L >= nwg) return false;
        int wgid = (int)L; { const int q = nwg / NXCD, r = nwg % NXCD, xcd = wgid % NXCD, off = wgid / NXCD; wgid = (xcd < r ? xcd * (q + 1) : r * (q + 1) + (xcd - r) * q) + off; }
        const int nig = WGM * nN, gid = wgid / nig, fm = gid * WGM, gsz = (nM - fm) < WGM ? (nM - fm) : WGM;
        u.pm = fm + ((wgid % nig) % gsz); u.pn = (wgid % nig) / gsz; return true;
    }
    __device__ __forceinline__ void a_ready(const Unit&) const {}
    __device__ __forceinline__ void done(const Unit&) const {}
};

__device__ __forceinline__ unsigned cvt_pk_bf16(float lo, float hi) { unsigned r; asm volatile("v_cvt_pk_bf16_f32 %0, %1, %2" : "=v"(r) : "v"(lo), "v"(hi)); return r; }
typedef float f32x2 __attribute__((ext_vector_type(2)));
__device__ __forceinline__ f32x2 gelu_pk(f32x2 v) {
    const f32x2 av = __builtin_elementwise_abs(v), d = av * 0.2316418882f + 1.0f;
    f32x2 t; t.x = __builtin_amdgcn_rcpf(d.x); t.y = __builtin_amdgcn_rcpf(d.y);
    f32x2 q = t * 0.5307027145f + (-0.7265760135f); q = q * t + 0.7107068705f; q = q * t + (-0.142248368f); q = q * t + 0.127414796f; q = q * t;
    const f32x2 s = (v * v) * (-0.72134752044f);
    f32x2 e; e.x = __builtin_amdgcn_exp2f(s.x); e.y = __builtin_amdgcn_exp2f(s.y);
    const f32x2 m = v * (q * e), r = v - m;
    f32x2 o; o.x = v.x < 0.f ? m.x : r.x; o.y = v.y < 0.f ? m.y : r.y; return o;
}

template <int ACT  > struct EpiBf16 {
    static constexpr bool PERM = true, AFTER_DRAIN = false; static_assert(ACT == 0 || ACT == 1, "EpiBf16: ACT is 0 (none) or 1 (gelu_pk)");
    bf16_t* O; int ldc; const float* bias; int split_cols; size_t split_stride; float scale0;
    __device__ __forceinline__ void operator()(const f32x4 (&acc)[2][2][4][2], const Unit& u, int wr, int wc, int fr, int fq) const {
        const int row0 = u.pm * BM + wr * 64 + fr; int colt = u.pn * BM; bf16_t* base = O;
        float sc = 1.f; if (split_cols) { const int t = colt / split_cols; base += (size_t)t * split_stride; colt -= t * split_cols; if (t == 0) sc = scale0; }
        const int col0 = colt + wc * 32 + 8 * fq, bcol0 = u.pn * BM + wc * 32 + 8 * fq;
        f32x4 bv[2][2];
#pragma unroll
        for (int bj = 0; bj < 2; ++bj)
#pragma unroll
            for (int n = 0; n < 2; ++n) bv[bj][n] = bias ? *(const f32x4*)(bias + bcol0 + bj * HALF + 4 * n) : (f32x4){0.f, 0.f, 0.f, 0.f};
#pragma unroll
        for (int ai = 0; ai < 2; ++ai)
#pragma unroll
            for (int m = 0; m < 4; ++m) { bf16_t* rowp = base + (size_t)(row0 + ai * HALF + m * 16) * ldc + col0;
#pragma unroll
                for (int bj = 0; bj < 2; ++bj) { f32x4 v0 = acc[ai][bj][m][0] + bv[bj][0], v1 = acc[ai][bj][m][1] + bv[bj][1];
                    if (ACT == 1) { f32x2 a = gelu_pk((f32x2){v0[0], v0[1]}), b = gelu_pk((f32x2){v0[2], v0[3]}), c = gelu_pk((f32x2){v1[0], v1[1]}), d = gelu_pk((f32x2){v1[2], v1[3]});
                        v0 = (f32x4){a.x, a.y, b.x, b.y}; v1 = (f32x4){c.x, c.y, d.x, d.y}; }
                    v0 = v0 * sc; v1 = v1 * sc; u32x4 w; w.x = cvt_pk_bf16(v0[0], v0[1]); w.y = cvt_pk_bf16(v0[2], v0[3]); w.z = cvt_pk_bf16(v1[0], v1[1]); w.w = cvt_pk_bf16(v1[2], v1[3]);
                    *(u32x4*)(rowp + bj * HALF) = w; } }
    }
};

struct EpiF32Store {
    static constexpr bool PERM = false, AFTER_DRAIN = false;
    float* C; int ldc;
    __device__ __forceinline__ void operator()(const f32x4 (&acc)[2][2][4][2], const Unit& u, int wr, int wc, int fr, int fq) const {
        const int row0 = u.pm * BM + wr * 64 + fr, col0 = u.pn * BM + wc * 32 + 4 * fq;
#pragma unroll
        for (int ai = 0; ai < 2; ++ai)
#pragma unroll
            for (int m = 0; m < 4; ++m) { float* rowp = C + (size_t)(row0 + ai * HALF + m * 16) * ldc + col0;
#pragma unroll
                for (int bj = 0; bj < 2; ++bj)
#pragma unroll
                    for (int n = 0; n < 2; ++n) *(f32x4*)(rowp + bj * HALF + n * 16) = acc[ai][bj][m][n]; }
    }
};
struct EpiResid {
    static constexpr bool PERM = false, AFTER_DRAIN = false;
    const float* base; float* out; int ldc;
    __device__ __forceinline__ void operator()(const f32x4 (&acc)[2][2][4][2], const Unit& u, int wr, int wc, int fr, int fq) const {
        const int row0 = u.pm * BM + wr * 64 + fr, col0 = u.pn * BM + wc * 32 + 4 * fq;
#pragma unroll
        for (int ai = 0; ai < 2; ++ai)
#pragma unroll
            for (int m = 0; m < 4; ++m) { const size_t off = (size_t)(row0 + ai * HALF + m * 16) * ldc + col0;
                f32x4 bs[2][2];
#pragma unroll
                for (int bj = 0; bj < 2; ++bj)
#pragma unroll
                    for (int n = 0; n < 2; ++n) bs[bj][n] = *(const f32x4*)(base + off + bj * HALF + n * 16);
#pragma unroll
                for (int bj = 0; bj < 2; ++bj)
#pragma unroll
                    for (int n = 0; n < 2; ++n) *(f32x4*)(out + off + bj * HALF + n * 16) = bs[bj][n] + acc[ai][bj][m][n];
                asm volatile("" ::: "memory"); }
    }
};
struct EpiPle {
    static constexpr bool PERM = false, AFTER_DRAIN = false;
    const float* base; float* out; const bf16_t* pw; int ldc;
    __device__ __forceinline__ void operator()(const f32x4 (&acc)[2][2][4][2], const Unit& u, int wr, int wc, int fr, int fq) const {
        typedef unsigned u32x2v __attribute__((ext_vector_type(2)));
        const int row0 = u.pm * BM + wr * 64 + fr, col0 = u.pn * BM + wc * 32 + 4 * fq;
#pragma unroll
        for (int ai = 0; ai < 2; ++ai)
#pragma unroll
            for (int m = 0; m < 4; ++m) { const size_t off = (size_t)(row0 + ai * HALF + m * 16) * ldc + col0;
                f32x4 bs[2][2]; u32x2v pv[2][2];
#pragma unroll
                for (int bj = 0; bj < 2; ++bj)
#pragma unroll
                    for (int n = 0; n < 2; ++n) { bs[bj][n] = *(const f32x4*)(base + off + bj * HALF + n * 16); pv[bj][n] = *(const u32x2v*)(pw + off + bj * HALF + n * 16); }
#pragma unroll
                for (int bj = 0; bj < 2; ++bj)
#pragma unroll
                    for (int n = 0; n < 2; ++n) { const f32x4 a = acc[ai][bj][m][n]; f32x4 o;
                        const float p0 = __uint_as_float(pv[bj][n].x << 16), p1 = __uint_as_float(pv[bj][n].x & 0xffff0000u), p2 = __uint_as_float(pv[bj][n].y << 16), p3 = __uint_as_float(pv[bj][n].y & 0xffff0000u);
                        o[0] = bs[bj][n][0] + p0 / (1.0f + __expf(-a[0])); o[1] = bs[bj][n][1] + p1 / (1.0f + __expf(-a[1]));
                        o[2] = bs[bj][n][2] + p2 / (1.0f + __expf(-a[2])); o[3] = bs[bj][n][3] + p3 / (1.0f + __expf(-a[3]));
                        *(f32x4*)(out + off + bj * HALF + n * 16) = o; }
                asm volatile("" ::: "memory"); }
    }
};
template <class Epi, class Sched, bool ALIGN_EPI = false, bool SP2 = false>
__device__ __forceinline__ void gemm_phase(PG8_LAS unsigned char* lds, const Gemm g, const Sched& S, const Epi& E, const int tid_in) {
    const int tid = tid_in, wid = __builtin_amdgcn_readfirstlane(tid >> 6), lane = tid & 63, wr = wid >> 2, wc = wid & 3, fr = lane & 15, fq = lane >> 4;
    const int K = g.K, nt = K / BK;
    unsigned voffA[2], voffB[2];
#pragma unroll
    for (int i = 0; i < 2; ++i) { int R, C; stage_rc(tid * 16 + i * 8192, R, C); const int Rb = Epi::PERM ? ((R & ~31) + perm32(R & 31)) : R;
        voffA[i] = (unsigned)(R * K + C) * 2u; voffB[i] = (unsigned)(Rb * K + C) * 2u; }
    const size_t kstep = (size_t)(BK * 2);
    const size_t hstep = (size_t)HALF * K * 2;
    const size_t tstep = 2 * hstep;
    const unsigned ldsw = (unsigned)wid * 1024u;
    const int aoff = lds_byte(wr * 64 + fr, fq * 8), boff = lds_byte(wc * 32 + fr, fq * 8);
#define PG8_SA(b, h) (((b) * 2 + (h)) * HTB)
#define PG8_SB(b, h) ((4 + (b) * 2 + (h)) * HTB)
#define PG8_STAGE(bufoff, gbase, voff) do { _Pragma("unroll") for (int _i = 0; _i < 2; ++_i) \
        __builtin_amdgcn_global_load_lds((const unsigned*)((const char*)(gbase) + (voff)[_i]), (PG8_LAS unsigned*)(lds + (bufoff) + ldsw + _i * 8192), 16, 0, 0); } while (0)
#define PG8_LDA(dst, b, h) do { _Pragma("unroll") for (int m = 0; m < 4; ++m) _Pragma("unroll") for (int k = 0; k < 2; ++k) dst[m][k] = *(const PG8_LAS bf16x8*)(lds + PG8_SA(b, h) + aoff + m * 2048 + k * 1024); } while (0)
#define PG8_LDB(dst, b, h) do { _Pragma("unroll") for (int n = 0; n < 2; ++n) _Pragma("unroll") for (int k = 0; k < 2; ++k) dst[n][k] = *(const PG8_LAS bf16x8*)(lds + PG8_SB(b, h) + boff + n * 2048 + k * 1024); } while (0)
#define PG8_MMA(ai, bj, At, Bt) do { __builtin_amdgcn_s_setprio(1); _Pragma("unroll") for (int m = 0; m < 4; ++m) _Pragma("unroll") for (int n = 0; n < 2; ++n) _Pragma("unroll") for (int k = 0; k < 2; ++k) \
        acc[ai][bj][m][n] = __builtin_amdgcn_mfma_f32_16x16x32_bf16(Bt[n][k], At[m][k], acc[ai][bj][m][n], 0, 0, 0); __builtin_amdgcn_s_setprio(0); } while (0)
#define PG8_WAIT_V(n) asm volatile("s_waitcnt vmcnt(" #n ")" ::: "memory")
#define PG8_WAIT_L(n) asm volatile("s_waitcnt lgkmcnt(" #n ")" ::: "memory")
#define PG8_BAR __builtin_amdgcn_s_barrier()
#define PG8_SCHED __builtin_amdgcn_sched_barrier(0)
    Unit cur, nxt; int ui = 0;
    if (!S.next(0, cur)) return;
    f32x4 acc[2][2][4][2];
#pragma unroll
    for (int a = 0; a < 2; ++a)
#pragma unroll
        for (int b = 0; b < 2; ++b)
#pragma unroll
            for (int m = 0; m < 4; ++m)
#pragma unroll
                for (int n = 0; n < 2; ++n) acc[a][b][m][n] = (f32x4){0.f, 0.f, 0.f, 0.f};
    bf16x8 At[4][2], B0[2][2], B1[2][2];
    const char* cA = (const char*)g.A + (size_t)cur.pm * tstep; const char* cB = (const char*)g.Bt + (size_t)cur.pn * tstep;
    S.a_ready(cur);
    if constexpr (SP2) {
        PG8_STAGE(PG8_SB(0, 0), cB, voffB); PG8_STAGE(PG8_SB(0, 1), cB + hstep, voffB); PG8_STAGE(PG8_SA(0, 0), cA, voffA); PG8_STAGE(PG8_SA(0, 1), cA + hstep, voffA);
        if (wr == 1) PG8_BAR;
        PG8_WAIT_V(2); PG8_BAR;
        PG8_STAGE(PG8_SB(1, 0), cB + kstep, voffB); PG8_STAGE(PG8_SA(1, 0), cA + kstep, voffA); PG8_STAGE(PG8_SB(1, 1), cB + hstep + kstep, voffB);
        PG8_WAIT_V(6); PG8_BAR;
    } else {
        PG8_STAGE(PG8_SB(0, 0), cB, voffB); PG8_STAGE(PG8_SA(0, 0), cA, voffA); PG8_STAGE(PG8_SB(0, 1), cB + hstep, voffB); PG8_STAGE(PG8_SA(0, 1), cA + hstep, voffA);
        if (wr == 1) PG8_BAR;
        PG8_WAIT_V(4); PG8_BAR;
        PG8_STAGE(PG8_SB(1, 0), cB + kstep, voffB); PG8_STAGE(PG8_SA(1, 0), cA + kstep, voffA); PG8_STAGE(PG8_SB(1, 1), cB + hstep + kstep, voffB);
        PG8_WAIT_V(6); PG8_BAR;
    }
    for (;;) {
        const bool has_next = S.next(ui + 1, nxt);
        const char* nA = has_next ? (const char*)g.A + (size_t)nxt.pm * tstep : cA; const char* nB = has_next ? (const char*)g.Bt + (size_t)nxt.pn * tstep : cB;
        for (int t = 0; t < nt; t += 2) {
            const bool last = (t == nt - 2);
            const char* a1 = cA + (size_t)(t + 1) * kstep;
            const char* a2 = last ? nA : cA + (size_t)(t + 2) * kstep; const char* b2 = last ? nB : cB + (size_t)(t + 2) * kstep;
            const char* a3 = a2 + kstep; const char* b3 = b2 + kstep;
            if (last && has_next) S.a_ready(nxt);
            if constexpr (SP2) {
            PG8_LDB(B0, 0, 0); PG8_LDB(B1, 0, 1); PG8_SCHED; PG8_LDA(At, 0, 0); PG8_STAGE(PG8_SA(1, 1), a1 + hstep, voffA);
            PG8_WAIT_V(8); PG8_WAIT_L(0); PG8_BAR; PG8_MMA(0, 0, At, B0); PG8_MMA(0, 1, At, B1); PG8_BAR; PG8_SCHED;
            PG8_LDA(At, 0, 1); PG8_STAGE(PG8_SB(0, 0), b2, voffB); PG8_STAGE(PG8_SB(0, 1), b2 + hstep, voffB); PG8_STAGE(PG8_SA(0, 0), a2, voffA);
            PG8_WAIT_V(8); PG8_WAIT_L(0); PG8_BAR; PG8_MMA(1, 0, At, B0); PG8_MMA(1, 1, At, B1); PG8_BAR; PG8_SCHED;
            PG8_LDB(B0, 1, 0); PG8_LDB(B1, 1, 1); PG8_SCHED; PG8_LDA(At, 1, 0); PG8_STAGE(PG8_SA(0, 1), a2 + hstep, voffA);
            PG8_WAIT_V(8); PG8_WAIT_L(0); PG8_BAR; PG8_MMA(0, 0, At, B0); PG8_MMA(0, 1, At, B1); PG8_BAR; PG8_SCHED;
            PG8_LDA(At, 1, 1); PG8_STAGE(PG8_SB(1, 0), b3, voffB); PG8_STAGE(PG8_SB(1, 1), b3 + hstep, voffB); PG8_STAGE(PG8_SA(1, 0), a3, voffA);
            PG8_WAIT_V(8); PG8_WAIT_L(0); PG8_BAR; PG8_MMA(1, 0, At, B0); PG8_MMA(1, 1, At, B1); PG8_BAR; PG8_SCHED;
            } else {
            PG8_LDB(B0, 0, 0); PG8_SCHED; PG8_LDA(At, 0, 0); PG8_STAGE(PG8_SA(1, 1), a1 + hstep, voffA);
            PG8_WAIT_L(8); PG8_BAR; PG8_WAIT_L(0); PG8_MMA(0, 0, At, B0); PG8_BAR; PG8_SCHED;
            PG8_LDB(B1, 0, 1); PG8_STAGE(PG8_SB(0, 0), b2, voffB);
            PG8_BAR; PG8_WAIT_L(0); PG8_MMA(0, 1, At, B1); PG8_BAR;
            PG8_LDA(At, 0, 1); PG8_STAGE(PG8_SA(0, 0), a2, voffA);
            PG8_BAR; PG8_WAIT_L(0); PG8_MMA(1, 0, At, B0); PG8_BAR; PG8_SCHED;
            PG8_STAGE(PG8_SB(0, 1), b2 + hstep, voffB);
            PG8_WAIT_V(6); PG8_BAR; PG8_MMA(1, 1, At, B1); PG8_BAR;
            PG8_LDB(B0, 1, 0); PG8_SCHED; PG8_LDA(At, 1, 0); PG8_STAGE(PG8_SA(0, 1), a2 + hstep, voffA);
            PG8_WAIT_L(8); PG8_BAR; PG8_WAIT_L(0); PG8_MMA(0, 0, At, B0); PG8_BAR; PG8_SCHED;
            PG8_LDB(B1, 1, 1); PG8_STAGE(PG8_SB(1, 0), b3, voffB);
            PG8_BAR; PG8_WAIT_L(0); PG8_MMA(0, 1, At, B1); PG8_BAR;
            PG8_LDA(At, 1, 1); PG8_STAGE(PG8_SA(1, 0), a3, voffA);
            PG8_BAR; PG8_WAIT_L(0); PG8_MMA(1, 0, At, B0); PG8_BAR; PG8_SCHED;
            PG8_STAGE(PG8_SB(1, 1), b3 + hstep, voffB);
            PG8_WAIT_V(6); PG8_BAR; PG8_MMA(1, 1, At, B1); PG8_BAR;
            }
        }
        if constexpr (ALIGN_EPI) { if (wr == 0) PG8_BAR; }
        if constexpr (!Epi::AFTER_DRAIN) { E(acc, cur, wr, wc, fr, fq); S.done(cur); }
        if (!has_next) break;
#pragma unroll
        for (int a = 0; a < 2; ++a)
#pragma unroll
            for (int b = 0; b < 2; ++b)
#pragma unroll
                for (int m = 0; m < 4; ++m)
#pragma unroll
                    for (int n = 0; n < 2; ++n) acc[a][b][m][n] = (f32x4){0.f, 0.f, 0.f, 0.f};
        cur = nxt; cA = nA; cB = nB; ++ui;
        if constexpr (ALIGN_EPI) { if (wr == 1) PG8_BAR; }
    }
    PG8_WAIT_V(0);
    if constexpr (!ALIGN_EPI) { if (wr == 0) PG8_BAR; }
    PG8_BAR;
    if constexpr (Epi::AFTER_DRAIN) { E.fused(acc, cur, wr, wc, fr, fq, lds, wid, lane); S.done(cur); }
#undef PG8_SA
#undef PG8_SB
#undef PG8_STAGE
#undef PG8_LDA
#undef PG8_LDB
#undef PG8_MMA
#undef PG8_WAIT_V
#undef PG8_WAIT_L
#undef PG8_BAR
#undef PG8_SCHED
}
}

#ifndef MK_N_LAUNCHES
#define MK_N_LAUNCHES 1
#endif
constexpr int NB = 8, SEQ = 4096, DM = 1024, DEPTH = 2, NT = NB * SEQ;
constexpr int PW = 3328;
constexpr int C_GQ = 0, C_GK = 256, C_GV = 512, C_GOG = 1024, C_AQ = 1536, C_AK = 2048, C_AV = 2560, C_GLR = 3072;
constexpr int IN_W = 3088, NEXP = 16384;
constexpr float RMS_EPS = 1e-6f;
constexpr int NWAVES = 8, NTHR = 512;
constexpr int LDS_BYTES = 147456;

constexpr size_t MiB = 1u << 20;
constexpr size_t WS_W = 1 * MiB, W_LAYER = 15 * MiB;
constexpr size_t WO_WIN = 0, WO_WOUT = 6656 * 1024, WO_WQ2 = WO_WOUT + 2 * MiB, WO_WG = WO_WQ2 + 4 * MiB, WO_WP = WO_WG + 2 * MiB;
static_assert(WO_WP + 512 * 1024 <= W_LAYER, "weights per layer");
constexpr size_t WS_A = 32 * MiB;
constexpr size_t WS_XN = 288 * MiB;
constexpr size_t WS_C = 352 * MiB;
constexpr size_t WS_D = 416 * MiB;
constexpr size_t WS_PB = 480 * MiB;
constexpr size_t WS_DEC = 496 * MiB;
constexpr size_t WS_END = 497 * MiB;

#define DI __device__ __forceinline__
typedef unsigned short bf16;
typedef short bf16x8 __attribute__((ext_vector_type(8)));
typedef float f32x4 __attribute__((ext_vector_type(4)));
typedef float f32x16 __attribute__((ext_vector_type(16)));
typedef unsigned u32x4 __attribute__((ext_vector_type(4)));
typedef unsigned u32x2 __attribute__((ext_vector_type(2)));
#define MFMA32(a, b, c) __builtin_amdgcn_mfma_f32_32x32x16_bf16((a), (b), (c), 0, 0, 0)
DI float bf2f(unsigned v) { return __uint_as_float(v << 16); }
DI unsigned f2bf(float f) { unsigned u = __float_as_uint(f); return (u + 0x7fffu + ((u >> 16) & 1u)) >> 16; }
DI unsigned pk2(float lo, float hi) { return f2bf(lo) | (f2bf(hi) << 16); }
DI int crow(int reg, int h) { return (reg & 3) + 8 * (reg >> 2) + 4 * h; }
DI float wave_sum(float v) {
#pragma unroll
    for (int o = 1; o < 64; o <<= 1) v += __shfl_xor(v, o);
    return v;
}
DI bf16x8 pack8(const f32x16& x, int s) {
    u32x4 p; p.x = pk2(x[8 * s + 0], x[8 * s + 1]); p.y = pk2(x[8 * s + 2], x[8 * s + 3]); p.z = pk2(x[8 * s + 4], x[8 * s + 5]); p.w = pk2(x[8 * s + 6], x[8 * s + 7]);
    return __builtin_bit_cast(bf16x8, p);
}

struct Args { const float* in[18]; float* out; unsigned char* ws; int ph_lo, ph_hi; };
struct Frame {
    unsigned char* lds; int tid, lane, wave, G, bid;
    const float *x, *p, *norm_mix, *w_in, *g_w2, *g_b, *head_norm, *rel_bias, *w_out, *norm_ffn, *peer_wq, *peer_sk, *peer_u, *peer_v, *norm_ple, *w_ple_gate, *w_ple, *final_norm;
    float* out; unsigned char* ws;
};

DI void win_map(int n, int& src, float& sc) {
    sc = 1.f;
    if (n < 256) { src = n; sc = 0.125f; }
    else if (n < 1024) src = n;
    else if (n < 1536) src = n + 16;
    else if (n < 2048) { src = n + 16; sc = 0.125f; }
    else if (n < 3072) src = n + 16;
    else if (n < 3088) src = n - 3072 + 1024;
    else src = -1;
}
DI void transpose_item(const float* W, int N, int K, bf16* WT, int n0, int k0, bool winmap, float* tile, int tid) {
    const int nl = tid & 63, kq = tid >> 6;
    int src = n0 + nl; float sc = 1.f;
    if (winmap) win_map(n0 + nl, src, sc);
#pragma unroll
    for (int kk = 0; kk < 8; ++kk) { const int k = kq * 8 + kk; tile[k * 65 + nl] = src >= 0 ? W[(size_t)(k0 + k) * N + src] * sc : 0.f; }
    __syncthreads();
    const int r = tid >> 3, c = tid & 7;
    u32x4 o;
    o.x = pk2(tile[(c * 8 + 0) * 65 + r], tile[(c * 8 + 1) * 65 + r]); o.y = pk2(tile[(c * 8 + 2) * 65 + r], tile[(c * 8 + 3) * 65 + r]);
    o.z = pk2(tile[(c * 8 + 4) * 65 + r], tile[(c * 8 + 5) * 65 + r]); o.w = pk2(tile[(c * 8 + 6) * 65 + r], tile[(c * 8 + 7) * 65 + r]);
    *(u32x4*)(WT + (size_t)(n0 + r) * K + k0 + c * 8) = o;
    __syncthreads();
}
DI void wq2_item(const float* wq, const float* sk, bf16* WT, int hp, int k0, float* lds, int tid) {
    float* s_sk = lds;
    float* s_wq = lds + 128 * 132;
#pragma unroll
    for (int i = 0; i < 8; ++i) { const int idx = tid + i * 512, n = idx >> 5, d4 = idx & 31; *(f32x4*)(s_sk + n * 132 + d4 * 4) = *(const f32x4*)(sk + (size_t)hp * 16384 + n * 128 + d4 * 4); }
#pragma unroll
    for (int i = 0; i < 4; ++i) { const int idx = tid + i * 512, k = idx >> 5, d4 = idx & 31; *(f32x4*)(s_wq + k * 132 + d4 * 4) = *(const f32x4*)(wq + (size_t)(k0 + k) * 2048 + hp * 128 + d4 * 4); }
    __syncthreads();
    const int tn = tid & 31, tk = tid >> 5;
    float acc[4][4];
#pragma unroll
    for (int a = 0; a < 4; ++a)
#pragma unroll
        for (int b = 0; b < 4; ++b) acc[a][b] = 0.f;
    for (int d4 = 0; d4 < 32; ++d4) {
        f32x4 av[4], bv[4];
#pragma unroll
        for (int a = 0; a < 4; ++a) av[a] = *(const f32x4*)(s_sk + (tn * 4 + a) * 132 + d4 * 4);
#pragma unroll
        for (int b = 0; b < 4; ++b) bv[b] = *(const f32x4*)(s_wq + (tk * 4 + b) * 132 + d4 * 4);
#pragma unroll
        for (int a = 0; a < 4; ++a)
#pragma unroll
            for (int b = 0; b < 4; ++b) acc[a][b] += av[a][0] * bv[b][0] + av[a][1] * bv[b][1] + av[a][2] * bv[b][2] + av[a][3] * bv[b][3];
    }
#pragma unroll
    for (int a = 0; a < 4; ++a) { u32x2 o; o.x = pk2(acc[a][0], acc[a][1]); o.y = pk2(acc[a][2], acc[a][3]);
        *(u32x2*)(WT + (size_t)(hp * 128 + tn * 4 + a) * 1024 + k0 + tk * 4) = o; }
    __syncthreads();
}
DI void phase_prep(Frame& F) {
    float* tile = (float*)F.lds;
    constexpr int I_WIN = 832, I_WOUT = 256, I_WG = 256, I_WP = 64, I_WQ2 = 256, I_L = I_WIN + I_WOUT + I_WG + I_WP + I_WQ2;
    for (int it = F.bid; it < DEPTH * I_L; it += F.G) {
        const int l = it / I_L; int r = it % I_L;
        bf16* wl = (bf16*)(F.ws + WS_W + (size_t)l * W_LAYER);
        if (r < I_WIN) { transpose_item(F.w_in + (size_t)l * DM * IN_W, IN_W, DM, wl + WO_WIN / 2, (r >> 4) * 64, (r & 15) * 64, true, tile, F.tid); continue; } r -= I_WIN;
        if (r < I_WOUT) { transpose_item(F.w_out + (size_t)l * DM * DM, DM, DM, wl + WO_WOUT / 2, (r >> 4) * 64, (r & 15) * 64, false, tile, F.tid); continue; } r -= I_WOUT;
        if (r < I_WG) { transpose_item(F.w_ple_gate + (size_t)l * DM * DM, DM, DM, wl + WO_WG / 2, (r >> 4) * 64, (r & 15) * 64, false, tile, F.tid); continue; } r -= I_WG;
        if (r < I_WP) { transpose_item(F.w_ple + (size_t)l * 256 * DM, DM, 256, wl + WO_WP / 2, (r >> 2) * 64, (r & 3) * 64, false, tile, F.tid); continue; } r -= I_WP;
        wq2_item(F.peer_wq + (size_t)l * DM * 2048, F.peer_sk + (size_t)l * 16 * 16384, wl + WO_WQ2 / 2, r >> 4, (r & 15) * 64, tile, F.tid);
    }
}

DI void rms_row_to_bf16(const float* xrow, const float* g, bf16* orow, int lane) {
    const f32x4* xr = (const f32x4*)xrow + lane; const f32x4* gr = (const f32x4*)g + lane;
    f32x4 v[4]; float s = 0.f;
#pragma unroll
    for (int j = 0; j < 4; ++j) { v[j] = xr[64 * j]; s += (v[j].x * v[j].x + v[j].y * v[j].y) + (v[j].z * v[j].z + v[j].w * v[j].w); }
    const float rs = rsqrtf(wave_sum(s) * (1.f / DM) + RMS_EPS);
    u32x2* o8 = (u32x2*)orow + lane;
#pragma unroll
    for (int j = 0; j < 4; ++j) { const f32x4 gg = gr[64 * j]; u32x2 o; o.x = pk2(v[j].x * rs * gg.x, v[j].y * rs * gg.y); o.y = pk2(v[j].z * rs * gg.z, v[j].w * rs * gg.w); o8[64 * j] = o; }
}
DI void phase_norm(Frame& F, const float* src, const float* g, bf16* dst) {
    for (int m = F.bid * NWAVES + F.wave; m < NT; m += F.G * NWAVES) rms_row_to_bf16(src + (size_t)m * DM, g, dst + (size_t)m * DM, F.lane);
}
DI void phase_final_norm(Frame& F, const float* g) {
    for (int m = F.bid * NWAVES + F.wave; m < NT; m += F.G * NWAVES) {
        f32x4* xr = (f32x4*)(F.out + (size_t)m * DM) + F.lane; const f32x4* gr = (const f32x4*)g + F.lane;
        f32x4 v[4]; float s = 0.f;
#pragma unroll
        for (int j = 0; j < 4; ++j) { v[j] = xr[64 * j]; s += (v[j].x * v[j].x + v[j].y * v[j].y) + (v[j].z * v[j].z + v[j].w * v[j].w); }
        const float rs = rsqrtf(wave_sum(s) * (1.f / DM) + RMS_EPS);
#pragma unroll
        for (int j = 0; j < 4; ++j) { const f32x4 gg = gr[64 * j]; xr[64 * j] = v[j] * rs * gg; }
    }
}
DI void convert_bf16(Frame& F, const float* src, bf16* dst, size_t n) {
    const size_t n8 = n >> 3;
    for (size_t i = (size_t)F.bid * NTHR + F.tid; i < n8; i += (size_t)F.G * NTHR) {
        const f32x4 a = ((const f32x4*)src)[2 * i], b = ((const f32x4*)src)[2 * i + 1];
        u32x4 o; o.x = pk2(a.x, a.y); o.y = pk2(a.z, a.w); o.z = pk2(b.x, b.y); o.w = pk2(b.z, b.w);
        ((u32x4*)dst)[i] = o;
    }
}

DI void att_unit(Frame& F, int l, int b, int h, int c, const bf16* proj, bf16* ocat) {
    const int tid = F.tid, lane = F.lane, w = F.wave, r = lane & 31, h2 = lane >> 5, qh = w & 1, kg = w >> 1;
    float* tab = (float*)F.lds;
    float* Ot = (float*)(F.lds + 2048);
    float* ML = (float*)(F.lds + 2048 + 8 * 64 * 33 * 4);
    if (tid < 257) tab[tid] = F.rel_bias[(size_t)l * 8 * 257 + h * 257 + tid];
    __syncthreads();
    const int m0 = b * SEQ + c * 64;
    const bf16* qp = proj + (size_t)(m0 + qh * 32 + r) * PW + C_AQ + h * 64 + h2 * 8;
    bf16x8 qf[4];
#pragma unroll
    for (int s = 0; s < 4; ++s) qf[s] = *(const bf16x8*)(qp + s * 16);
    const int nvc = (c < 8 ? c : 8) + 1, kt0 = 18 - 2 * nvc;
    f32x16 o0, o1;
#pragma unroll
    for (int i = 0; i < 16; ++i) { o0[i] = 0.f; o1[i] = 0.f; }
    float mrun = -1e30f, lrun = 0.f;
    const int iq = qh * 32 + r;
    for (int kt = kt0 + kg; kt < 18; kt += 4) {
        const int krow0 = b * SEQ + (c - 8) * 64 + kt * 32;
        const bf16* kp = proj + (size_t)(krow0 + r) * PW + C_AK + h * 64 + h2 * 8;
        bf16x8 kf[4];
#pragma unroll
        for (int s = 0; s < 4; ++s) kf[s] = *(const bf16x8*)(kp + s * 16);
        const bf16* vp = proj + (size_t)krow0 * PW + C_AV + h * 64 + r;
        bf16x8 vf[2][2];
#pragma unroll
        for (int s = 0; s < 2; ++s)
#pragma unroll
            for (int dt = 0; dt < 2; ++dt)
#pragma unroll
                for (int j = 0; j < 8; ++j) vf[s][dt][j] = (short)vp[(size_t)(16 * s + 8 * (j >> 2) + 4 * h2 + (j & 3)) * PW + dt * 32];
        f32x16 sacc;
#pragma unroll
        for (int i = 0; i < 16; ++i) sacc[i] = 0.f;
#pragma unroll
        for (int s = 0; s < 4; ++s) sacc = MFMA32(kf[s], qf[s], sacc);
        const int jb = kt * 32 + 4 * h2;
        float tmax = -1e30f;
#pragma unroll
        for (int i = 0; i < 16; ++i) { const int j = jb + (i & 3) + 8 * (i >> 2); int rel = iq + 512 - j; rel = rel < -128 ? -128 : (rel > 128 ? 128 : rel);
            sacc[i] += tab[rel + 128]; tmax = fmaxf(tmax, sacc[i]); }
        tmax = fmaxf(tmax, __shfl_xor(tmax, 32));
        const float mnew = fmaxf(mrun, tmax), alpha = __expf(mrun - mnew);
        float psum = 0.f;
#pragma unroll
        for (int i = 0; i < 16; ++i) { const float p = __expf(sacc[i] - mnew); sacc[i] = p; psum += p; }
        lrun = lrun * alpha + psum; mrun = mnew;
#pragma unroll
        for (int i = 0; i < 16; ++i) { o0[i] *= alpha; o1[i] *= alpha; }
#pragma unroll
        for (int s = 0; s < 2; ++s) { const bf16x8 pf = pack8(sacc, s); o0 = MFMA32(vf[s][0], pf, o0); o1 = MFMA32(vf[s][1], pf, o1); }
    }
    lrun += __shfl_xor(lrun, 32);
#pragma unroll
    for (int i = 0; i < 16; ++i) { const int d = crow(i, h2); Ot[(w * 64 + d) * 33 + r] = o0[i]; Ot[(w * 64 + 32 + d) * 33 + r] = o1[i]; }
    if (h2 == 0) { ML[w * 64 + r] = mrun; ML[w * 64 + 32 + r] = lrun; }
    __syncthreads();
    {
        const int q = tid >> 3, dg = tid & 7, qq = q & 31, qhh = q >> 5;
        float mg[4], lg[4], ms = -1e30f;
#pragma unroll
        for (int g = 0; g < 4; ++g) { const int ww = g * 2 + qhh; mg[g] = ML[ww * 64 + qq]; lg[g] = ML[ww * 64 + 32 + qq]; ms = fmaxf(ms, mg[g]); }
        float L = 0.f, wg[4];
#pragma unroll
        for (int g = 0; g < 4; ++g) { wg[g] = __expf(mg[g] - ms); L += wg[g] * lg[g]; }
        const float inv = 1.f / L;
        float ov[8];
#pragma unroll
        for (int dd = 0; dd < 8; ++dd) { float a = 0.f;
#pragma unroll
            for (int g = 0; g < 4; ++g) a += wg[g] * Ot[((g * 2 + qhh) * 64 + dg * 8 + dd) * 33 + qq];
            ov[dd] = a * inv; }
        u32x4 o; o.x = pk2(ov[0], ov[1]); o.y = pk2(ov[2], ov[3]); o.z = pk2(ov[4], ov[5]); o.w = pk2(ov[6], ov[7]);
        *(u32x4*)(ocat + (size_t)(m0 + q) * DM + 512 + h * 64 + dg * 8) = o;
    }
    __syncthreads();
}

constexpr int GL_GLR = 0, GL_W2 = 4096, GL_B2 = 8192, GL_CUM = 8448, GL_TOT = GL_CUM + 16384, GL_VT = GL_TOT + 2048, GL_KS = GL_VT + 128 * 72 * 2, GL_QE = GL_KS + 64 * 72 * 2, GL_KE = GL_QE + 64 * 72 * 2,
              GL_QG = GL_KE + 64 * 72 * 2, GL_OS = GL_QG + 64 * 72 * 2, GL_SSQ = GL_OS + 64 * 132 * 4, GL_END = GL_SSQ + 1024;
static_assert(GL_END <= LDS_BYTES && GL_VT % 16 == 0 && GL_KS % 16 == 0 && GL_QE % 16 == 0 && GL_OS % 16 == 0, "GLA LDS map");
DI float log_sigmoid(float x) { return fminf(x, 0.f) - log1pf(__expf(-fabsf(x))); }
DI void gla_cum(Frame& F, int l, int h, int m0, const bf16* proj) {
    const int tid = F.tid;
    float* Gl = (float*)(F.lds + GL_GLR); float* W2 = (float*)(F.lds + GL_W2); float* B2 = (float*)(F.lds + GL_B2); float* CUM = (float*)(F.lds + GL_CUM); float* TOT = (float*)(F.lds + GL_TOT);
    if (tid < 128) { const int t = tid >> 1, hf = tid & 1; const u32x4 v = *(const u32x4*)(proj + (size_t)(m0 + t) * PW + C_GLR + hf * 8);
        float* g = Gl + t * 16 + hf * 8; g[0] = bf2f(v.x & 0xffffu); g[1] = bf2f(v.x >> 16); g[2] = bf2f(v.y & 0xffffu); g[3] = bf2f(v.y >> 16); g[4] = bf2f(v.z & 0xffffu); g[5] = bf2f(v.z >> 16); g[6] = bf2f(v.w & 0xffffu); g[7] = bf2f(v.w >> 16); }
#pragma unroll
    for (int i = 0; i < 2; ++i) { const int idx = tid + i * 512, rr = idx >> 6, d = idx & 63; W2[idx] = F.g_w2[(size_t)l * 16 * 256 + rr * 256 + h * 64 + d]; }
    if (tid < 64) B2[tid] = F.g_b[(size_t)l * 256 + h * 64 + tid];
    __syncthreads();
    const int d = tid & 63, tq = tid >> 6;
    float w2r[16];
#pragma unroll
    for (int rr = 0; rr < 16; ++rr) w2r[rr] = W2[rr * 64 + d];
    const float bb = B2[d];
    float run = 0.f;
#pragma unroll
    for (int tt = 0; tt < 8; ++tt) { const int t = tq * 8 + tt; float x = bb;
#pragma unroll
        for (int rr = 0; rr < 16; ++rr) x += Gl[t * 16 + rr] * w2r[rr];
        run += log_sigmoid(x) * (1.f / 16.f); CUM[t * 64 + d] = run; }
    TOT[tq * 64 + d] = run;
    __syncthreads();
    float off = 0.f;
    for (int q = 0; q < tq; ++q) off += TOT[q * 64 + d];
#pragma unroll
    for (int tt = 0; tt < 8; ++tt) CUM[(tq * 8 + tt) * 64 + d] += off;
    __syncthreads();
}
DI void gla_stage_vt(Frame& F, int h, int m0, const bf16* proj) {
    const int tid = F.tid, e = tid & 127, cq = tid >> 7;
    bf16* Vt = (bf16*)(F.lds + GL_VT);
    unsigned short v[16];
#pragma unroll
    for (int i = 0; i < 16; ++i) v[i] = proj[(size_t)(m0 + cq * 16 + i) * PW + C_GV + h * 128 + e];
    u32x4 a, b2;
    a.x = v[0] | ((unsigned)v[1] << 16); a.y = v[2] | ((unsigned)v[3] << 16); a.z = v[4] | ((unsigned)v[5] << 16); a.w = v[6] | ((unsigned)v[7] << 16);
    b2.x = v[8] | ((unsigned)v[9] << 16); b2.y = v[10] | ((unsigned)v[11] << 16); b2.z = v[12] | ((unsigned)v[13] << 16); b2.w = v[14] | ((unsigned)v[15] << 16);
    *(u32x4*)(Vt + e * 72 + cq * 16) = a; *(u32x4*)(Vt + e * 72 + cq * 16 + 8) = b2;
}
DI void gla_kv_unit(Frame& F, int l, int b, int h, int c, const bf16* proj, float* KVt, float* dec) {
    const int tid = F.tid, lane = F.lane, w = F.wave, r = lane & 31, h2 = lane >> 5;
    const int m0 = b * SEQ + c * 64, unit = (b * 4 + h) * 64 + c;
    float* CUM = (float*)(F.lds + GL_CUM); bf16* Vt = (bf16*)(F.lds + GL_VT); bf16* Ks = (bf16*)(F.lds + GL_KS);
    gla_cum(F, l, h, m0, proj);
    {
        const int d = tid & 63, tq = tid >> 6; const float last = CUM[63 * 64 + d];
        float kv[8];
#pragma unroll
        for (int tt = 0; tt < 8; ++tt) { const int t = tq * 8 + tt; kv[tt] = bf2f(proj[(size_t)(m0 + t) * PW + C_GK + h * 64 + d]) * __expf(last - CUM[t * 64 + d]); }
        u32x4 o; o.x = pk2(kv[0], kv[1]); o.y = pk2(kv[2], kv[3]); o.z = pk2(kv[4], kv[5]); o.w = pk2(kv[6], kv[7]);
        *(u32x4*)(Ks + d * 72 + tq * 8) = o;
        if (tid < 64) dec[(size_t)unit * 64 + tid] = __expf(last);
    }
    gla_stage_vt(F, h, m0, proj);
    __syncthreads();
    {
        const int et = w >> 1, dt = w & 1;
        f32x16 acc;
#pragma unroll
        for (int i = 0; i < 16; ++i) acc[i] = 0.f;
#pragma unroll
        for (int s = 0; s < 4; ++s) { const bf16x8 a = *(const bf16x8*)(Vt + (et * 32 + r) * 72 + 16 * s + 8 * h2); const bf16x8 bb = *(const bf16x8*)(Ks + (dt * 32 + r) * 72 + 16 * s + 8 * h2); acc = MFMA32(a, bb, acc); }
        float* o = KVt + (size_t)unit * 8192;
#pragma unroll
        for (int i = 0; i < 16; ++i) o[(et * 32 + crow(i, h2)) * 64 + dt * 32 + r] = acc[i];
    }
    __syncthreads();
}
DI void phase_scan(Frame& F, float* KVt, const float* dec) {
    for (int idx = F.bid * NTHR + F.tid; idx < 32 * 8192; idx += F.G * NTHR) {
        const int bh = idx >> 13, ed = idx & 8191, d = ed & 63;
        float* p = KVt + (size_t)bh * 64 * 8192 + ed; const float* dc = dec + (size_t)bh * 64 * 64 + d;
        float S = 0.f;
#pragma unroll 8
        for (int n = 0; n < 64; ++n) { const float kv = p[(size_t)n * 8192], dcy = dc[n * 64]; p[(size_t)n * 8192] = S; S = dcy * S + kv; }
    }
}
DI void gla_out_unit(Frame& F, int l, int b, int h, int c, const bf16* proj, const float* prevT, bf16* ocat) {
    const int tid = F.tid, lane = F.lane, w = F.wave, r = lane & 31, h2 = lane >> 5;
    const int m0 = b * SEQ + c * 64, unit = (b * 4 + h) * 64 + c;
    float* CUM = (float*)(F.lds + GL_CUM); bf16* Vt = (bf16*)(F.lds + GL_VT); bf16* Qe = (bf16*)(F.lds + GL_QE); bf16* Ke = (bf16*)(F.lds + GL_KE); bf16* Qg = (bf16*)(F.lds + GL_QG);
    float* Os = (float*)(F.lds + GL_OS);
    gla_cum(F, l, h, m0, proj);
    {
        const int d = tid & 63, tq = tid >> 6; const float mid = CUM[32 * 64 + d];
#pragma unroll
        for (int tt = 0; tt < 8; ++tt) { const int t = tq * 8 + tt; const float cm = CUM[t * 64 + d];
            const float q = bf2f(proj[(size_t)(m0 + t) * PW + C_GQ + h * 64 + d]), k = bf2f(proj[(size_t)(m0 + t) * PW + C_GK + h * 64 + d]);
            Qe[t * 72 + d] = (bf16)f2bf(q * __expf(cm - mid)); Ke[t * 72 + d] = (bf16)f2bf(k * __expf(mid - cm)); Qg[t * 72 + d] = (bf16)f2bf(q * __expf(cm)); }
    }
    gla_stage_vt(F, h, m0, proj);
    __syncthreads();
    {
        const int et = w >> 1, it = w & 1;
        f32x16 o;
#pragma unroll
        for (int i = 0; i < 16; ++i) o[i] = 0.f;
        const float* pp = prevT + (size_t)unit * 8192 + (et * 32 + r) * 64 + 8 * h2;
#pragma unroll
        for (int s = 0; s < 4; ++s) { const f32x4 p0 = *(const f32x4*)(pp + 16 * s), p1 = *(const f32x4*)(pp + 16 * s + 4);
            u32x4 pa; pa.x = pk2(p0.x, p0.y); pa.y = pk2(p0.z, p0.w); pa.z = pk2(p1.x, p1.y); pa.w = pk2(p1.z, p1.w);
            const bf16x8 bq = *(const bf16x8*)(Qg + (it * 32 + r) * 72 + 16 * s + 8 * h2);
            o = MFMA32(__builtin_bit_cast(bf16x8, pa), bq, o); }
        for (int jt = 0; jt <= it; ++jt) {
            f32x16 X;
#pragma unroll
            for (int i = 0; i < 16; ++i) X[i] = 0.f;
#pragma unroll
            for (int s = 0; s < 4; ++s) { const bf16x8 a = *(const bf16x8*)(Ke + (jt * 32 + r) * 72 + 16 * s + 8 * h2); const bf16x8 bb = *(const bf16x8*)(Qe + (it * 32 + r) * 72 + 16 * s + 8 * h2); X = MFMA32(a, bb, X); }
            if (jt == it) {
#pragma unroll
                for (int i = 0; i < 16; ++i) if (crow(i, h2) > r) X[i] = 0.f;
            }
#pragma unroll
            for (int s = 0; s < 2; ++s) { const bf16x8 pf = pack8(X, s);
                const u32x2 lo = *(const u32x2*)(Vt + (et * 32 + r) * 72 + jt * 32 + 16 * s + 4 * h2), hi = *(const u32x2*)(Vt + (et * 32 + r) * 72 + jt * 32 + 16 * s + 8 + 4 * h2);
                u32x4 va; va.x = lo.x; va.y = lo.y; va.z = hi.x; va.w = hi.y;
                o = MFMA32(__builtin_bit_cast(bf16x8, va), pf, o); }
        }
#pragma unroll
        for (int i = 0; i < 16; ++i) Os[(it * 32 + r) * 132 + et * 32 + crow(i, h2)] = o[i];
    }
    __syncthreads();
    {
        const int i = tid >> 3, ec = tid & 7, e0 = ec * 16;
        float v[16]; float ss = 0.f;
#pragma unroll
        for (int k = 0; k < 4; ++k) { const f32x4 t = *(const f32x4*)(Os + i * 132 + e0 + 4 * k); v[4 * k] = t.x; v[4 * k + 1] = t.y; v[4 * k + 2] = t.z; v[4 * k + 3] = t.w; ss += (t.x * t.x + t.y * t.y) + (t.z * t.z + t.w * t.w); }
        ss += __shfl_xor(ss, 1); ss += __shfl_xor(ss, 2); ss += __shfl_xor(ss, 4);
        const float rs = rsqrtf(ss * (1.f / 128.f) + RMS_EPS);
        const u32x4 g0 = *(const u32x4*)(proj + (size_t)(m0 + i) * PW + C_GOG + h * 128 + e0), g1 = *(const u32x4*)(proj + (size_t)(m0 + i) * PW + C_GOG + h * 128 + e0 + 8);
        const unsigned gw[8] = {g0.x, g0.y, g0.z, g0.w, g1.x, g1.y, g1.z, g1.w};
        const float* hn = F.head_norm + (size_t)l * 128 + e0;
        unsigned ow[8];
#pragma unroll
        for (int k = 0; k < 8; ++k) { const float ga = bf2f(gw[k] & 0xffffu), gb = bf2f(gw[k] >> 16);
            const float a = v[2 * k] * rs * hn[2 * k] * (ga / (1.f + __expf(-ga))), bq = v[2 * k + 1] * rs * hn[2 * k + 1] * (gb / (1.f + __expf(-gb)));
            ow[k] = pk2(a, bq); }
        u32x4 o0, o1; o0.x = ow[0]; o0.y = ow[1]; o0.z = ow[2]; o0.w = ow[3]; o1.x = ow[4]; o1.y = ow[5]; o1.z = ow[6]; o1.w = ow[7];
        *(u32x4*)(ocat + (size_t)(m0 + i) * DM + h * 128 + e0) = o0; *(u32x4*)(ocat + (size_t)(m0 + i) * DM + h * 128 + e0 + 8) = o1;
    }
    __syncthreads();
}

DI unsigned ord_f32(float v) { const unsigned b = __float_as_uint(v); return (b & 0x80000000u) ? ~b : (b | 0x80000000u); }
DI void topk_tile(Frame& F, int tile, const float* sc, int* eout, float* gout) {
    const int tid = F.tid;
    float* S = (float*)F.lds;
    const float* src = sc + (size_t)tile * 32768;
#pragma unroll 4
    for (int i = 0; i < 16; ++i) { const int idx = tid + i * 512, R = idx >> 5, c4 = idx & 31; const f32x4 v = *(const f32x4*)(src + (size_t)idx * 4);
        float* d = S + R * 129 + c4 * 4; d[0] = v.x; d[1] = v.y; d[2] = v.z; d[3] = v.w; }
    __syncthreads();
    float tv[16]; int ti[16];
    if (tid < 256) {
        unsigned tk[16];
#pragma unroll
        for (int k = 0; k < 16; ++k) tk[k] = 0u;
        const float* row = S + tid * 129;
#pragma unroll 4
        for (int n = 0; n < 128; ++n) { unsigned key = (ord_f32(row[n]) & ~127u) | (unsigned)(127 - n);
#pragma unroll
            for (int k = 0; k < 16; ++k) { const unsigned hi = tk[k] > key ? tk[k] : key; key = tk[k] > key ? key : tk[k]; tk[k] = hi; } }
#pragma unroll
        for (int k = 0; k < 16; ++k) { ti[k] = 127 - (int)(tk[k] & 127u); tv[k] = row[ti[k]]; }
    }
    __syncthreads();
    float* LV = (float*)F.lds; int* LI = (int*)(F.lds + 16384);
    if (tid < 256) {
#pragma unroll
        for (int k = 0; k < 16; ++k) { LV[tid * 16 + k] = tv[k]; LI[tid * 16 + k] = ti[k]; }
    }
    __syncthreads();
    if (tid < 128) {
        const int R1 = 2 * tid, R2 = 2 * tid + 1;
        float s1[16], s2[16];
#pragma unroll
        for (int k = 0; k < 16; ++k) { s1[k] = LV[R1 * 16 + k]; s2[k] = LV[R2 * 16 + k]; }
        unsigned tk[16];
#pragma unroll
        for (int k = 0; k < 16; ++k) tk[k] = 0u;
#pragma unroll
        for (int i = 0; i < 16; ++i)
#pragma unroll
            for (int j = 0; j < 16; ++j)
                if ((i + 1) * (j + 1) <= 16) { unsigned key = (ord_f32(s1[i] + s2[j]) & ~255u) | (unsigned)(255 - (i * 16 + j));
#pragma unroll
                    for (int k = 0; k < 16; ++k) { const unsigned hi = tk[k] > key ? tk[k] : key; key = tk[k] > key ? key : tk[k]; tk[k] = hi; } }
        float top[16]; int ee[16]; float mx = -1e30f;
#pragma unroll
        for (int k = 0; k < 16; ++k) { const int cid = 255 - (int)(tk[k] & 255u), i = cid >> 4, j = cid & 15;
            top[k] = LV[R1 * 16 + i] + LV[R2 * 16 + j]; ee[k] = LI[R1 * 16 + i] * 128 + LI[R2 * 16 + j]; mx = fmaxf(mx, top[k]); }
        float sum = 0.f;
#pragma unroll
        for (int k = 0; k < 16; ++k) { top[k] = __expf(top[k] - mx); sum += top[k]; }
        const float inv = 1.f / sum;
        const int t = tile * 16 + (tid >> 3), hh = tid & 7;
        int* eo = eout + (size_t)t * 128 + hh * 16; float* go = gout + (size_t)t * 128 + hh * 16;
#pragma unroll
        for (int k = 0; k < 16; ++k) { eo[k] = ee[k]; go[k] = top[k] * inv; }
    }
    __syncthreads();
}

typedef float f32x2 __attribute__((ext_vector_type(2)));
DI unsigned pack4_fp8(float a, float b, float c, float d) { int w = 0; w = __builtin_amdgcn_cvt_pk_fp8_f32(a, b, w, false); w = __builtin_amdgcn_cvt_pk_fp8_f32(c, d, w, true); return (unsigned)w; }
DI float wave_max(float v) {
#pragma unroll
    for (int o = 1; o < 64; o <<= 1) v = fmaxf(v, __shfl_xor(v, o));
    return v;
}
DI void convert_rows_fp8(Frame& F, const float* src, unsigned char* dst, float* rscale, bool vslice) {
    const int lane = F.lane;
    for (int e = F.bid * NWAVES + F.wave; e < NEXP; e += F.G * NWAVES) {
        const f32x4* r = (const f32x4*)(src + (size_t)e * DM) + lane * 4;
        f32x4 v[4]; float mx = 0.f;
#pragma unroll
        for (int j = 0; j < 4; ++j) { v[j] = r[j]; mx = fmaxf(mx, fmaxf(fmaxf(fabsf(v[j].x), fabsf(v[j].y)), fmaxf(fabsf(v[j].z), fabsf(v[j].w)))); }
        mx = wave_max(mx);
        const float s = mx > 0.f ? 240.f / mx : 1.f, inv = mx > 0.f ? mx * (1.f / 240.f) : 1.f;
        u32x4 o; o.x = pack4_fp8(v[0].x * s, v[0].y * s, v[0].z * s, v[0].w * s); o.y = pack4_fp8(v[1].x * s, v[1].y * s, v[1].z * s, v[1].w * s);
        o.z = pack4_fp8(v[2].x * s, v[2].y * s, v[2].z * s, v[2].w * s); o.w = pack4_fp8(v[3].x * s, v[3].y * s, v[3].z * s, v[3].w * s);
        if (!vslice) *(u32x4*)(dst + (size_t)e * DM + lane * 16) = o;
        else *(u32x4*)(dst + ((size_t)(lane >> 3) * NEXP + e) * 128 + (lane & 7) * 16) = o;
        if (lane == 0) rscale[e] = inv;
    }
}
DI unsigned xcc_id() { return (unsigned)__builtin_amdgcn_s_getreg((3 << 11) | 20) & 7u; }
DI unsigned wave_dequeue(unsigned* ctr, int lane) { unsigned v = 0; if (lane == 0) v = __hip_atomic_fetch_add(ctr, 1u, __ATOMIC_RELAXED, __HIP_MEMORY_SCOPE_AGENT); return (unsigned)__builtin_amdgcn_readfirstlane((int)v); }
constexpr int PEER_ITEM_TOK = 32, PEER_ITEMS = NT / PEER_ITEM_TOK;
struct PeerMetaU { int ea, eb; u32x4 xa, xb; };
struct PeerMetaV { int ea, eb; float ha, hb; f32x2 hv; };
DI PeerMetaU peer_meta_u(int lane, int t, int sl, const bf16* xn, const int* E) {
    PeerMetaU m; m.ea = E[(size_t)t * 128 + lane]; m.eb = E[(size_t)t * 128 + 64 + lane];
    const bf16* xp = xn + (size_t)t * DM + sl * 128 + (lane & 7) * 16; m.xa = *(const u32x4*)xp; m.xb = *(const u32x4*)(xp + 8); return m;
}
DI PeerMetaV peer_meta_v(int lane, int t, int sl, const int* E, const float* hid, const float* h) {
    PeerMetaV m; m.ea = E[(size_t)t * 128 + lane]; m.eb = E[(size_t)t * 128 + 64 + lane]; m.ha = hid[(size_t)t * 128 + lane]; m.hb = hid[(size_t)t * 128 + 64 + lane];
    m.hv = *(const f32x2*)(h + (size_t)t * DM + sl * 128 + (lane & 7) * 16 + (lane >> 3) * 2); return m;
}
DI void peer_u_visit(int lane, int t, int sl, const PeerMetaU& m, const unsigned char* U8s, float* part) {
    const int g = lane >> 3, sub = lane & 7;
    f32x2 xp[8];
    { const unsigned wv[8] = {m.xa.x, m.xa.y, m.xa.z, m.xa.w, m.xb.x, m.xb.y, m.xb.z, m.xb.w};
#pragma unroll
      for (int k = 0; k < 8; ++k) { xp[k].x = bf2f(wv[k] & 0xffffu); xp[k].y = __uint_as_float(wv[k] & 0xffff0000u); } }
    const unsigned char* ub = U8s + (size_t)sl * NEXP * 128 + sub * 16;
    u32x4 uw[16];
#pragma unroll
    for (int I = 0; I < 16; ++I) { const int ek = __shfl(I < 8 ? m.ea : m.eb, (I & 7) * 8 + g); uw[I] = *(const u32x4*)(ub + (size_t)ek * 128); }
    float s[16];
#pragma unroll
    for (int I = 0; I < 16; ++I) {
        const unsigned wv[4] = {uw[I].x, uw[I].y, uw[I].z, uw[I].w};
        f32x2 s2 = {0.f, 0.f};
#pragma unroll
        for (int k = 0; k < 4; ++k) { s2 = __builtin_amdgcn_cvt_pk_f32_fp8((int)wv[k], false) * xp[2 * k] + s2; s2 = __builtin_amdgcn_cvt_pk_f32_fp8((int)wv[k], true) * xp[2 * k + 1] + s2; }
        s[I] = s2.x + s2.y;
    }
    const bool b2 = (lane & 4) != 0, b1 = (lane & 2) != 0, b0 = (lane & 1) != 0;
    float p[8], q[4], r[2];
#pragma unroll
    for (int j = 0; j < 8; ++j) { const float keep = b2 ? s[8 + j] : s[j], send = b2 ? s[j] : s[8 + j]; p[j] = keep + __shfl_xor(send, 4); }
#pragma unroll
    for (int j = 0; j < 4; ++j) { const float keep = b1 ? p[4 + j] : p[j], send = b1 ? p[j] : p[4 + j]; q[j] = keep + __shfl_xor(send, 2); }
#pragma unroll
    for (int j = 0; j < 2; ++j) { const float keep = b0 ? q[2 + j] : q[j], send = b0 ? q[j] : q[2 + j]; r[j] = keep + __shfl_xor(send, 1); }
    const int I0 = (b2 ? 8 : 0) + (b1 ? 4 : 0) + (b0 ? 2 : 0);
    float* pp = part + ((size_t)sl * NT + t) * 128;
#pragma unroll
    for (int j = 0; j < 2; ++j) { const int I = I0 + j; pp[64 * (I >> 3) + 8 * (I & 7) + g] = r[j]; }
}
DI void peer_v_visit(int lane, int t, int sl, const PeerMetaV& m, const unsigned char* V8s, float* h) {
    const int g = lane >> 3, sub = lane & 7;
    const unsigned char* vb = V8s + (size_t)sl * NEXP * 128 + sub * 16;
    u32x4 vw[16]; float hk[16];
#pragma unroll
    for (int I = 0; I < 16; ++I) { const int src = (I & 7) * 8 + g; const int ek = __shfl(I < 8 ? m.ea : m.eb, src); hk[I] = __shfl(I < 8 ? m.ha : m.hb, src); vw[I] = *(const u32x4*)(vb + (size_t)ek * 128); }
    f32x2 o[8];
#pragma unroll
    for (int k = 0; k < 8; ++k) o[k] = (f32x2){0.f, 0.f};
#pragma unroll
    for (int I = 0; I < 16; ++I) {
        const unsigned wv[4] = {vw[I].x, vw[I].y, vw[I].z, vw[I].w}; const f32x2 h2 = {hk[I], hk[I]};
#pragma unroll
        for (int k = 0; k < 4; ++k) { o[2 * k] = __builtin_amdgcn_cvt_pk_f32_fp8((int)wv[k], false) * h2 + o[2 * k]; o[2 * k + 1] = __builtin_amdgcn_cvt_pk_f32_fp8((int)wv[k], true) * h2 + o[2 * k + 1]; }
    }
    const bool b5 = (lane & 32) != 0, b4 = (lane & 16) != 0, b3 = (lane & 8) != 0;
    f32x2 p[4];
#pragma unroll
    for (int k = 0; k < 4; ++k) { const f32x2 keep = b5 ? o[4 + k] : o[k], send = b5 ? o[k] : o[4 + k]; f32x2 rc; rc.x = __shfl_xor(send.x, 32); rc.y = __shfl_xor(send.y, 32); p[k] = keep + rc; }
    f32x2 q[2];
#pragma unroll
    for (int k = 0; k < 2; ++k) { const f32x2 keep = b4 ? p[2 + k] : p[k], send = b4 ? p[k] : p[2 + k]; f32x2 rc; rc.x = __shfl_xor(send.x, 16); rc.y = __shfl_xor(send.y, 16); q[k] = keep + rc; }
    f32x2 r1;
    { const f32x2 keep = b3 ? q[1] : q[0], send = b3 ? q[0] : q[1]; f32x2 rc; rc.x = __shfl_xor(send.x, 8); rc.y = __shfl_xor(send.y, 8); r1 = keep + rc; }
    *(f32x2*)(h + (size_t)t * DM + sl * 128 + sub * 16 + g * 2) = m.hv + r1;
}
template <bool VSIDE>
DI void phase_peer(Frame& F, unsigned* ctr  , const bf16* xn, const int* E, const unsigned char* T8s, const float* hid, float* part) {
    const unsigned xcc = xcc_id(); const int lane = F.lane;
    for (int so = 0; so < 8; ++so) {
        const int sl = (int)((xcc + (unsigned)so) & 7u);
        for (;;) {
            const unsigned item = wave_dequeue(ctr + 64 * sl, lane);
            if (item >= (unsigned)PEER_ITEMS) break;
            const int t0 = (int)item * PEER_ITEM_TOK;
            if (VSIDE) {
                PeerMetaV nx = peer_meta_v(lane, t0, sl, E, hid, F.out);
                for (int tt = 0; tt < PEER_ITEM_TOK; ++tt) { const PeerMetaV cur = nx; if (tt + 1 < PEER_ITEM_TOK) nx = peer_meta_v(lane, t0 + tt + 1, sl, E, hid, F.out); peer_v_visit(lane, t0 + tt, sl, cur, T8s, F.out); }
            } else {
                PeerMetaU nx = peer_meta_u(lane, t0, sl, xn, E);
                for (int tt = 0; tt < PEER_ITEM_TOK; ++tt) { const PeerMetaU cur = nx; if (tt + 1 < PEER_ITEM_TOK) nx = peer_meta_u(lane, t0 + tt + 1, sl, xn, E); peer_u_visit(lane, t0 + tt, sl, cur, T8s, part); }
            }
        }
    }
}
DI void phase_peer_hid(Frame& F, const int* E, const float* Gt, const float* part, const float* usc, const float* vsc, float* hid) {
    for (size_t i = (size_t)F.bid * NTHR + F.tid; i < (size_t)NT * 128; i += (size_t)F.G * NTHR) {
        float a = 0.f;
#pragma unroll
        for (int sl = 0; sl < 8; ++sl) a += part[(size_t)sl * NT * 128 + i];
        const int e = E[i]; a *= usc[e];
        hid[i] = Gt[i] * (0.5f * a * (1.f + erff(a * 0.70710678118654752f))) * vsc[e];
    }
}

#ifndef PHMASK
#define PHMASK 0xFFFF
#endif
#define EN(n) if constexpr (((PHMASK) >> (n)) & 1)
#ifndef PROBE_DUP
#define PROBE_DUP -1
#endif
constexpr int PH_PER_LAYER = 14, NPH = 2 + DEPTH * PH_PER_LAYER;

__global__ void __launch_bounds__(NTHR, 2) hybrid_fwd(Args args) {
    extern __shared__ __attribute__((aligned(16))) unsigned char lds[];
    unsigned char* ws = args.ws;
    bf16* proj = (bf16*)(ws + WS_A); float* sc = (float*)(ws + WS_A);
    bf16* xn = (bf16*)(ws + WS_XN);
    bf16* ocat = (bf16*)(ws + WS_C); int* eids = (int*)(ws + WS_C); float* gates = (float*)(ws + WS_C + 16 * MiB); float* hid = (float*)(ws + WS_C + 32 * MiB); unsigned* ctl = (unsigned*)ws; bf16* pw = (bf16*)(ws + WS_C);
    float* kvt = (float*)(ws + WS_D); unsigned char* u8 = ws + WS_D; unsigned char* v8 = ws + WS_D + 16 * MiB; float* usc = (float*)(ws + WS_D + 32 * MiB); float* vsc = (float*)(ws + WS_D + 33 * MiB);
    bf16* pb = (bf16*)(ws + WS_PB); float* dec = (float*)(ws + WS_DEC);
    cg::grid_group grid = cg::this_grid();
    PG8_LAS unsigned char* gl = (PG8_LAS unsigned char*)lds;

    for (int ph = args.ph_lo, rep = 0; ph < args.ph_hi;) {
        int tid_ = threadIdx.x; asm volatile("" : "+v"(tid_));
    Frame F;
        F.lds = lds; F.tid = tid_; F.lane = F.tid & 63; F.wave = __builtin_amdgcn_readfirstlane(F.tid >> 6); F.G = gridDim.x; F.bid = blockIdx.x;
        F.x = args.in[0]; F.p = args.in[1]; F.norm_mix = args.in[2]; F.w_in = args.in[3]; F.g_w2 = args.in[4]; F.g_b = args.in[5]; F.head_norm = args.in[6]; F.rel_bias = args.in[7]; F.w_out = args.in[8];
        F.norm_ffn = args.in[9]; F.peer_wq = args.in[10]; F.peer_sk = args.in[11]; F.peer_u = args.in[12]; F.peer_v = args.in[13]; F.norm_ple = args.in[14]; F.w_ple_gate = args.in[15]; F.w_ple = args.in[16]; F.final_norm = args.in[17];
        F.out = args.out; F.ws = args.ws;
        if (ph == 0) { EN(14) { phase_prep(F); if (F.bid == 0 && F.tid < 32) ctl[64 * F.tid] = 0u; } }
        else if (ph == NPH - 1) { EN(15) phase_final_norm(F, F.final_norm); }
        else {
            const int l = (ph - 1) / PH_PER_LAYER, sp = (ph - 1) % PH_PER_LAYER;
            const pg8::bf16_t* wl = (const pg8::bf16_t*)(ws + WS_W + (size_t)l * W_LAYER);
            const float* hsrc = (l == 0) ? F.x : F.out;
            switch (sp) {
            case 0: EN(0) {
                phase_norm(F, hsrc, F.norm_mix + (size_t)l * DM, xn);
                convert_bf16(F, F.p + (size_t)l * NT * 256, pb, (size_t)NT * 256);
            } break;
            case 1: EN(1) {
                pg8::Gemm g{(const pg8::bf16_t*)xn, wl + WO_WIN / 2, NT, PW, DM}; pg8::StaticOrder S; S.init(NT, PW, F.G, F.bid);
                pg8::EpiBf16<0> E{(pg8::bf16_t*)proj, PW, nullptr, 0, 0, 1.f};
                pg8::gemm_phase<pg8::EpiBf16<0>, pg8::StaticOrder, true, true>(gl, g, S, E, F.tid);
            } break;
            case 2: EN(2) {
                for (int u = F.bid; u < NB * 8 * 64; u += F.G) { const int c = ((u & 63) + (u >> 6)) & 63, h = (u >> 6) & 7, b = u >> 9; att_unit(F, l, b, h, c, proj, ocat); }
                for (int u = F.bid; u < NB * 4 * 64; u += F.G) { const int c = u & 63, h = (u >> 6) & 3, b = u >> 8; gla_kv_unit(F, l, b, h, c, proj, kvt, dec); }
            } break;
            case 3: EN(3) { phase_scan(F, kvt, dec); } break;
            case 4: EN(4) {
                for (int u = F.bid; u < NB * 4 * 64; u += F.G) { const int c = u & 63, h = (u >> 6) & 3, b = u >> 8; gla_out_unit(F, l, b, h, c, proj, kvt, ocat); }
            } break;
            case 5: EN(5) {
                pg8::Gemm g{(const pg8::bf16_t*)ocat, wl + WO_WOUT / 2, NT, DM, DM}; pg8::StaticOrder S; S.init(NT, DM, F.G, F.bid);
                pg8::EpiResid E{hsrc, F.out, DM};
                pg8::gemm_phase<pg8::EpiResid, pg8::StaticOrder, true, true>(gl, g, S, E, F.tid);
            } break;
            case 6: EN(6) {
                phase_norm(F, F.out, F.norm_ffn + (size_t)l * DM, xn);
                convert_rows_fp8(F, F.peer_u + (size_t)l * NEXP * DM, u8, usc, true);
                convert_rows_fp8(F, F.peer_v + (size_t)l * NEXP * DM, v8, vsc, true);
            } break;
            case 7: EN(7) {
                pg8::Gemm g{(const pg8::bf16_t*)xn, wl + WO_WQ2 / 2, NT, 2048, DM}; pg8::StaticOrder S; S.init(NT, 2048, F.G, F.bid);
                pg8::EpiF32Store E{sc, 2048};
                pg8::gemm_phase<pg8::EpiF32Store, pg8::StaticOrder, true, true>(gl, g, S, E, F.tid);
            } break;
            case 8: EN(8) { for (int tl = F.bid; tl < NT / 16; tl += F.G) topk_tile(F, tl, sc, eids, gates); } break;
            case 9: EN(9) { phase_peer<false>(F, ctl + 64 * (16 * l), xn, eids, u8, hid, (float*)(ws + WS_A)); } break;
            case 10: EN(10) { phase_peer_hid(F, eids, gates, (const float*)(ws + WS_A), usc, vsc, hid); } break;
            case 11: EN(11) { phase_peer<true>(F, ctl + 64 * (16 * l + 8), xn, eids, v8, hid, nullptr); } break;
            case 12: EN(12) {
                phase_norm(F, F.out, F.norm_ple + (size_t)l * DM, xn);
                pg8::Gemm g{(const pg8::bf16_t*)pb, wl + WO_WP / 2, NT, DM, 256}; pg8::StaticOrder S; S.init(NT, DM, F.G, F.bid);
                pg8::EpiBf16<0> E{(pg8::bf16_t*)pw, DM, nullptr, 0, 0, 1.f};
                pg8::gemm_phase<pg8::EpiBf16<0>, pg8::StaticOrder, true, true>(gl, g, S, E, F.tid);
            } break;
            case 13: EN(13) {
                pg8::Gemm g{(const pg8::bf16_t*)xn, wl + WO_WG / 2, NT, DM, DM}; pg8::StaticOrder S; S.init(NT, DM, F.G, F.bid);
                pg8::EpiPle E{F.out, F.out, (const pg8::bf16_t*)pw, DM};
                pg8::gemm_phase<pg8::EpiPle, pg8::StaticOrder, true, true>(gl, g, S, E, F.tid);
            } break;
            }
        }
        bool adv = true;
        if (PROBE_DUP >= 0 && ph > 0 && ph < NPH - 1 && (ph - 1) % PH_PER_LAYER == PROBE_DUP && rep == 0) { rep = 1; adv = false; }
        if (adv) { rep = 0; ++ph; }
        if (ph < args.ph_hi) grid.sync();
    }
}

extern "C" void kernel_launch(void* const* d_in, const int* in_sizes, int n_in, void* d_out, int out_size, void* d_ws, size_t ws_size, hipStream_t stream) {
    static int grid = 0;
    if (grid == 0) {
        if (n_in != 18 || in_sizes[0] != NT * DM || out_size != NT * DM || ws_size < WS_END) { fprintf(stderr, "kernel_launch: unexpected shapes (n_in %d, in0 %d, out %d, ws %zu); nothing launched\n", n_in, n_in > 0 ? in_sizes[0] : -1, out_size, ws_size); grid = -1; return; }
        int dev = 0, cus = 0, per_cu = 0;
        if (hipGetDevice(&dev) != hipSuccess || hipDeviceGetAttribute(&cus, hipDeviceAttributeMultiprocessorCount, dev) != hipSuccess) { fprintf(stderr, "kernel_launch: device query failed\n"); grid = -1; return; }
        if (hipFuncSetAttribute((const void*)hybrid_fwd, hipFuncAttributeMaxDynamicSharedMemorySize, LDS_BYTES) != hipSuccess) { fprintf(stderr, "kernel_launch: hipFuncSetAttribute failed\n"); grid = -1; return; }
        if (hipOccupancyMaxActiveBlocksPerMultiprocessor(&per_cu, (const void*)hybrid_fwd, NTHR, LDS_BYTES) != hipSuccess || per_cu < 1) { fprintf(stderr, "kernel_launch: occupancy query says %d blocks per CU\n", per_cu); (void)hipGetLastError(); grid = -1; return; }
        grid = cus * 1;
    }
    if (grid < 0) return;
    Args a{};
    for (int i = 0; i < 18; ++i) a.in[i] = (const float*)d_in[i];
    a.out = (float*)d_out; a.ws = (unsigned char*)d_ws;
#if MK_N_LAUNCHES == 1
    a.ph_lo = 0; a.ph_hi = NPH;
    void* kargs[] = {&a};
    hipError_t e = hipLaunchCooperativeKernel((const void*)hybrid_fwd, dim3(grid), dim3(NTHR), kargs, LDS_BYTES, stream);
    if (e != hipSuccess) fprintf(stderr, "kernel_launch: cooperative launch failed: %s (grid %d)\n", hipGetErrorString(e), grid);
#else
    for (int ph = 0; ph < NPH; ++ph) { a.ph_lo = ph; a.ph_hi = ph + 1; hipLaunchKernelGGL(hybrid_fwd, dim3(grid), dim3(NTHR), LDS_BYTES, stream, a); }
#endif
}
```

```cpp
#include <hip/hip_runtime.h>
#include <hip/hip_cooperative_groups.h>
#include <cstdio>
#include <cstdint>
namespace cg = cooperative_groups;
#define MK_N_LAUNCHES 1
namespace pg8 {
#define PG8_LAS __attribute__((address_space(3)))
typedef unsigned short bf16_t;
typedef short bf16x8 __attribute__((ext_vector_type(8)));
typedef float f32x4 __attribute__((ext_vector_type(4)));
typedef unsigned u32x4 __attribute__((ext_vector_type(4)));
constexpr int BM = 256, BK = 64, HALF = 128, HTB = HALF * BK * 2  , STAGE_BYTES = 8 * HTB, NXCD = 8, WGM = 8;

__host__ __device__ __forceinline__ int lds_byte(int r, int c) { const int st = (r >> 4) * 2 + (c >> 5), rr = r & 15, cc = c & 31, ob = rr * 64 + cc * 2; return st * 1024 + (ob ^ (((ob >> 9) & 1) << 5)); }
__host__ __device__ __forceinline__ void stage_rc(int b, int& R, int& C) { const int st = b / 1024, sb = b % 1024, swz = sb ^ (((sb >> 9) & 1) << 5); R = (st >> 1) * 16 + swz / 64; C = (st & 1) * 32 + (swz % 64) / 2; }
__host__ __device__ __forceinline__ int perm32(int rho) { const int n = rho >> 4, i = rho & 15; return 8 * (i >> 2) + 4 * n + (i & 3); }

struct Unit { int pm, pn; };
struct Gemm { const bf16_t* A; const bf16_t* Bt; int M, N, K; };

struct StaticOrder {
    int nM, nN, nwg, G, c;
    __host__ __device__ void init(int M, int N, int G_, int c_) { nM = M / BM; nN = N / BM; nwg = nM * nN; G = G_; c = c_; }
    __host__ __device__ bool next(int i, Unit& u) const {
        const long L = (long)i * G + c; if (L >= nwg) return false;
        int wgid = (int)L; { const int q = nwg / NXCD, r = nwg % NXCD, xcd = wgid % NXCD, off = wgid / NXCD; wgid = (xcd < r ? xcd * (q + 1) : r * (q + 1) + (xcd - r) * q) + off; }
        const int nig = WGM * nN, gid = wgid / nig, fm = gid * WGM, gsz = (nM - fm) < WGM ? (nM - fm) : WGM;
        u.pm = fm + ((wgid % nig) % gsz); u.pn = (wgid % nig) / gsz; return true;
    }
    __device__ __forceinline__ void a_ready(const Unit&) const {}
    __device__ __forceinline__ void done(const Unit&) const {}
};

__device__ __forceinline__ unsigned cvt_pk_bf16(float lo, float hi) { unsigned r; asm volatile("v_cvt_pk_bf16_f32 %0, %1, %2" : "=v"(r) : "v"(lo), "v"(hi)); return r; }
typedef float f32x2 __attribute__((ext_vector_type(2)));
__device__ __forceinline__ f32x2 gelu_pk(f32x2 v) {
    const f32x2 av = __builtin_elementwise_abs(v), d = av * 0.2316418882f + 1.0f;
    f32x2 t; t.x = __builtin_amdgcn_rcpf(d.x); t.y = __builtin_amdgcn_rcpf(d.y);
    f32x2 q = t * 0.5307027145f + (-0.7265760135f); q = q * t + 0.7107068705f; q = q * t + (-0.142248368f); q = q * t + 0.127414796f; q = q * t;
    const f32x2 s = (v * v) * (-0.72134752044f);
    f32x2 e; e.x = __builtin_amdgcn_exp2f(s.x); e.y = __builtin_amdgcn_exp2f(s.y);
    const f32x2 m = v * (q * e), r = v - m;
    f32x2 o; o.x = v.x < 0.f ? m.x : r.x; o.y = v.y < 0.f ? m.y : r.y; return o;
}

template <int ACT  > struct EpiBf16 {
    static constexpr bool PERM = true, AFTER_DRAIN = false; static_assert(ACT == 0 || ACT == 1, "EpiBf16: ACT is 0 (none) or 1 (gelu_pk)");
    bf16_t* O; int ldc; const float* bias; int split_cols; size_t split_stride; float scale0;
    __device__ __forceinline__ void operator()(const f32x4 (&acc)[2][2][4][2], const Unit& u, int wr, int wc, int fr, int fq) const {
        const int row0 = u.pm * BM + wr * 64 + fr; int colt = u.pn * BM; bf16_t* base = O;
        float sc = 1.f; if (split_cols) { const int t = colt / split_cols; base += (size_t)t * split_stride; colt -= t * split_cols; if (t == 0) sc = scale0; }
        const int col0 = colt + wc * 32 + 8 * fq, bcol0 = u.pn * BM + wc * 32 + 8 * fq;
        f32x4 bv[2][2];
#pragma unroll
        for (int bj = 0; bj < 2; ++bj)
#pragma unroll
            for (int n = 0; n < 2; ++n) bv[bj][n] = bias ? *(const f32x4*)(bias + bcol0 + bj * HALF + 4 * n) : (f32x4){0.f, 0.f, 0.f, 0.f};
#pragma unroll
        for (int ai = 0; ai < 2; ++ai)
#pragma unroll
            for (int m = 0; m < 4; ++m) { bf16_t* rowp = base + (size_t)(row0 + ai * HALF + m * 16) * ldc + col0;
#pragma unroll
                for (int bj = 0; bj < 2; ++bj) { f32x4 v0 = acc[ai][bj][m][0] + bv[bj][0], v1 = acc[ai][bj][m][1] + bv[bj][1];
                    if (ACT == 1) { f32x2 a = gelu_pk((f32x2){v0[0], v0[1]}), b = gelu_pk((f32x2){v0[2], v0[3]}), c = gelu_pk((f32x2){v1[0], v1[1]}), d = gelu_pk((f32x2){v1[2], v1[3]});
                        v0 = (f32x4){a.x, a.y, b.x, b.y}; v1 = (f32x4){c.x, c.y, d.x, d.y}; }
                    v0 = v0 * sc; v1 = v1 * sc; u32x4 w; w.x = cvt_pk_bf16(v0[0], v0[1]); w.y = cvt_pk_bf16(v0[2], v0[3]); w.z = cvt_pk_bf16(v1[0], v1[1]); w.w = cvt_pk_bf16(v1[2], v1[3]);
                    *(u32x4*)(rowp + bj * HALF) = w; } }
    }
};

struct EpiF32Store {
    static constexpr bool PERM = false, AFTER_DRAIN = false;
    float* C; int ldc;
    __device__ __forceinline__ void operator()(const f32x4 (&acc)[2][2][4][2], const Unit& u, int wr, int wc, int fr, int fq) const {
        const int row0 = u.pm * BM + wr * 64 + fr, col0 = u.pn * BM + wc * 32 + 4 * fq;
#pragma unroll
        for (int ai = 0; ai < 2; ++ai)
#pragma unroll
            for (int m = 0; m < 4; ++m) { float* rowp = C + (size_t)(row0 + ai * HALF + m * 16) * ldc + col0;
#pragma unroll
                for (int bj = 0; bj < 2; ++bj)
#pragma unroll
                    for (int n = 0; n < 2; ++n) *(f32x4*)(rowp + bj * HALF + n * 16) = acc[ai][bj][m][n]; }
    }
};
struct EpiResid {
    static constexpr bool PERM = false, AFTER_DRAIN = false;
    const float* base; float* out; int ldc;
    __device__ __forceinline__ void operator()(const f32x4 (&acc)[2][2][4][2], const Unit& u, int wr, int wc, int fr, int fq) const {
        const int row0 = u.pm * BM + wr * 64 + fr, col0 = u.pn * BM + wc * 32 + 4 * fq;
#pragma unroll
        for (int ai = 0; ai < 2; ++ai)
#pragma unroll
            for (int m = 0; m < 4; ++m) { const size_t off = (size_t)(row0 + ai * HALF + m * 16) * ldc + col0;
                f32x4 bs[2][2];
#pragma unroll
                for (int bj = 0; bj < 2; ++bj)
#pragma unroll
                    for (int n = 0; n < 2; ++n) bs[bj][n] = *(const f32x4*)(base + off + bj * HALF + n * 16);
#pragma unroll
                for (int bj = 0; bj < 2; ++bj)
#pragma unroll
                    for (int n = 0; n < 2; ++n) *(f32x4*)(out + off + bj * HALF + n * 16) = bs[bj][n] + acc[ai][bj][m][n];
                asm volatile("" ::: "memory"); }
    }
};
struct EpiPle {
    static constexpr bool PERM = false, AFTER_DRAIN = false;
    const float* base; float* out; const bf16_t* pw; int ldc;
    __device__ __forceinline__ void operator()(const f32x4 (&acc)[2][2][4][2], const Unit& u, int wr, int wc, int fr, int fq) const {
        typedef unsigned u32x2v __attribute__((ext_vector_type(2)));
        const int row0 = u.pm * BM + wr * 64 + fr, col0 = u.pn * BM + wc * 32 + 4 * fq;
#pragma unroll
        for (int ai = 0; ai < 2; ++ai)
#pragma unroll
            for (int m = 0; m < 4; ++m) { const size_t off = (size_t)(row0 + ai * HALF + m * 16) * ldc + col0;
                f32x4 bs[2][2]; u32x2v pv[2][2];
#pragma unroll
                for (int bj = 0; bj < 2; ++bj)
#pragma unroll
                    for (int n = 0; n < 2; ++n) { bs[bj][n] = *(const f32x4*)(base + off + bj * HALF + n * 16); pv[bj][n] = *(const u32x2v*)(pw + off + bj * HALF + n * 16); }
#pragma unroll
                for (int bj = 0; bj < 2; ++bj)
#pragma unroll
                    for (int n = 0; n < 2; ++n) { const f32x4 a = acc[ai][bj][m][n]; f32x4 o;
                        const float p0 = __uint_as_float(pv[bj][n].x << 16), p1 = __uint_as_float(pv[bj][n].x & 0xffff0000u), p2 = __uint_as_float(pv[bj][n].y << 16), p3 = __uint_as_float(pv[bj][n].y & 0xffff0000u);
                        o[0] = bs[bj][n][0] + p0 / (1.0f + __expf(-a[0])); o[1] = bs[bj][n][1] + p1 / (1.0f + __expf(-a[1]));
                        o[2] = bs[bj][n][2] + p2 / (1.0f + __expf(-a[2])); o[3] = bs[bj][n][3] + p3 / (1.0f + __expf(-a[3]));
                        *(f32x4*)(out + off + bj * HALF + n * 16) = o; }
                asm volatile("" ::: "memory"); }
    }
};
template <class Epi, class Sched, bool ALIGN_EPI = false, bool SP2 = false>
__device__ __forceinline__ void gemm_phase(PG8_LAS unsigned char* lds, const Gemm g, const Sched& S, const Epi& E, const int tid_in) {
    const int tid = tid_in, wid = __builtin_amdgcn_readfirstlane(tid >> 6), lane = tid & 63, wr = wid >> 2, wc = wid & 3, fr = lane & 15, fq = lane >> 4;
    const int K = g.K, nt = K / BK;
    unsigned voffA[2], voffB[2];
#pragma unroll
    for (int i = 0; i < 2; ++i) { int R, C; stage_rc(tid * 16 + i * 8192, R, C); const int Rb = Epi::PERM ? ((R & ~31) + perm32(R & 31)) : R;
        voffA[i] = (unsigned)(R * K + C) * 2u; voffB[i] = (unsigned)(Rb * K + C) * 2u; }
    const size_t kstep = (size_t)(BK * 2);
    const size_t hstep = (size_t)HALF * K * 2;
    const size_t tstep = 2 * hstep;
    const unsigned ldsw = (unsigned)wid * 1024u;
    const int aoff = lds_byte(wr * 64 + fr, fq * 8), boff = lds_byte(wc * 32 + fr, fq * 8);
#define PG8_SA(b, h) (((b) * 2 + (h)) * HTB)
#define PG8_SB(b, h) ((4 + (b) * 2 + (h)) * HTB)
#define PG8_STAGE(bufoff, gbase, voff) do { _Pragma("unroll") for (int _i = 0; _i < 2; ++_i) \
        __builtin_amdgcn_global_load_lds((const unsigned*)((const char*)(gbase) + (voff)[_i]), (PG8_LAS unsigned*)(lds + (bufoff) + ldsw + _i * 8192), 16, 0, 0); } while (0)
#define PG8_LDA(dst, b, h) do { _Pragma("unroll") for (int m = 0; m < 4; ++m) _Pragma("unroll") for (int k = 0; k < 2; ++k) dst[m][k] = *(const PG8_LAS bf16x8*)(lds + PG8_SA(b, h) + aoff + m * 2048 + k * 1024); } while (0)
#define PG8_LDB(dst, b, h) do { _Pragma("unroll") for (int n = 0; n < 2; ++n) _Pragma("unroll") for (int k = 0; k < 2; ++k) dst[n][k] = *(const PG8_LAS bf16x8*)(lds + PG8_SB(b, h) + boff + n * 2048 + k * 1024); } while (0)
#define PG8_MMA(ai, bj, At, Bt) do { __builtin_amdgcn_s_setprio(1); _Pragma("unroll") for (int m = 0; m < 4; ++m) _Pragma("unroll") for (int n = 0; n < 2; ++n) _Pragma("unroll") for (int k = 0; k < 2; ++k) \
        acc[ai][bj][m][n] = __builtin_amdgcn_mfma_f32_16x16x32_bf16(Bt[n][k], At[m][k], acc[ai][bj][m][n], 0, 0, 0); __builtin_amdgcn_s_setprio(0); } while (0)
#define PG8_WAIT_V(n) asm volatile("s_waitcnt vmcnt(" #n ")" ::: "memory")
#define PG8_WAIT_L(n) asm volatile("s_waitcnt lgkmcnt(" #n ")" ::: "memory")
#define PG8_BAR __builtin_amdgcn_s_barrier()
#define PG8_SCHED __builtin_amdgcn_sched_barrier(0)
    Unit cur, nxt; int ui = 0;
    if (!S.next(0, cur)) return;
    f32x4 acc[2][2][4][2];
#pragma unroll
    for (int a = 0; a < 2; ++a)
#pragma unroll
        for (int b = 0; b < 2; ++b)
#pragma unroll
            for (int m = 0; m < 4; ++m)
#pragma unroll
                for (int n = 0; n < 2; ++n) acc[a][b][m][n] = (f32x4){0.f, 0.f, 0.f, 0.f};
    bf16x8 At[4][2], B0[2][2], B1[2][2];
    const char* cA = (const char*)g.A + (size_t)cur.pm * tstep; const char* cB = (const char*)g.Bt + (size_t)cur.pn * tstep;
    S.a_ready(cur);
    if constexpr (SP2) {
        PG8_STAGE(PG8_SB(0, 0), cB, voffB); PG8_STAGE(PG8_SB(0, 1), cB + hstep, voffB); PG8_STAGE(PG8_SA(0, 0), cA, voffA); PG8_STAGE(PG8_SA(0, 1), cA + hstep, voffA);
        if (wr == 1) PG8_BAR;
        PG8_WAIT_V(2); PG8_BAR;
        PG8_STAGE(PG8_SB(1, 0), cB + kstep, voffB); PG8_STAGE(PG8_SA(1, 0), cA + kstep, voffA); PG8_STAGE(PG8_SB(1, 1), cB + hstep + kstep, voffB);
        PG8_WAIT_V(6); PG8_BAR;
    } else {
        PG8_STAGE(PG8_SB(0, 0), cB, voffB); PG8_STAGE(PG8_SA(0, 0), cA, voffA); PG8_STAGE(PG8_SB(0, 1), cB + hstep, voffB); PG8_STAGE(PG8_SA(0, 1), cA + hstep, voffA);
        if (wr == 1) PG8_BAR;
        PG8_WAIT_V(4); PG8_BAR;
        PG8_STAGE(PG8_SB(1, 0), cB + kstep, voffB); PG8_STAGE(PG8_SA(1, 0), cA + kstep, voffA); PG8_STAGE(PG8_SB(1, 1), cB + hstep + kstep, voffB);
        PG8_WAIT_V(6); PG8_BAR;
    }
    for (;;) {
        const bool has_next = S.next(ui + 1, nxt);
        const char* nA = has_next ? (const char*)g.A + (size_t)nxt.pm * tstep : cA; const char* nB = has_next ? (const char*)g.Bt + (size_t)nxt.pn * tstep : cB;
        for (int t = 0; t < nt; t += 2) {
            const bool last = (t == nt - 2);
            const char* a1 = cA + (size_t)(t + 1) * kstep;
            const char* a2 = last ? nA : cA + (size_t)(t + 2) * kstep; const char* b2 = last ? nB : cB + (size_t)(t + 2) * kstep;
            const char* a3 = a2 + kstep; const char* b3 = b2 + kstep;
            if (last && has_next) S.a_ready(nxt);
            if constexpr (SP2) {
            PG8_LDB(B0, 0, 0); PG8_LDB(B1, 0, 1); PG8_SCHED; PG8_LDA(At, 0, 0); PG8_STAGE(PG8_SA(1, 1), a1 + hstep, voffA);
            PG8_WAIT_V(8); PG8_WAIT_L(0); PG8_BAR; PG8_MMA(0, 0, At, B0); PG8_MMA(0, 1, At, B1); PG8_BAR; PG8_SCHED;
            PG8_LDA(At, 0, 1); PG8_STAGE(PG8_SB(0, 0), b2, voffB); PG8_STAGE(PG8_SB(0, 1), b2 + hstep, voffB); PG8_STAGE(PG8_SA(0, 0), a2, voffA);
            PG8_WAIT_V(8); PG8_WAIT_L(0); PG8_BAR; PG8_MMA(1, 0, At, B0); PG8_MMA(1, 1, At, B1); PG8_BAR; PG8_SCHED;
            PG8_LDB(B0, 1, 0); PG8_LDB(B1, 1, 1); PG8_SCHED; PG8_LDA(At, 1, 0); PG8_STAGE(PG8_SA(0, 1), a2 + hstep, voffA);
            PG8_WAIT_V(8); PG8_WAIT_L(0); PG8_BAR; PG8_MMA(0, 0, At, B0); PG8_MMA(0, 1, At, B1); PG8_BAR; PG8_SCHED;
            PG8_LDA(At, 1, 1); PG8_STAGE(PG8_SB(1, 0), b3, voffB); PG8_STAGE(PG8_SB(1, 1), b3 + hstep, voffB); PG8_STAGE(PG8_SA(1, 0), a3, voffA);
            PG8_WAIT_V(8); PG8_WAIT_L(0); PG8_BAR; PG8_MMA(1, 0, At, B0); PG8_MMA(1, 1, At, B1); PG8_BAR; PG8_SCHED;
            } else {
            PG8_LDB(B0, 0, 0); PG8_SCHED; PG8_LDA(At, 0, 0); PG8_STAGE(PG8_SA(1, 1), a1 + hstep, voffA);
            PG8_WAIT_L(8); PG8_BAR; PG8_WAIT_L(0); PG8_MMA(0, 0, At, B0); PG8_BAR; PG8_SCHED;
            PG8_LDB(B1, 0, 1); PG8_STAGE(PG8_SB(0, 0), b2, voffB);
            PG8_BAR; PG8_WAIT_L(0); PG8_MMA(0, 1, At, B1); PG8_BAR;
            PG8_LDA(At, 0, 1); PG8_STAGE(PG8_SA(0, 0), a2, voffA);
            PG8_BAR; PG8_WAIT_L(0); PG8_MMA(1, 0, At, B0); PG8_BAR; PG8_SCHED;
            PG8_STAGE(PG8_SB(0, 1), b2 + hstep, voffB);
            PG8_WAIT_V(6); PG8_BAR; PG8_MMA(1, 1, At, B1); PG8_BAR;
            PG8_LDB(B0, 1, 0); PG8_SCHED; PG8_LDA(At, 1, 0); PG8_STAGE(PG8_SA(0, 1), a2 + hstep, voffA);
            PG8_WAIT_L(8); PG8_BAR; PG8_WAIT_L(0); PG8_MMA(0, 0, At, B0); PG8_BAR; PG8_SCHED;
            PG8_LDB(B1, 1, 1); PG8_STAGE(PG8_SB(1, 0), b3, voffB);
            PG8_BAR; PG8_WAIT_L(0); PG8_MMA(0, 1, At, B1); PG8_BAR;
            PG8_LDA(At, 1, 1); PG8_STAGE(PG8_SA(1, 0), a3, voffA);
            PG8_BAR; PG8_WAIT_L(0); PG8_MMA(1, 0, At, B0); PG8_BAR; PG8_SCHED;
            PG8_STAGE(PG8_SB(1, 1), b3 + hstep, voffB);
            PG8_WAIT_V(6); PG8_BAR; PG8_MMA(1, 1, At, B1); PG8_BAR;
            }
        }
        if constexpr (ALIGN_EPI) { if (wr == 0) PG8_BAR; }
        if constexpr (!Epi::AFTER_DRAIN) { E(acc, cur, wr, wc, fr, fq); S.done(cur); }
        if (!has_next) break;
#pragma unroll
        for (int a = 0; a < 2; ++a)
#pragma unroll
            for (int b = 0; b < 2; ++b)
#pragma unroll
                for (int m = 0; m < 4; ++m)
#pragma unroll
                    for (int n = 0; n < 2; ++n) acc[a][b][m][n] = (f32x4){0.f, 0.f, 0.f, 0.f};
        cur = nxt; cA = nA; cB = nB; ++ui;
        if constexpr (ALIGN_EPI) { if (wr == 1) PG8_BAR; }
    }
    PG8_WAIT_V(0);
    if constexpr (!ALIGN_EPI) { if (wr == 0) PG8_BAR; }
    PG8_BAR;
    if constexpr (Epi::AFTER_DRAIN) { E.fused(acc, cur, wr, wc, fr, fq, lds, wid, lane); S.done(cur); }
#undef PG8_SA
#undef PG8_SB
#undef PG8_STAGE
#undef PG8_LDA
#undef PG8_LDB
#undef PG8_MMA
#undef PG8_WAIT_V
#undef PG8_WAIT_L
#undef PG8_BAR
#undef PG8_SCHED
}
}

#ifndef MK_N_LAUNCHES
#define MK_N_LAUNCHES 1
#endif
constexpr int NB = 8, SEQ = 4096, DM = 1024, DEPTH = 2, NT = NB * SEQ;
constexpr int PW = 3328;
constexpr int C_GQ = 0, C_GK = 256, C_GV = 512, C_GOG = 1024, C_AQ = 1536, C_AK = 2048, C_AV = 2560, C_GLR = 3072;
constexpr int IN_W = 3088, NEXP = 16384;
constexpr float RMS_EPS = 1e-6f;
constexpr int NWAVES = 8, NTHR = 512;
#ifndef USE_XCD_BARRIER
#define USE_XCD_BARRIER 1
#endif
constexpr int CTL_BAR = 8192, CTL_ZERO_BYTES = 65536;
constexpr int LDS_BYTES = 147456;

constexpr size_t MiB = 1u << 20;
constexpr size_t WS_W = 1 * MiB, W_LAYER = 15 * MiB;
constexpr size_t WO_WIN = 0, WO_WOUT = 6656 * 1024, WO_WQ2 = WO_WOUT + 2 * MiB, WO_WG = WO_WQ2 + 4 * MiB, WO_WP = WO_WG + 2 * MiB;
static_assert(WO_WP + 512 * 1024 <= W_LAYER, "weights per layer");
constexpr size_t WS_A = 32 * MiB;
constexpr size_t WS_XN = 288 * MiB;
constexpr size_t WS_C = 352 * MiB;
constexpr size_t WS_D = 416 * MiB;
constexpr size_t WS_PB = 480 * MiB;
constexpr size_t WS_DEC = 496 * MiB;
constexpr size_t WS_END = 497 * MiB;

#define DI __device__ __forceinline__
typedef unsigned short bf16;
typedef short bf16x8 __attribute__((ext_vector_type(8)));
typedef float f32x4 __attribute__((ext_vector_type(4)));
typedef float f32x16 __attribute__((ext_vector_type(16)));
typedef unsigned u32x4 __attribute__((ext_vector_type(4)));
typedef unsigned u32x2 __attribute__((ext_vector_type(2)));
#define MFMA32(a, b, c) __builtin_amdgcn_mfma_f32_32x32x16_bf16((a), (b), (c), 0, 0, 0)
DI float bf2f(unsigned v) { return __uint_as_float(v << 16); }
DI unsigned f2bf(float f) { unsigned u = __float_as_uint(f); return (u + 0x7fffu + ((u >> 16) & 1u)) >> 16; }
DI unsigned pk2(float lo, float hi) { return f2bf(lo) | (f2bf(hi) << 16); }
DI int crow(int reg, int h) { return (reg & 3) + 8 * (reg >> 2) + 4 * h; }
DI float wave_sum(float v) {
#pragma unroll
    for (int o = 1; o < 64; o <<= 1) v += __shfl_xor(v, o);
    return v;
}
DI bf16x8 pack8(const f32x16& x, int s) {
    u32x4 p; p.x = pk2(x[8 * s + 0], x[8 * s + 1]); p.y = pk2(x[8 * s + 2], x[8 * s + 3]); p.z = pk2(x[8 * s + 4], x[8 * s + 5]); p.w = pk2(x[8 * s + 6], x[8 * s + 7]);
    return __builtin_bit_cast(bf16x8, p);
}

struct Args { const float* in[18]; float* out; unsigned char* ws; int ph_lo, ph_hi; };
struct Frame {
    unsigned char* lds; int tid, lane, wave, G, bid;
    const float *x, *p, *norm_mix, *w_in, *g_w2, *g_b, *head_norm, *rel_bias, *w_out, *norm_ffn, *peer_wq, *peer_sk, *peer_u, *peer_v, *norm_ple, *w_ple_gate, *w_ple, *final_norm;
    float* out; unsigned char* ws;
};

DI void win_map(int n, int& src, float& sc) {
    sc = 1.f;
    if (n < 256) { src = n; sc = 0.125f; }
    else if (n < 1024) src = n;
    else if (n < 1536) src = n + 16;
    else if (n < 2048) { src = n + 16; sc = 0.125f; }
    else if (n < 3072) src = n + 16;
    else if (n < 3088) src = n - 3072 + 1024;
    else src = -1;
}
DI void transpose_item(const float* W, int N, int K, bf16* WT, int n0, int k0, bool winmap, float* tile, int tid) {
    const int nl = tid & 63, kq = tid >> 6;
    int src = n0 + nl; float sc = 1.f;
    if (winmap) win_map(n0 + nl, src, sc);
#pragma unroll
    for (int kk = 0; kk < 8; ++kk) { const int k = kq * 8 + kk; tile[k * 65 + nl] = src >= 0 ? W[(size_t)(k0 + k) * N + src] * sc : 0.f; }
    __syncthreads();
    const int r = tid >> 3, c = tid & 7;
    u32x4 o;
    o.x = pk2(tile[(c * 8 + 0) * 65 + r], tile[(c * 8 + 1) * 65 + r]); o.y = pk2(tile[(c * 8 + 2) * 65 + r], tile[(c * 8 + 3) * 65 + r]);
    o.z = pk2(tile[(c * 8 + 4) * 65 + r], tile[(c * 8 + 5) * 65 + r]); o.w = pk2(tile[(c * 8 + 6) * 65 + r], tile[(c * 8 + 7) * 65 + r]);
    *(u32x4*)(WT + (size_t)(n0 + r) * K + k0 + c * 8) = o;
    __syncthreads();
}
DI void wq2_item(const float* wq, const float* sk, bf16* WT, int hp, int k0, float* lds, int tid) {
    float* s_sk = lds;
    float* s_wq = lds + 128 * 132;
#pragma unroll
    for (int i = 0; i < 8; ++i) { const int idx = tid + i * 512, n = idx >> 5, d4 = idx & 31; *(f32x4*)(s_sk + n * 132 + d4 * 4) = *(const f32x4*)(sk + (size_t)hp * 16384 + n * 128 + d4 * 4); }
#pragma unroll
    for (int i = 0; i < 4; ++i) { const int idx = tid + i * 512, k = idx >> 5, d4 = idx & 31; *(f32x4*)(s_wq + k * 132 + d4 * 4) = *(const f32x4*)(wq + (size_t)(k0 + k) * 2048 + hp * 128 + d4 * 4); }
    __syncthreads();
    const int tn = tid & 31, tk = tid >> 5;
    float acc[4][4];
#pragma unroll
    for (int a = 0; a < 4; ++a)
#pragma unroll
        for (int b = 0; b < 4; ++b) acc[a][b] = 0.f;
    for (int d4 = 0; d4 < 32; ++d4) {
        f32x4 av[4], bv[4];
#pragma unroll
        for (int a = 0; a < 4; ++a) av[a] = *(const f32x4*)(s_sk + (tn * 4 + a) * 132 + d4 * 4);
#pragma unroll
        for (int b = 0; b < 4; ++b) bv[b] = *(const f32x4*)(s_wq + (tk * 4 + b) * 132 + d4 * 4);
#pragma unroll
        for (int a = 0; a < 4; ++a)
#pragma unroll
            for (int b = 0; b < 4; ++b) acc[a][b] += av[a][0] * bv[b][0] + av[a][1] * bv[b][1] + av[a][2] * bv[b][2] + av[a][3] * bv[b][3];
    }
#pragma unroll
    for (int a = 0; a < 4; ++a) { u32x2 o; o.x = pk2(acc[a][0], acc[a][1]); o.y = pk2(acc[a][2], acc[a][3]);
        *(u32x2*)(WT + (size_t)(hp * 128 + tn * 4 + a) * 1024 + k0 + tk * 4) = o; }
    __syncthreads();
}
DI void phase_prep(Frame& F) {
    float* tile = (float*)F.lds;
    constexpr int I_WIN = 832, I_WOUT = 256, I_WG = 256, I_WP = 64, I_WQ2 = 256, I_L = I_WIN + I_WOUT + I_WG + I_WP + I_WQ2;
    for (int it = F.bid; it < DEPTH * I_L; it += F.G) {
        const int l = it / I_L; int r = it % I_L;
        bf16* wl = (bf16*)(F.ws + WS_W + (size_t)l * W_LAYER);
        if (r < I_WIN) { transpose_item(F.w_in + (size_t)l * DM * IN_W, IN_W, DM, wl + WO_WIN / 2, (r >> 4) * 64, (r & 15) * 64, true, tile, F.tid); continue; } r -= I_WIN;
        if (r < I_WOUT) { transpose_item(F.w_out + (size_t)l * DM * DM, DM, DM, wl + WO_WOUT / 2, (r >> 4) * 64, (r & 15) * 64, false, tile, F.tid); continue; } r -= I_WOUT;
        if (r < I_WG) { transpose_item(F.w_ple_gate + (size_t)l * DM * DM, DM, DM, wl + WO_WG / 2, (r >> 4) * 64, (r & 15) * 64, false, tile, F.tid); continue; } r -= I_WG;
        if (r < I_WP) { transpose_item(F.w_ple + (size_t)l * 256 * DM, DM, 256, wl + WO_WP / 2, (r >> 2) * 64, (r & 3) * 64, false, tile, F.tid); continue; } r -= I_WP;
        wq2_item(F.peer_wq + (size_t)l * DM * 2048, F.peer_sk + (size_t)l * 16 * 16384, wl + WO_WQ2 / 2, r >> 4, (r & 15) * 64, tile, F.tid);
    }
}

DI void rms_row_to_bf16(const float* xrow, const float* g, bf16* orow, int lane) {
    const f32x4* xr = (const f32x4*)xrow + lane; const f32x4* gr = (const f32x4*)g + lane;
    f32x4 v[4]; float s = 0.f;
#pragma unroll
    for (int j = 0; j < 4; ++j) { v[j] = xr[64 * j]; s += (v[j].x * v[j].x + v[j].y * v[j].y) + (v[j].z * v[j].z + v[j].w * v[j].w); }
    const float rs = rsqrtf(wave_sum(s) * (1.f / DM) + RMS_EPS);
    u32x2* o8 = (u32x2*)orow + lane;
#pragma unroll
    for (int j = 0; j < 4; ++j) { const f32x4 gg = gr[64 * j]; u32x2 o; o.x = pk2(v[j].x * rs * gg.x, v[j].y * rs * gg.y); o.y = pk2(v[j].z * rs * gg.z, v[j].w * rs * gg.w); o8[64 * j] = o; }
}
DI void phase_norm(Frame& F, const float* src, const float* g, bf16* dst) {
    for (int m = F.bid * NWAVES + F.wave; m < NT; m += F.G * NWAVES) rms_row_to_bf16(src + (size_t)m * DM, g, dst + (size_t)m * DM, F.lane);
}
DI void phase_final_norm(Frame& F, const float* g) {
    for (int m = F.bid * NWAVES + F.wave; m < NT; m += F.G * NWAVES) {
        f32x4* xr = (f32x4*)(F.out + (size_t)m * DM) + F.lane; const f32x4* gr = (const f32x4*)g + F.lane;
        f32x4 v[4]; float s = 0.f;
#pragma unroll
        for (int j = 0; j < 4; ++j) { v[j] = xr[64 * j]; s += (v[j].x * v[j].x + v[j].y * v[j].y) + (v[j].z * v[j].z + v[j].w * v[j].w); }
        const float rs = rsqrtf(wave_sum(s) * (1.f / DM) + RMS_EPS);
#pragma unroll
        for (int j = 0; j < 4; ++j) { const f32x4 gg = gr[64 * j]; xr[64 * j] = v[j] * rs * gg; }
    }
}
DI void convert_bf16(Frame& F, const float* src, bf16* dst, size_t n) {
    const size_t n8 = n >> 3;
    for (size_t i = (size_t)F.bid * NTHR + F.tid; i < n8; i += (size_t)F.G * NTHR) {
        const f32x4 a = ((const f32x4*)src)[2 * i], b = ((const f32x4*)src)[2 * i + 1];
        u32x4 o; o.x = pk2(a.x, a.y); o.y = pk2(a.z, a.w); o.z = pk2(b.x, b.y); o.w = pk2(b.z, b.w);
        ((u32x4*)dst)[i] = o;
    }
}

DI void att_unit(Frame& F, int l, int b, int h, int c, const bf16* proj, bf16* ocat) {
    const int tid = F.tid, lane = F.lane, w = F.wave, r = lane & 31, h2 = lane >> 5, qh = w & 1, kg = w >> 1;
    float* tab = (float*)F.lds;
    float* Ot = (float*)(F.lds + 2048);
    float* ML = (float*)(F.lds + 2048 + 8 * 64 * 33 * 4);
    if (tid < 257) tab[tid] = F.rel_bias[(size_t)l * 8 * 257 + h * 257 + tid];
    __syncthreads();
    const int m0 = b * SEQ + c * 64;
    const bf16* qp = proj + (size_t)(m0 + qh * 32 + r) * PW + C_AQ + h * 64 + h2 * 8;
    bf16x8 qf[4];
#pragma unroll
    for (int s = 0; s < 4; ++s) qf[s] = *(const bf16x8*)(qp + s * 16);
    const int nvc = (c < 8 ? c : 8) + 1, kt0 = 18 - 2 * nvc;
    f32x16 o0, o1;
#pragma unroll
    for (int i = 0; i < 16; ++i) { o0[i] = 0.f; o1[i] = 0.f; }
    float mrun = -1e30f, lrun = 0.f;
    const int iq = qh * 32 + r;
    for (int kt = kt0 + kg; kt < 18; kt += 4) {
        const int krow0 = b * SEQ + (c - 8) * 64 + kt * 32;
        const bf16* kp = proj + (size_t)(krow0 + r) * PW + C_AK + h * 64 + h2 * 8;
        bf16x8 kf[4];
#pragma unroll
        for (int s = 0; s < 4; ++s) kf[s] = *(const bf16x8*)(kp + s * 16);
        const bf16* vp = proj + (size_t)krow0 * PW + C_AV + h * 64 + r;
        bf16x8 vf[2][2];
#pragma unroll
        for (int s = 0; s < 2; ++s)
#pragma unroll
            for (int dt = 0; dt < 2; ++dt)
#pragma unroll
                for (int j = 0; j < 8; ++j) vf[s][dt][j] = (short)vp[(size_t)(16 * s + 8 * (j >> 2) + 4 * h2 + (j & 3)) * PW + dt * 32];
        f32x16 sacc;
#pragma unroll
        for (int i = 0; i < 16; ++i) sacc[i] = 0.f;
#pragma unroll
        for (int s = 0; s < 4; ++s) sacc = MFMA32(kf[s], qf[s], sacc);
        const int jb = kt * 32 + 4 * h2;
        float tmax = -1e30f;
#pragma unroll
        for (int i = 0; i < 16; ++i) { const int j = jb + (i & 3) + 8 * (i >> 2); int rel = iq + 512 - j; rel = rel < -128 ? -128 : (rel > 128 ? 128 : rel);
            sacc[i] += tab[rel + 128]; tmax = fmaxf(tmax, sacc[i]); }
        tmax = fmaxf(tmax, __shfl_xor(tmax, 32));
        const float mnew = fmaxf(mrun, tmax), alpha = __expf(mrun - mnew);
        float psum = 0.f;
#pragma unroll
        for (int i = 0; i < 16; ++i) { const float p = __expf(sacc[i] - mnew); sacc[i] = p; psum += p; }
        lrun = lrun * alpha + psum; mrun = mnew;
#pragma unroll
        for (int i = 0; i < 16; ++i) { o0[i] *= alpha; o1[i] *= alpha; }
#pragma unroll
        for (int s = 0; s < 2; ++s) { const bf16x8 pf = pack8(sacc, s); o0 = MFMA32(vf[s][0], pf, o0); o1 = MFMA32(vf[s][1], pf, o1); }
    }
    lrun += __shfl_xor(lrun, 32);
#pragma unroll
    for (int i = 0; i < 16; ++i) { const int d = crow(i, h2); Ot[(w * 64 + d) * 33 + r] = o0[i]; Ot[(w * 64 + 32 + d) * 33 + r] = o1[i]; }
    if (h2 == 0) { ML[w * 64 + r] = mrun; ML[w * 64 + 32 + r] = lrun; }
    __syncthreads();
    {
        const int q = tid >> 3, dg = tid & 7, qq = q & 31, qhh = q >> 5;
        float mg[4], lg[4], ms = -1e30f;
#pragma unroll
        for (int g = 0; g < 4; ++g) { const int ww = g * 2 + qhh; mg[g] = ML[ww * 64 + qq]; lg[g] = ML[ww * 64 + 32 + qq]; ms = fmaxf(ms, mg[g]); }
        float L = 0.f, wg[4];
#pragma unroll
        for (int g = 0; g < 4; ++g) { wg[g] = __expf(mg[g] - ms); L += wg[g] * lg[g]; }
        const float inv = 1.f / L;
        float ov[8];
#pragma unroll
        for (int dd = 0; dd < 8; ++dd) { float a = 0.f;
#pragma unroll
            for (int g = 0; g < 4; ++g) a += wg[g] * Ot[((g * 2 + qhh) * 64 + dg * 8 + dd) * 33 + qq];
            ov[dd] = a * inv; }
        u32x4 o; o.x = pk2(ov[0], ov[1]); o.y = pk2(ov[2], ov[3]); o.z = pk2(ov[4], ov[5]); o.w = pk2(ov[6], ov[7]);
        *(u32x4*)(ocat + (size_t)(m0 + q) * DM + 512 + h * 64 + dg * 8) = o;
    }
    __syncthreads();
}

constexpr int GL_GLR = 0, GL_W2 = 4096, GL_B2 = 8192, GL_CUM = 8448, GL_TOT = GL_CUM + 16384, GL_VT = GL_TOT + 2048, GL_KS = GL_VT + 128 * 72 * 2, GL_QE = GL_KS + 64 * 72 * 2, GL_KE = GL_QE + 64 * 72 * 2,
              GL_QG = GL_KE + 64 * 72 * 2, GL_OS = GL_QG + 64 * 72 * 2, GL_SSQ = GL_OS + 64 * 132 * 4, GL_END = GL_SSQ + 1024;
static_assert(GL_END <= LDS_BYTES && GL_VT % 16 == 0 && GL_KS % 16 == 0 && GL_QE % 16 == 0 && GL_OS % 16 == 0, "GLA LDS map");
DI float log_sigmoid(float x) { return fminf(x, 0.f) - log1pf(__expf(-fabsf(x))); }
DI void gla_cum(Frame& F, int l, int h, int m0, const bf16* proj) {
    const int tid = F.tid;
    float* Gl = (float*)(F.lds + GL_GLR); float* W2 = (float*)(F.lds + GL_W2); float* B2 = (float*)(F.lds + GL_B2); float* CUM = (float*)(F.lds + GL_CUM); float* TOT = (float*)(F.lds + GL_TOT);
    if (tid < 128) { const int t = tid >> 1, hf = tid & 1; const u32x4 v = *(const u32x4*)(proj + (size_t)(m0 + t) * PW + C_GLR + hf * 8);
        float* g = Gl + t * 16 + hf * 8; g[0] = bf2f(v.x & 0xffffu); g[1] = bf2f(v.x >> 16); g[2] = bf2f(v.y & 0xffffu); g[3] = bf2f(v.y >> 16); g[4] = bf2f(v.z & 0xffffu); g[5] = bf2f(v.z >> 16); g[6] = bf2f(v.w & 0xffffu); g[7] = bf2f(v.w >> 16); }
#pragma unroll
    for (int i = 0; i < 2; ++i) { const int idx = tid + i * 512, rr = idx >> 6, d = idx & 63; W2[idx] = F.g_w2[(size_t)l * 16 * 256 + rr * 256 + h * 64 + d]; }
    if (tid < 64) B2[tid] = F.g_b[(size_t)l * 256 + h * 64 + tid];
    __syncthreads();
    const int d = tid & 63, tq = tid >> 6;
    float w2r[16];
#pragma unroll
    for (int rr = 0; rr < 16; ++rr) w2r[rr] = W2[rr * 64 + d];
    const float bb = B2[d];
    float run = 0.f;
#pragma unroll
    for (int tt = 0; tt < 8; ++tt) { const int t = tq * 8 + tt; float x = bb;
#pragma unroll
        for (int rr = 0; rr < 16; ++rr) x += Gl[t * 16 + rr] * w2r[rr];
        run += log_sigmoid(x) * (1.f / 16.f); CUM[t * 64 + d] = run; }
    TOT[tq * 64 + d] = run;
    __syncthreads();
    float off = 0.f;
    for (int q = 0; q < tq; ++q) off += TOT[q * 64 + d];
#pragma unroll
    for (int tt = 0; tt < 8; ++tt) CUM[(tq * 8 + tt) * 64 + d] += off;
    __syncthreads();
}
DI void gla_stage_vt(Frame& F, int h, int m0, const bf16* proj) {
    const int tid = F.tid, e = tid & 127, cq = tid >> 7;
    bf16* Vt = (bf16*)(F.lds + GL_VT);
    unsigned short v[16];
#pragma unroll
    for (int i = 0; i < 16; ++i) v[i] = proj[(size_t)(m0 + cq * 16 + i) * PW + C_GV + h * 128 + e];
    u32x4 a, b2;
    a.x = v[0] | ((unsigned)v[1] << 16); a.y = v[2] | ((unsigned)v[3] << 16); a.z = v[4] | ((unsigned)v[5] << 16); a.w = v[6] | ((unsigned)v[7] << 16);
    b2.x = v[8] | ((unsigned)v[9] << 16); b2.y = v[10] | ((unsigned)v[11] << 16); b2.z = v[12] | ((unsigned)v[13] << 16); b2.w = v[14] | ((unsigned)v[15] << 16);
    *(u32x4*)(Vt + e * 72 + cq * 16) = a; *(u32x4*)(Vt + e * 72 + cq * 16 + 8) = b2;
}
DI void gla_kv_unit(Frame& F, int l, int b, int h, int c, const bf16* proj, float* KVt, float* dec) {
    const int tid = F.tid, lane = F.lane, w = F.wave, r = lane & 31, h2 = lane >> 5;
    const int m0 = b * SEQ + c * 64, unit = (b * 4 + h) * 64 + c;
    float* CUM = (float*)(F.lds + GL_CUM); bf16* Vt = (bf16*)(F.lds + GL_VT); bf16* Ks = (bf16*)(F.lds + GL_KS);
    gla_cum(F, l, h, m0, proj);
    {
        const int d = tid & 63, tq = tid >> 6; const float last = CUM[63 * 64 + d];
        float kv[8];
#pragma unroll
        for (int tt = 0; tt < 8; ++tt) { const int t = tq * 8 + tt; kv[tt] = bf2f(proj[(size_t)(m0 + t) * PW + C_GK + h * 64 + d]) * __expf(last - CUM[t * 64 + d]); }
        u32x4 o; o.x = pk2(kv[0], kv[1]); o.y = pk2(kv[2], kv[3]); o.z = pk2(kv[4], kv[5]); o.w = pk2(kv[6], kv[7]);
        *(u32x4*)(Ks + d * 72 + tq * 8) = o;
        if (tid < 64) dec[(size_t)unit * 64 + tid] = __expf(last);
    }
    gla_stage_vt(F, h, m0, proj);
    __syncthreads();
    {
        const int et = w >> 1, dt = w & 1;
        f32x16 acc;
#pragma unroll
        for (int i = 0; i < 16; ++i) acc[i] = 0.f;
#pragma unroll
        for (int s = 0; s < 4; ++s) { const bf16x8 a = *(const bf16x8*)(Vt + (et * 32 + r) * 72 + 16 * s + 8 * h2); const bf16x8 bb = *(const bf16x8*)(Ks + (dt * 32 + r) * 72 + 16 * s + 8 * h2); acc = MFMA32(a, bb, acc); }
        float* o = KVt + (size_t)unit * 8192;
#pragma unroll
        for (int i = 0; i < 16; ++i) o[(et * 32 + crow(i, h2)) * 64 + dt * 32 + r] = acc[i];
    }
    __syncthreads();
}
DI void phase_scan(Frame& F, float* KVt, const float* dec) {
    for (int idx = F.bid * NTHR + F.tid; idx < 32 * 8192; idx += F.G * NTHR) {
        const int bh = idx >> 13, ed = idx & 8191, d = ed & 63;
        float* p = KVt + (size_t)bh * 64 * 8192 + ed; const float* dc = dec + (size_t)bh * 64 * 64 + d;
        float S = 0.f;
#pragma unroll 8
        for (int n = 0; n < 64; ++n) { const float kv = p[(size_t)n * 8192], dcy = dc[n * 64]; p[(size_t)n * 8192] = S; S = dcy * S + kv; }
    }
}
DI void gla_out_unit(Frame& F, int l, int b, int h, int c, const bf16* proj, const float* prevT, bf16* ocat) {
    const int tid = F.tid, lane = F.lane, w = F.wave, r = lane & 31, h2 = lane >> 5;
    const int m0 = b * SEQ + c * 64, unit = (b * 4 + h) * 64 + c;
    float* CUM = (float*)(F.lds + GL_CUM); bf16* Vt = (bf16*)(F.lds + GL_VT); bf16* Qe = (bf16*)(F.lds + GL_QE); bf16* Ke = (bf16*)(F.lds + GL_KE); bf16* Qg = (bf16*)(F.lds + GL_QG);
    float* Os = (float*)(F.lds + GL_OS);
    gla_cum(F, l, h, m0, proj);
    {
        const int d = tid & 63, tq = tid >> 6; const float mid = CUM[32 * 64 + d];
#pragma unroll
        for (int tt = 0; tt < 8; ++tt) { const int t = tq * 8 + tt; const float cm = CUM[t * 64 + d];
            const float q = bf2f(proj[(size_t)(m0 + t) * PW + C_GQ + h * 64 + d]), k = bf2f(proj[(size_t)(m0 + t) * PW + C_GK + h * 64 + d]);
            Qe[t * 72 + d] = (bf16)f2bf(q * __expf(cm - mid)); Ke[t * 72 + d] = (bf16)f2bf(k * __expf(mid - cm)); Qg[t * 72 + d] = (bf16)f2bf(q * __expf(cm)); }
    }
    gla_stage_vt(F, h, m0, proj);
    __syncthreads();
    {
        const int et = w >> 1, it = w & 1;
        f32x16 o;
#pragma unroll
        for (int i = 0; i < 16; ++i) o[i] = 0.f;
        const float* pp = prevT + (size_t)unit * 8192 + (et * 32 + r) * 64 + 8 * h2;
#pragma unroll
        for (int s = 0; s < 4; ++s) { const f32x4 p0 = *(const f32x4*)(pp + 16 * s), p1 = *(const f32x4*)(pp + 16 * s + 4);
            u32x4 pa; pa.x = pk2(p0.x, p0.y); pa.y = pk2(p0.z, p0.w); pa.z = pk2(p1.x, p1.y); pa.w = pk2(p1.z, p1.w);
            const bf16x8 bq = *(const bf16x8*)(Qg + (it * 32 + r) * 72 + 16 * s + 8 * h2);
            o = MFMA32(__builtin_bit_cast(bf16x8, pa), bq, o); }
        for (int jt = 0; jt <= it; ++jt) {
            f32x16 X;
#pragma unroll
            for (int i = 0; i < 16; ++i) X[i] = 0.f;
#pragma unroll
            for (int s = 0; s < 4; ++s) { const bf16x8 a = *(const bf16x8*)(Ke + (jt * 32 + r) * 72 + 16 * s + 8 * h2); const bf16x8 bb = *(const bf16x8*)(Qe + (it * 32 + r) * 72 + 16 * s + 8 * h2); X = MFMA32(a, bb, X); }
            if (jt == it) {
#pragma unroll
                for (int i = 0; i < 16; ++i) if (crow(i, h2) > r) X[i] = 0.f;
            }
#pragma unroll
            for (int s = 0; s < 2; ++s) { const bf16x8 pf = pack8(X, s);
                const u32x2 lo = *(const u32x2*)(Vt + (et * 32 + r) * 72 + jt * 32 + 16 * s + 4 * h2), hi = *(const u32x2*)(Vt + (et * 32 + r) * 72 + jt * 32 + 16 * s + 8 + 4 * h2);
                u32x4 va; va.x = lo.x; va.y = lo.y; va.z = hi.x; va.w = hi.y;
                o = MFMA32(__builtin_bit_cast(bf16x8, va), pf, o); }
        }
#pragma unroll
        for (int i = 0; i < 16; ++i) Os[(it * 32 + r) * 132 + et * 32 + crow(i, h2)] = o[i];
    }
    __syncthreads();
    {
        const int i = tid >> 3, ec = tid & 7, e0 = ec * 16;
        float v[16]; float ss = 0.f;
#pragma unroll
        for (int k = 0; k < 4; ++k) { const f32x4 t = *(const f32x4*)(Os + i * 132 + e0 + 4 * k); v[4 * k] = t.x; v[4 * k + 1] = t.y; v[4 * k + 2] = t.z; v[4 * k + 3] = t.w; ss += (t.x * t.x + t.y * t.y) + (t.z * t.z + t.w * t.w); }
        ss += __shfl_xor(ss, 1); ss += __shfl_xor(ss, 2); ss += __shfl_xor(ss, 4);
        const float rs = rsqrtf(ss * (1.f / 128.f) + RMS_EPS);
        const u32x4 g0 = *(const u32x4*)(proj + (size_t)(m0 + i) * PW + C_GOG + h * 128 + e0), g1 = *(const u32x4*)(proj + (size_t)(m0 + i) * PW + C_GOG + h * 128 + e0 + 8);
        const unsigned gw[8] = {g0.x, g0.y, g0.z, g0.w, g1.x, g1.y, g1.z, g1.w};
        const float* hn = F.head_norm + (size_t)l * 128 + e0;
        unsigned ow[8];
#pragma unroll
        for (int k = 0; k < 8; ++k) { const float ga = bf2f(gw[k] & 0xffffu), gb = bf2f(gw[k] >> 16);
            const float a = v[2 * k] * rs * hn[2 * k] * (ga / (1.f + __expf(-ga))), bq = v[2 * k + 1] * rs * hn[2 * k + 1] * (gb / (1.f + __expf(-gb)));
            ow[k] = pk2(a, bq); }
        u32x4 o0, o1; o0.x = ow[0]; o0.y = ow[1]; o0.z = ow[2]; o0.w = ow[3]; o1.x = ow[4]; o1.y = ow[5]; o1.z = ow[6]; o1.w = ow[7];
        *(u32x4*)(ocat + (size_t)(m0 + i) * DM + h * 128 + e0) = o0; *(u32x4*)(ocat + (size_t)(m0 + i) * DM + h * 128 + e0 + 8) = o1;
    }
    __syncthreads();
}

DI unsigned ord_f32(float v) { const unsigned b = __float_as_uint(v); return (b & 0x80000000u) ? ~b : (b | 0x80000000u); }
DI void topk_tile(Frame& F, int tile, const float* sc, int* eout, float* gout) {
    const int tid = F.tid;
    float* S = (float*)F.lds;
    const float* src = sc + (size_t)tile * 32768;
#pragma unroll 4
    for (int i = 0; i < 16; ++i) { const int idx = tid + i * 512, R = idx >> 5, c4 = idx & 31; const f32x4 v = *(const f32x4*)(src + (size_t)idx * 4);
        float* d = S + R * 129 + c4 * 4; d[0] = v.x; d[1] = v.y; d[2] = v.z; d[3] = v.w; }
    __syncthreads();
    float tv[16]; int ti[16];
    if (tid < 256) {
        unsigned tk[16];
#pragma unroll
        for (int k = 0; k < 16; ++k) tk[k] = 0u;
        const float* row = S + tid * 129;
#pragma unroll 4
        for (int n = 0; n < 128; ++n) { unsigned key = (ord_f32(row[n]) & ~127u) | (unsigned)(127 - n);
#pragma unroll
            for (int k = 0; k < 16; ++k) { const unsigned hi = tk[k] > key ? tk[k] : key; key = tk[k] > key ? key : tk[k]; tk[k] = hi; } }
#pragma unroll
        for (int k = 0; k < 16; ++k) { ti[k] = 127 - (int)(tk[k] & 127u); tv[k] = row[ti[k]]; }
    }
    __syncthreads();
    float* LV = (float*)F.lds; int* LI = (int*)(F.lds + 16384);
    if (tid < 256) {
#pragma unroll
        for (int k = 0; k < 16; ++k) { LV[tid * 16 + k] = tv[k]; LI[tid * 16 + k] = ti[k]; }
    }
    __syncthreads();
    if (tid < 128) {
        const int R1 = 2 * tid, R2 = 2 * tid + 1;
        float s1[16], s2[16];
#pragma unroll
        for (int k = 0; k < 16; ++k) { s1[k] = LV[R1 * 16 + k]; s2[k] = LV[R2 * 16 + k]; }
        unsigned tk[16];
#pragma unroll
        for (int k = 0; k < 16; ++k) tk[k] = 0u;
#pragma unroll
        for (int i = 0; i < 16; ++i)
#pragma unroll
            for (int j = 0; j < 16; ++j)
                if ((i + 1) * (j + 1) <= 16) { unsigned key = (ord_f32(s1[i] + s2[j]) & ~255u) | (unsigned)(255 - (i * 16 + j));
#pragma unroll
                    for (int k = 0; k < 16; ++k) { const unsigned hi = tk[k] > key ? tk[k] : key; key = tk[k] > key ? key : tk[k]; tk[k] = hi; } }
        float top[16]; int ee[16]; float mx = -1e30f;
#pragma unroll
        for (int k = 0; k < 16; ++k) { const int cid = 255 - (int)(tk[k] & 255u), i = cid >> 4, j = cid & 15;
            top[k] = LV[R1 * 16 + i] + LV[R2 * 16 + j]; ee[k] = LI[R1 * 16 + i] * 128 + LI[R2 * 16 + j]; mx = fmaxf(mx, top[k]); }
        float sum = 0.f;
#pragma unroll
        for (int k = 0; k < 16; ++k) { top[k] = __expf(top[k] - mx); sum += top[k]; }
        const float inv = 1.f / sum;
        const int t = tile * 16 + (tid >> 3), hh = tid & 7;
        int* eo = eout + (size_t)t * 128 + hh * 16; float* go = gout + (size_t)t * 128 + hh * 16;
#pragma unroll
        for (int k = 0; k < 16; ++k) { eo[k] = ee[k]; go[k] = top[k] * inv; }
    }
    __syncthreads();
}

typedef float f32x2 __attribute__((ext_vector_type(2)));
DI unsigned pack4_fp8(float a, float b, float c, float d) { int w = 0; w = __builtin_amdgcn_cvt_pk_fp8_f32(a, b, w, false); w = __builtin_amdgcn_cvt_pk_fp8_f32(c, d, w, true); return (unsigned)w; }
DI float wave_max(float v) {
#pragma unroll
    for (int o = 1; o < 64; o <<= 1) v = fmaxf(v, __shfl_xor(v, o));
    return v;
}
DI void convert_rows_fp8(Frame& F, const float* src, unsigned char* dst, float* rscale, bool vslice) {
    const int lane = F.lane;
    for (int e = F.bid * NWAVES + F.wave; e < NEXP; e += F.G * NWAVES) {
        const f32x4* r = (const f32x4*)(src + (size_t)e * DM) + lane * 4;
        f32x4 v[4]; float mx = 0.f;
#pragma unroll
        for (int j = 0; j < 4; ++j) { v[j] = r[j]; mx = fmaxf(mx, fmaxf(fmaxf(fabsf(v[j].x), fabsf(v[j].y)), fmaxf(fabsf(v[j].z), fabsf(v[j].w)))); }
        mx = wave_max(mx);
        const float s = mx > 0.f ? 240.f / mx : 1.f, inv = mx > 0.f ? mx * (1.f / 240.f) : 1.f;
        u32x4 o; o.x = pack4_fp8(v[0].x * s, v[0].y * s, v[0].z * s, v[0].w * s); o.y = pack4_fp8(v[1].x * s, v[1].y * s, v[1].z * s, v[1].w * s);
        o.z = pack4_fp8(v[2].x * s, v[2].y * s, v[2].z * s, v[2].w * s); o.w = pack4_fp8(v[3].x * s, v[3].y * s, v[3].z * s, v[3].w * s);
        if (!vslice) *(u32x4*)(dst + (size_t)e * DM + lane * 16) = o;
        else *(u32x4*)(dst + ((size_t)(lane >> 3) * NEXP + e) * 128 + (lane & 7) * 16) = o;
        if (lane == 0) rscale[e] = inv;
    }
}
DI unsigned xcc_id() { return (unsigned)__builtin_amdgcn_s_getreg((3 << 11) | 20) & 7u; }
DI unsigned wave_dequeue(unsigned* ctr, int lane) { unsigned v = 0; if (lane == 0) v = __hip_atomic_fetch_add(ctr, 1u, __ATOMIC_RELAXED, __HIP_MEMORY_SCOPE_AGENT); return (unsigned)__builtin_amdgcn_readfirstlane((int)v); }
constexpr int PEER_ITEM_TOK = 32, PEER_ITEMS = NT / PEER_ITEM_TOK;
struct PeerMetaU { int ea, eb; u32x4 xa, xb; };
struct PeerMetaV { int ea, eb; float ha, hb; f32x2 hv; };
DI PeerMetaU peer_meta_u(int lane, int t, int sl, const bf16* xn, const int* E) {
    PeerMetaU m; m.ea = E[(size_t)t * 128 + lane]; m.eb = E[(size_t)t * 128 + 64 + lane];
    const bf16* xp = xn + (size_t)t * DM + sl * 128 + (lane & 7) * 16; m.xa = *(const u32x4*)xp; m.xb = *(const u32x4*)(xp + 8); return m;
}
DI PeerMetaV peer_meta_v(int lane, int t, int sl, const int* E, const float* hid, const float* h) {
    PeerMetaV m; m.ea = E[(size_t)t * 128 + lane]; m.eb = E[(size_t)t * 128 + 64 + lane]; m.ha = hid[(size_t)t * 128 + lane]; m.hb = hid[(size_t)t * 128 + 64 + lane];
    m.hv = *(const f32x2*)(h + (size_t)t * DM + sl * 128 + (lane & 7) * 16 + (lane >> 3) * 2); return m;
}
struct PeerRows { u32x4 w[16]; };
DI void peer_load_rows(int lane, int sl, int ea, int eb, const unsigned char* T8s, PeerRows& R) {
    const int g = lane >> 3, sub = lane & 7;
    const unsigned tb = (unsigned)sl * (NEXP * 128u) + (unsigned)sub * 16u;
#pragma unroll
    for (int I = 0; I < 16; ++I) { const unsigned ek = (unsigned)__shfl(I < 8 ? ea : eb, (I & 7) * 8 + g); R.w[I] = *(const u32x4*)(T8s + (size_t)(tb + ek * 128u)); }
}
DI void peer_u_visit(int lane, int t, int sl, const PeerMetaU& m, const PeerRows& R, float* part) {
    const int g = lane >> 3;
    f32x2 xp[8];
    { const unsigned wv[8] = {m.xa.x, m.xa.y, m.xa.z, m.xa.w, m.xb.x, m.xb.y, m.xb.z, m.xb.w};
#pragma unroll
      for (int k = 0; k < 8; ++k) { xp[k].x = bf2f(wv[k] & 0xffffu); xp[k].y = __uint_as_float(wv[k] & 0xffff0000u); } }
    float s[16];
#pragma unroll
    for (int I = 0; I < 16; ++I) {
        const unsigned wv[4] = {R.w[I].x, R.w[I].y, R.w[I].z, R.w[I].w};
        f32x2 s2 = {0.f, 0.f};
#pragma unroll
        for (int k = 0; k < 4; ++k) { s2 = __builtin_amdgcn_cvt_pk_f32_fp8((int)wv[k], false) * xp[2 * k] + s2; s2 = __builtin_amdgcn_cvt_pk_f32_fp8((int)wv[k], true) * xp[2 * k + 1] + s2; }
        s[I] = s2.x + s2.y;
    }
    const bool b2 = (lane & 4) != 0, b1 = (lane & 2) != 0, b0 = (lane & 1) != 0;
    float p[8], q[4], r[2];
#pragma unroll
    for (int j = 0; j < 8; ++j) { const float keep = b2 ? s[8 + j] : s[j], send = b2 ? s[j] : s[8 + j]; p[j] = keep + __shfl_xor(send, 4); }
#pragma unroll
    for (int j = 0; j < 4; ++j) { const float keep = b1 ? p[4 + j] : p[j], send = b1 ? p[j] : p[4 + j]; q[j] = keep + __shfl_xor(send, 2); }
#pragma unroll
    for (int j = 0; j < 2; ++j) { const float keep = b0 ? q[2 + j] : q[j], send = b0 ? q[j] : q[2 + j]; r[j] = keep + __shfl_xor(send, 1); }
    const int I0 = (b2 ? 8 : 0) + (b1 ? 4 : 0) + (b0 ? 2 : 0);
    float* pp = part + ((size_t)sl * NT + t) * 128;
#pragma unroll
    for (int j = 0; j < 2; ++j) { const int I = I0 + j; pp[64 * (I >> 3) + 8 * (I & 7) + g] = r[j]; }
}
DI void peer_v_visit(int lane, int t, int sl, const PeerMetaV& m, const PeerRows& R, float* h) {
    const int g = lane >> 3, sub = lane & 7;
    float hk[16];
#pragma unroll
    for (int I = 0; I < 16; ++I) hk[I] = __shfl(I < 8 ? m.ha : m.hb, (I & 7) * 8 + g);
    f32x2 o[8];
#pragma unroll
    for (int k = 0; k < 8; ++k) o[k] = (f32x2){0.f, 0.f};
#pragma unroll
    for (int I = 0; I < 16; ++I) {
        const unsigned wv[4] = {R.w[I].x, R.w[I].y, R.w[I].z, R.w[I].w}; const f32x2 h2 = {hk[I], hk[I]};
#pragma unroll
        for (int k = 0; k < 4; ++k) { o[2 * k] = __builtin_amdgcn_cvt_pk_f32_fp8((int)wv[k], false) * h2 + o[2 * k]; o[2 * k + 1] = __builtin_amdgcn_cvt_pk_f32_fp8((int)wv[k], true) * h2 + o[2 * k + 1]; }
    }
    const bool b5 = (lane & 32) != 0, b4 = (lane & 16) != 0, b3 = (lane & 8) != 0;
    f32x2 p[4];
#pragma unroll
    for (int k = 0; k < 4; ++k) { const f32x2 keep = b5 ? o[4 + k] : o[k], send = b5 ? o[k] : o[4 + k]; f32x2 rc; rc.x = __shfl_xor(send.x, 32); rc.y = __shfl_xor(send.y, 32); p[k] = keep + rc; }
    f32x2 q[2];
#pragma unroll
    for (int k = 0; k < 2; ++k) { const f32x2 keep = b4 ? p[2 + k] : p[k], send = b4 ? p[k] : p[2 + k]; f32x2 rc; rc.x = __shfl_xor(send.x, 16); rc.y = __shfl_xor(send.y, 16); q[k] = keep + rc; }
    f32x2 r1;
    { const f32x2 keep = b3 ? q[1] : q[0], send = b3 ? q[0] : q[1]; f32x2 rc; rc.x = __shfl_xor(send.x, 8); rc.y = __shfl_xor(send.y, 8); r1 = keep + rc; }
    *(f32x2*)(h + (size_t)t * DM + sl * 128 + sub * 16 + g * 2) = m.hv + r1;
}
template <bool VSIDE>
DI void phase_peer(Frame& F, unsigned* ctr  , const bf16* xn, const int* E, const unsigned char* T8s, const float* hid, float* part, float* hbuf) {
    const unsigned xcc = xcc_id(); const int lane = F.lane;
    for (int so = 0; so < 8; ++so) {
        const int sl = (int)((xcc + (unsigned)so) & 7u);
        for (;;) {
            const unsigned item = wave_dequeue(ctr + 64 * sl, lane);
            if (item >= (unsigned)PEER_ITEMS) break;
            const int t0 = (int)item * PEER_ITEM_TOK;
#define PEER_CL(x) ((x) < PEER_ITEM_TOK ? (x) : PEER_ITEM_TOK - 1)
            if (VSIDE) {
                PeerMetaV m0 = peer_meta_v(lane, t0, sl, E, hid, hbuf), m1 = peer_meta_v(lane, t0 + 1, sl, E, hid, hbuf);
                PeerRows ra, rb; peer_load_rows(lane, sl, m0.ea, m0.eb, T8s, ra);
                for (int tt = 0; tt < PEER_ITEM_TOK; tt += 2) {
                    const PeerMetaV m2 = peer_meta_v(lane, t0 + PEER_CL(tt + 2), sl, E, hid, hbuf);
                    peer_load_rows(lane, sl, m1.ea, m1.eb, T8s, rb); __builtin_amdgcn_sched_barrier(0);
                    peer_v_visit(lane, t0 + tt, sl, m0, ra, hbuf); __builtin_amdgcn_sched_barrier(0);
                    const PeerMetaV m3 = peer_meta_v(lane, t0 + PEER_CL(tt + 3), sl, E, hid, hbuf);
                    peer_load_rows(lane, sl, m2.ea, m2.eb, T8s, ra); __builtin_amdgcn_sched_barrier(0);
                    peer_v_visit(lane, t0 + tt + 1, sl, m1, rb, hbuf); __builtin_amdgcn_sched_barrier(0);
                    m0 = m2; m1 = m3;
                }
            } else {
                PeerMetaU m0 = peer_meta_u(lane, t0, sl, xn, E), m1 = peer_meta_u(lane, t0 + 1, sl, xn, E);
                PeerRows ra, rb; peer_load_rows(lane, sl, m0.ea, m0.eb, T8s, ra);
                for (int tt = 0; tt < PEER_ITEM_TOK; tt += 2) {
                    const PeerMetaU m2 = peer_meta_u(lane, t0 + PEER_CL(tt + 2), sl, xn, E);
                    peer_load_rows(lane, sl, m1.ea, m1.eb, T8s, rb); __builtin_amdgcn_sched_barrier(0);
                    peer_u_visit(lane, t0 + tt, sl, m0, ra, part); __builtin_amdgcn_sched_barrier(0);
                    const PeerMetaU m3 = peer_meta_u(lane, t0 + PEER_CL(tt + 3), sl, xn, E);
                    peer_load_rows(lane, sl, m2.ea, m2.eb, T8s, ra); __builtin_amdgcn_sched_barrier(0);
                    peer_u_visit(lane, t0 + tt + 1, sl, m1, rb, part); __builtin_amdgcn_sched_barrier(0);
                    m0 = m2; m1 = m3;
                }
            }
        }
    }
}
DI void phase_peer_hid(Frame& F, const int* E, const float* Gt, const float* part, const float* usc, const float* vsc, float* hid) {
    for (size_t i = (size_t)F.bid * NTHR + F.tid; i < (size_t)NT * 128; i += (size_t)F.G * NTHR) {
        float a = 0.f;
#pragma unroll
        for (int sl = 0; sl < 8; ++sl) a += part[(size_t)sl * NT * 128 + i];
        const int e = E[i]; a *= usc[e];
        hid[i] = Gt[i] * (0.5f * a * (1.f + erff(a * 0.70710678118654752f))) * vsc[e];
    }
}

#define LAS __attribute__((address_space(3)))
#define XB_TMO      128
#define XB_XCNT(j)  (256  + 64 * (j))
#define XB_XSUB(j)  (1280 + 64 * (j))
#define XB_XGEN(j)  (2304 + 64 * (j))
#define XB_TOP      3328
#define XB_TOPGEN   3392
#define XCD_BAR_WORDS 3456
#define XB_SPIN_CAP (1u << 18)

__device__ __forceinline__ unsigned xb_ld(unsigned* p)              { return __hip_atomic_load(p, __ATOMIC_RELAXED, __HIP_MEMORY_SCOPE_AGENT); }
__device__ __forceinline__ unsigned xb_add(unsigned* p, unsigned v) { return __hip_atomic_fetch_add(p, v, __ATOMIC_RELAXED, __HIP_MEMORY_SCOPE_AGENT); }
__device__ __forceinline__ unsigned xb_xcc_id() { return (unsigned)__builtin_amdgcn_s_getreg((3 << 11) | 20) & 0xFu; }
#define XB_SPIN(cond, bar) do { unsigned _sp = 0; while (cond) { __builtin_amdgcn_s_sleep(1); \
    if ((++_sp & 255u) == 0u) { if (xb_ld(&(bar)[XB_TMO])) break; if (_sp > XB_SPIN_CAP) { atomicAdd(&(bar)[XB_TMO], 1u); break; } } } } while (0)

struct XcdBarrier {
    unsigned* bar; unsigned x;
    volatile LAS unsigned* st;
};

__device__ __forceinline__ XcdBarrier xcd_barrier_post(unsigned* bar, volatile LAS unsigned* st) {
    XcdBarrier b; b.bar = bar; b.x = xb_xcc_id(); b.st = st;
    if (threadIdx.x == 0) (void)xb_add(&bar[XB_XCNT(b.x)], 1u);
    return b;
}
__device__ __forceinline__ void xcd_barrier_complete(unsigned* bar, unsigned x, unsigned& nloc, unsigned& nx) {
    const unsigned G = gridDim.x * gridDim.y * gridDim.z;
    unsigned sum, cnt, mine, sp = 0u;
    for (;;) {
        sum = 0u; cnt = 0u; mine = 0u;
#pragma unroll
        for (unsigned j = 0; j < 16; ++j) { const unsigned c = xb_ld(&bar[XB_XCNT(j)]); sum += c; cnt += (c > 0u) ? 1u : 0u; mine = (j == x) ? c : mine; }
        if (sum == G) break;
        __builtin_amdgcn_s_sleep(1);
        if ((++sp & 255u) == 0u) { if (xb_ld(&bar[XB_TMO])) break; if (sp > XB_SPIN_CAP) { atomicAdd(&bar[XB_TMO], 1u); break; } }
    }
    nloc = mine > 0u ? mine : 1u; nx = cnt > 0u ? cnt : 1u;
}

__device__ __forceinline__ void xcd_barrier(const XcdBarrier& b) {
    asm volatile("s_waitcnt vmcnt(0)" ::: "memory");
    __syncthreads();
    if (threadIdx.x == 0) {
        unsigned* bar = b.bar;
        __builtin_amdgcn_s_waitcnt(0);
        unsigned nloc = b.st[0], nx = b.st[1];
        if (nloc == 0u) { xcd_barrier_complete(bar, b.x, nloc, nx); b.st[0] = nloc; b.st[1] = nx; }
        const unsigned old = xb_add(&bar[XB_XSUB(b.x)], 1u);
        const unsigned gen = old / nloc;
        if (old + 1u == (gen + 1u) * nloc) {
            __builtin_amdgcn_fence(__ATOMIC_RELEASE, "agent");
            asm volatile("s_waitcnt vmcnt(0)" ::: "memory");
            const unsigned og = xb_add(&bar[XB_TOP], 1u);
            const unsigned tg = og / nx;
            if (og + 1u == (tg + 1u) * nx) xb_add(&bar[XB_TOPGEN], 1u);
            else XB_SPIN(xb_ld(&bar[XB_TOPGEN]) == tg, bar);
            __builtin_amdgcn_fence(__ATOMIC_ACQUIRE, "agent");
            xb_add(&bar[XB_XGEN(b.x)], 1u);
            asm volatile("s_waitcnt vmcnt(0)" ::: "memory");
        } else {
            XB_SPIN(xb_ld(&bar[XB_XGEN(b.x)]) == gen, bar);
            __builtin_amdgcn_fence(__ATOMIC_ACQUIRE, "agent");
            asm volatile("s_waitcnt vmcnt(0)" ::: "memory");
        }
    }
    __syncthreads();
}

#ifndef PHMASK
#define PHMASK 0xFFFF
#endif
#define EN(n) if constexpr (((PHMASK) >> (n)) & 1)
#ifndef PROBE_DUP
#define PROBE_DUP -1
#endif
constexpr int PH_PER_LAYER = 14, NPH = 2 + DEPTH * PH_PER_LAYER;

__global__ void __launch_bounds__(NTHR, 2) hybrid_fwd(Args args) {
    extern __shared__ __attribute__((aligned(16))) unsigned char lds[];
    unsigned char* ws = args.ws;
    bf16* proj = (bf16*)(ws + WS_A); float* sc = (float*)(ws + WS_A);
    bf16* xn = (bf16*)(ws + WS_XN);
    bf16* ocat = (bf16*)(ws + WS_C); int* eids = (int*)(ws + WS_C); float* gates = (float*)(ws + WS_C + 16 * MiB); float* hid = (float*)(ws + WS_C + 32 * MiB); unsigned* ctl = (unsigned*)ws; bf16* pw = (bf16*)(ws + WS_C);
    float* kvt = (float*)(ws + WS_D); unsigned char* u8 = ws + WS_D; unsigned char* v8 = ws + WS_D + 16 * MiB; float* usc = (float*)(ws + WS_D + 32 * MiB); float* vsc = (float*)(ws + WS_D + 33 * MiB);
    bf16* pb = (bf16*)(ws + WS_PB); float* dec = (float*)(ws + WS_DEC);
    cg::grid_group grid = cg::this_grid();
    volatile LAS unsigned* misc = (volatile LAS unsigned*)((LAS unsigned char*)lds + (LDS_BYTES - 64));
    if (threadIdx.x < 16) misc[threadIdx.x] = 0u;
    __syncthreads();
    XcdBarrier xbar = xcd_barrier_post((unsigned*)args.ws + CTL_BAR, misc);
    PG8_LAS unsigned char* gl = (PG8_LAS unsigned char*)lds;

    for (int ph = args.ph_lo, rep = 0; ph < args.ph_hi;) {
        int tid_ = threadIdx.x; asm volatile("" : "+v"(tid_));
    Frame F;
        F.lds = lds; F.tid = tid_; F.lane = F.tid & 63; F.wave = __builtin_amdgcn_readfirstlane(F.tid >> 6); F.G = gridDim.x; F.bid = blockIdx.x;
        F.x = args.in[0]; F.p = args.in[1]; F.norm_mix = args.in[2]; F.w_in = args.in[3]; F.g_w2 = args.in[4]; F.g_b = args.in[5]; F.head_norm = args.in[6]; F.rel_bias = args.in[7]; F.w_out = args.in[8];
        F.norm_ffn = args.in[9]; F.peer_wq = args.in[10]; F.peer_sk = args.in[11]; F.peer_u = args.in[12]; F.peer_v = args.in[13]; F.norm_ple = args.in[14]; F.w_ple_gate = args.in[15]; F.w_ple = args.in[16]; F.final_norm = args.in[17];
        F.out = args.out; F.ws = args.ws;
        if (ph == 0) { EN(14) { phase_prep(F); if (F.bid == 0 && F.tid < 64) ctl[64 * F.tid] = 0u; } }
        else if (ph == NPH - 1) { EN(15) phase_final_norm(F, F.final_norm); }
        else {
            const int l = (ph - 1) / PH_PER_LAYER, sp = (ph - 1) % PH_PER_LAYER;
            const pg8::bf16_t* wl = (const pg8::bf16_t*)(ws + WS_W + (size_t)l * W_LAYER);
            const float* hsrc = (l == 0) ? F.x : F.out;
            switch (sp) {
            case 0: EN(0) {
                phase_norm(F, hsrc, F.norm_mix + (size_t)l * DM, xn);
                convert_bf16(F, F.p + (size_t)l * NT * 256, pb, (size_t)NT * 256);
            } break;
            case 1: EN(1) {
                pg8::Gemm g{(const pg8::bf16_t*)xn, wl + WO_WIN / 2, NT, PW, DM}; pg8::StaticOrder S; S.init(NT, PW, F.G, F.bid);
                pg8::EpiBf16<0> E{(pg8::bf16_t*)proj, PW, nullptr, 0, 0, 1.f};
                pg8::gemm_phase<pg8::EpiBf16<0>, pg8::StaticOrder, true, true>(gl, g, S, E, F.tid);
            } break;
            case 2: EN(2) {
                for (int u = F.bid; u < NB * 8 * 64; u += F.G) { const int c = ((u & 63) + (u >> 6)) & 63, h = (u >> 6) & 7, b = u >> 9; att_unit(F, l, b, h, c, proj, ocat); }
                for (int u = F.bid; u < NB * 4 * 64; u += F.G) { const int c = u & 63, h = (u >> 6) & 3, b = u >> 8; gla_kv_unit(F, l, b, h, c, proj, kvt, dec); }
            } break;
            case 3: EN(3) { phase_scan(F, kvt, dec); } break;
            case 4: EN(4) {
                for (int u = F.bid; u < NB * 4 * 64; u += F.G) { const int c = u & 63, h = (u >> 6) & 3, b = u >> 8; gla_out_unit(F, l, b, h, c, proj, kvt, ocat); }
            } break;
            case 5: EN(5) {
                pg8::Gemm g{(const pg8::bf16_t*)ocat, wl + WO_WOUT / 2, NT, DM, DM}; pg8::StaticOrder S; S.init(NT, DM, F.G, F.bid);
                pg8::EpiResid E{hsrc, F.out, DM};
                pg8::gemm_phase<pg8::EpiResid, pg8::StaticOrder, true, true>(gl, g, S, E, F.tid);
            } break;
            case 6: EN(6) {
                phase_norm(F, F.out, F.norm_ffn + (size_t)l * DM, xn);
                convert_rows_fp8(F, F.peer_u + (size_t)l * NEXP * DM, u8, usc, true);
                convert_rows_fp8(F, F.peer_v + (size_t)l * NEXP * DM, v8, vsc, true);
            } break;
            case 7: EN(7) {
                pg8::Gemm g{(const pg8::bf16_t*)xn, wl + WO_WQ2 / 2, NT, 2048, DM}; pg8::StaticOrder S; S.init(NT, 2048, F.G, F.bid);
                pg8::EpiF32Store E{sc, 2048};
                pg8::gemm_phase<pg8::EpiF32Store, pg8::StaticOrder, true, true>(gl, g, S, E, F.tid);
            } break;
            case 8: EN(8) { for (int tl = F.bid; tl < NT / 16; tl += F.G) topk_tile(F, tl, sc, eids, gates); } break;
            case 9: EN(9) { phase_peer<false>(F, ctl + 64 * (16 * l + 32 * rep), xn, eids, u8, hid, (float*)(ws + WS_A), nullptr); } break;
            case 10: EN(10) { phase_peer_hid(F, eids, gates, (const float*)(ws + WS_A), usc, vsc, hid); } break;
            case 11: EN(11) { phase_peer<true>(F, ctl + 64 * (16 * l + 8 + 32 * rep), xn, eids, v8, hid, nullptr, rep ? (float*)(ws + WS_A + 128 * MiB) : F.out); } break;
            case 12: EN(12) {
                phase_norm(F, F.out, F.norm_ple + (size_t)l * DM, xn);
                pg8::Gemm g{(const pg8::bf16_t*)pb, wl + WO_WP / 2, NT, DM, 256}; pg8::StaticOrder S; S.init(NT, DM, F.G, F.bid);
                pg8::EpiBf16<0> E{(pg8::bf16_t*)pw, DM, nullptr, 0, 0, 1.f};
                pg8::gemm_phase<pg8::EpiBf16<0>, pg8::StaticOrder, true, true>(gl, g, S, E, F.tid);
            } break;
            case 13: EN(13) {
                pg8::Gemm g{(const pg8::bf16_t*)xn, wl + WO_WG / 2, NT, DM, DM}; pg8::StaticOrder S; S.init(NT, DM, F.G, F.bid);
                pg8::EpiPle E{F.out, F.out, (const pg8::bf16_t*)pw, DM};
                pg8::gemm_phase<pg8::EpiPle, pg8::StaticOrder, true, true>(gl, g, S, E, F.tid);
            } break;
            }
        }
        bool adv = true;
        if (PROBE_DUP >= 0 && ph > 0 && ph < NPH - 1 && (ph - 1) % PH_PER_LAYER == PROBE_DUP && rep == 0) { rep = 1; adv = false; }
        if (adv) { rep = 0; ++ph; }
        if (ph < args.ph_hi) { if (USE_XCD_BARRIER && ph > 1) xcd_barrier(xbar); else grid.sync(); }
    }
}

extern "C" void kernel_launch(void* const* d_in, const int* in_sizes, int n_in, void* d_out, int out_size, void* d_ws, size_t ws_size, hipStream_t stream) {
    static int grid = 0;
    if (grid == 0) {
        if (n_in != 18 || in_sizes[0] != NT * DM || out_size != NT * DM || ws_size < WS_END) { fprintf(stderr, "kernel_launch: unexpected shapes (n_in %d, in0 %d, out %d, ws %zu); nothing launched\n", n_in, n_in > 0 ? in_sizes[0] : -1, out_size, ws_size); grid = -1; return; }
        int dev = 0, cus = 0, per_cu = 0;
        if (hipGetDevice(&dev) != hipSuccess || hipDeviceGetAttribute(&cus, hipDeviceAttributeMultiprocessorCount, dev) != hipSuccess) { fprintf(stderr, "kernel_launch: device query failed\n"); grid = -1; return; }
        if (hipFuncSetAttribute((const void*)hybrid_fwd, hipFuncAttributeMaxDynamicSharedMemorySize, LDS_BYTES) != hipSuccess) { fprintf(stderr, "kernel_launch: hipFuncSetAttribute failed\n"); grid = -1; return; }
        if (hipOccupancyMaxActiveBlocksPerMultiprocessor(&per_cu, (const void*)hybrid_fwd, NTHR, LDS_BYTES) != hipSuccess || per_cu < 1) { fprintf(stderr, "kernel_launch: occupancy query says %d blocks per CU\n", per_cu); (void)hipGetLastError(); grid = -1; return; }
        grid = cus * 1;
    }
    if (grid < 0) return;
    if (hipMemsetAsync(d_ws, 0, CTL_ZERO_BYTES, stream) != hipSuccess) { fprintf(stderr, "kernel_launch: hipMemsetAsync failed\n"); return; }
    Args a{};
    for (int i = 0; i < 18; ++i) a.in[i] = (const float*)d_in[i];
    a.out = (float*)d_out; a.ws = (unsigned char*)d_ws;
#if MK_N_LAUNCHES == 1
    a.ph_lo = 0; a.ph_hi = NPH;
    void* kargs[] = {&a};
    hipError_t e = hipLaunchCooperativeKernel((const void*)hybrid_fwd, dim3(grid), dim3(NTHR), kargs, LDS_BYTES, stream);
    if (e != hipSuccess) fprintf(stderr, "kernel_launch: cooperative launch failed: %s (grid %d)\n", hipGetErrorString(e), grid);
#else
    for (int ph = 0; ph < NPH; ++ph) { a.ph_lo = ph; a.ph_hi = ph + 1; hipLaunchKernelGGL(hybrid_fwd, dim3(grid), dim3(NTHR), LDS_BYTES, stream, a); }
#endif
}
```

```cpp
#include <hip/hip_runtime.h>
#include <hip/hip_cooperative_groups.h>
#include <cstdio>
#include <cstdint>
namespace cg = cooperative_groups;
#define MK_N_LAUNCHES 1
namespace pg8 {
#define PG8_LAS __attribute__((address_space(3)))
typedef unsigned short bf16_t;
typedef short bf16x8 __attribute__((ext_vector_type(8)));
typedef float f32x4 __attribute__((ext_vector_type(4)));
typedef unsigned u32x4 __attribute__((ext_vector_type(4)));
constexpr int BM = 256, BK = 64, HALF = 128, HTB = HALF * BK * 2  , STAGE_BYTES = 8 * HTB, NXCD = 8, WGM = 8;

__host__ __device__ __forceinline__ int lds_byte(int r, int c) { const int st = (r >> 4) * 2 + (c >> 5), rr = r & 15, cc = c & 31, ob = rr * 64 + cc * 2; return st * 1024 + (ob ^ (((ob >> 9) & 1) << 5)); }
__host__ __device__ __forceinline__ void stage_rc(int b, int& R, int& C) { const int st = b / 1024, sb = b % 1024, swz = sb ^ (((sb >> 9) & 1) << 5); R = (st >> 1) * 16 + swz / 64; C = (st & 1) * 32 + (swz % 64) / 2; }
__host__ __device__ __forceinline__ int perm32(int rho) { const int n = rho >> 4, i = rho & 15; return 8 * (i >> 2) + 4 * n + (i & 3); }

struct Unit { int pm, pn; };
struct Gemm { const bf16_t* A; const bf16_t* Bt; int M, N, K; };

struct StaticOrder {
    int nM, nN, nwg, G, c;
    __host__ __device__ void init(int M, int N, int G_, int c_) { nM = M / BM; nN = N / BM; nwg = nM * nN; G = G_; c = c_; }
    __host__ __device__ bool next(int i, Unit& u) const {
        const long L = (long)i * G + c; if (L >= nwg) return false;
        int wgid = (int)L; { const int q = nwg / NXCD, r = nwg % NXCD, xcd = wgid % NXCD, off = wgid / NXCD; wgid = (xcd < r ? xcd * (q + 1) : r * (q + 1) + (xcd - r) * q) + off; }
        const int nig = WGM * nN, gid = wgid / nig, fm = gid * WGM, gsz = (nM - fm) < WGM ? (nM - fm) : WGM;
        u.pm = fm + ((wgid % nig) % gsz); u.pn = (wgid % nig) / gsz; return true;
    }
    __device__ __forceinline__ void a_ready(const Unit&) const {}
    __device__ __forceinline__ void done(const Unit&) const {}
};

__device__ __forceinline__ unsigned cvt_pk_bf16(float lo, float hi) { unsigned r; asm volatile("v_cvt_pk_bf16_f32 %0, %1, %2" : "=v"(r) : "v"(lo), "v"(hi)); return r; }
typedef float f32x2 __attribute__((ext_vector_type(2)));
__device__ __forceinline__ f32x2 gelu_pk(f32x2 v) {
    const f32x2 av = __builtin_elementwise_abs(v), d = av * 0.2316418882f + 1.0f;
    f32x2 t; t.x = __builtin_amdgcn_rcpf(d.x); t.y = __builtin_amdgcn_rcpf(d.y);
    f32x2 q = t * 0.5307027145f + (-0.7265760135f); q = q * t + 0.7107068705f; q = q * t + (-0.142248368f); q = q * t + 0.127414796f; q = q * t;
    const f32x2 s = (v * v) * (-0.72134752044f);
    f32x2 e; e.x = __builtin_amdgcn_exp2f(s.x); e.y = __builtin_amdgcn_exp2f(s.y);
    const f32x2 m = v * (q * e), r = v - m;
    f32x2 o; o.x = v.x < 0.f ? m.x : r.x; o.y = v.y < 0.f ? m.y : r.y; return o;
}

template <int ACT  > struct EpiBf16 {
    static constexpr bool PERM = true, AFTER_DRAIN = false; static_assert(ACT == 0 || ACT == 1, "EpiBf16: ACT is 0 (none) or 1 (gelu_pk)");
    bf16_t* O; int ldc; const float* bias; int split_cols; size_t split_stride; float scale0;
    __device__ __forceinline__ void operator()(const f32x4 (&acc)[2][2][4][2], const Unit& u, int wr, int wc, int fr, int fq) const {
        const int row0 = u.pm * BM + wr * 64 + fr; int colt = u.pn * BM; bf16_t* base = O;
        float sc = 1.f; if (split_cols) { const int t = colt / split_cols; base += (size_t)t * split_stride; colt -= t * split_cols; if (t == 0) sc = scale0; }
        const int col0 = colt + wc * 32 + 8 * fq, bcol0 = u.pn * BM + wc * 32 + 8 * fq;
        f32x4 bv[2][2];
#pragma unroll
        for (int bj = 0; bj < 2; ++bj)
#pragma unroll
            for (int n = 0; n < 2; ++n) bv[bj][n] = bias ? *(const f32x4*)(bias + bcol0 + bj * HALF + 4 * n) : (f32x4){0.f, 0.f, 0.f, 0.f};
#pragma unroll
        for (int ai = 0; ai < 2; ++ai)
#pragma unroll
            for (int m = 0; m < 4; ++m) { bf16_t* rowp = base + (size_t)(row0 + ai * HALF + m * 16) * ldc + col0;
#pragma unroll
                for (int bj = 0; bj < 2; ++bj) { f32x4 v0 = acc[ai][bj][m][0] + bv[bj][0], v1 = acc[ai][bj][m][1] + bv[bj][1];
                    if (ACT == 1) { f32x2 a = gelu_pk((f32x2){v0[0], v0[1]}), b = gelu_pk((f32x2){v0[2], v0[3]}), c = gelu_pk((f32x2){v1[0], v1[1]}), d = gelu_pk((f32x2){v1[2], v1[3]});
                        v0 = (f32x4){a.x, a.y, b.x, b.y}; v1 = (f32x4){c.x, c.y, d.x, d.y}; }
                    v0 = v0 * sc; v1 = v1 * sc; u32x4 w; w.x = cvt_pk_bf16(v0[0], v0[1]); w.y = cvt_pk_bf16(v0[2], v0[3]); w.z = cvt_pk_bf16(v1[0], v1[1]); w.w = cvt_pk_bf16(v1[2], v1[3]);
                    *(u32x4*)(rowp + bj * HALF) = w; } }
    }
};

struct EpiF32Store {
    static constexpr bool PERM = false, AFTER_DRAIN = false;
    float* C; int ldc;
    __device__ __forceinline__ void operator()(const f32x4 (&acc)[2][2][4][2], const Unit& u, int wr, int wc, int fr, int fq) const {
        const int row0 = u.pm * BM + wr * 64 + fr, col0 = u.pn * BM + wc * 32 + 4 * fq;
#pragma unroll
        for (int ai = 0; ai < 2; ++ai)
#pragma unroll
            for (int m = 0; m < 4; ++m) { float* rowp = C + (size_t)(row0 + ai * HALF + m * 16) * ldc + col0;
#pragma unroll
                for (int bj = 0; bj < 2; ++bj)
#pragma unroll
                    for (int n = 0; n < 2; ++n) *(f32x4*)(rowp + bj * HALF + n * 16) = acc[ai][bj][m][n]; }
    }
};
struct EpiResid {
    static constexpr bool PERM = false, AFTER_DRAIN = false;
    const float* base; float* out; int ldc;
    __device__ __forceinline__ void operator()(const f32x4 (&acc)[2][2][4][2], const Unit& u, int wr, int wc, int fr, int fq) const {
        const int row0 = u.pm * BM + wr * 64 + fr, col0 = u.pn * BM + wc * 32 + 4 * fq;
#pragma unroll
        for (int ai = 0; ai < 2; ++ai)
#pragma unroll
            for (int m = 0; m < 4; ++m) { const size_t off = (size_t)(row0 + ai * HALF + m * 16) * ldc + col0;
                f32x4 bs[2][2];
#pragma unroll
                for (int bj = 0; bj < 2; ++bj)
#pragma unroll
                    for (int n = 0; n < 2; ++n) bs[bj][n] = *(const f32x4*)(base + off + bj * HALF + n * 16);
#pragma unroll
                for (int bj = 0; bj < 2; ++bj)
#pragma unroll
                    for (int n = 0; n < 2; ++n) *(f32x4*)(out + off + bj * HALF + n * 16) = bs[bj][n] + acc[ai][bj][m][n];
                asm volatile("" ::: "memory"); }
    }
};
struct EpiPle {
    static constexpr bool PERM = false, AFTER_DRAIN = false;
    const float* base; float* out; const bf16_t* pw; int ldc;
    __device__ __forceinline__ void operator()(const f32x4 (&acc)[2][2][4][2], const Unit& u, int wr, int wc, int fr, int fq) const {
        typedef unsigned u32x2v __attribute__((ext_vector_type(2)));
        const int row0 = u.pm * BM + wr * 64 + fr, col0 = u.pn * BM + wc * 32 + 4 * fq;
#pragma unroll
        for (int ai = 0; ai < 2; ++ai)
#pragma unroll
            for (int m = 0; m < 4; ++m) { const size_t off = (size_t)(row0 + ai * HALF + m * 16) * ldc + col0;
                f32x4 bs[2][2]; u32x2v pv[2][2];
#pragma unroll
                for (int bj = 0; bj < 2; ++bj)
#pragma unroll
                    for (int n = 0; n < 2; ++n) { bs[bj][n] = *(const f32x4*)(base + off + bj * HALF + n * 16); pv[bj][n] = *(const u32x2v*)(pw + off + bj * HALF + n * 16); }
#pragma unroll
                for (int bj = 0; bj < 2; ++bj)
#pragma unroll
                    for (int n = 0; n < 2; ++n) { const f32x4 a = acc[ai][bj][m][n]; f32x4 o;
                        const float p0 = __uint_as_float(pv[bj][n].x << 16), p1 = __uint_as_float(pv[bj][n].x & 0xffff0000u), p2 = __uint_as_float(pv[bj][n].y << 16), p3 = __uint_as_float(pv[bj][n].y & 0xffff0000u);
                        o[0] = bs[bj][n][0] + p0 / (1.0f + __expf(-a[0])); o[1] = bs[bj][n][1] + p1 / (1.0f + __expf(-a[1]));
                        o[2] = bs[bj][n][2] + p2 / (1.0f + __expf(-a[2])); o[3] = bs[bj][n][3] + p3 / (1.0f + __expf(-a[3]));
                        *(f32x4*)(out + off + bj * HALF + n * 16) = o; }
                asm volatile("" ::: "memory"); }
    }
};

__device__ __forceinline__ float rs_from16(const float* ss) { const f32x4 a = ((const f32x4*)ss)[0], b = ((const f32x4*)ss)[1], c = ((const f32x4*)ss)[2], d = ((const f32x4*)ss)[3];
    const f32x4 s = (a + b) + (c + d); return rsqrtf(((s[0] + s[1]) + (s[2] + s[3])) * (1.0f / 1024.0f) + 1e-6f); }
__device__ __forceinline__ float rs_from8(const float* ss) { const f32x4 a = ((const f32x4*)ss)[0], b = ((const f32x4*)ss)[1];
    const f32x4 s = a + b; return rsqrtf(((s[0] + s[1]) + (s[2] + s[3])) * (1.0f / 1024.0f) + 1e-6f); }
struct EpiBf16RS {
    static constexpr bool PERM = true, AFTER_DRAIN = false;
    bf16_t* O; int ldc; const float* ssq;
    __device__ __forceinline__ void operator()(const f32x4 (&acc)[2][2][4][2], const Unit& u, int wr, int wc, int fr, int fq) const {
        const int row0 = u.pm * BM + wr * 64 + fr, col0 = u.pn * BM + wc * 32 + 8 * fq;
#pragma unroll
        for (int ai = 0; ai < 2; ++ai)
#pragma unroll
            for (int m = 0; m < 4; ++m) { const int row = row0 + ai * HALF + m * 16; const float sc = rs_from16(ssq + (size_t)row * 16); bf16_t* rowp = O + (size_t)row * ldc + col0;
#pragma unroll
                for (int bj = 0; bj < 2; ++bj) { const f32x4 v0 = acc[ai][bj][m][0] * sc, v1 = acc[ai][bj][m][1] * sc;
                    u32x4 w; w.x = cvt_pk_bf16(v0[0], v0[1]); w.y = cvt_pk_bf16(v0[2], v0[3]); w.z = cvt_pk_bf16(v1[0], v1[1]); w.w = cvt_pk_bf16(v1[2], v1[3]);
                    *(u32x4*)(rowp + bj * HALF) = w; } }
    }
};
struct EpiF32RS {
    static constexpr bool PERM = false, AFTER_DRAIN = false;
    float* C; int ldc; const float* ssq;
    __device__ __forceinline__ void operator()(const f32x4 (&acc)[2][2][4][2], const Unit& u, int wr, int wc, int fr, int fq) const {
        const int row0 = u.pm * BM + wr * 64 + fr, col0 = u.pn * BM + wc * 32 + 4 * fq;
#pragma unroll
        for (int ai = 0; ai < 2; ++ai)
#pragma unroll
            for (int m = 0; m < 4; ++m) { const int row = row0 + ai * HALF + m * 16; const float sc = rs_from16(ssq + (size_t)row * 16); float* rowp = C + (size_t)row * ldc + col0;
#pragma unroll
                for (int bj = 0; bj < 2; ++bj)
#pragma unroll
                    for (int n = 0; n < 2; ++n) *(f32x4*)(rowp + bj * HALF + n * 16) = acc[ai][bj][m][n] * sc; }
    }
};
struct EpiResidN {
    static constexpr bool PERM = true, AFTER_DRAIN = false;
    const float* base; float* out; int ldc; const float* g; bf16_t* xo; float* ssq;
    __device__ __forceinline__ void operator()(const f32x4 (&acc)[2][2][4][2], const Unit& u, int wr, int wc, int fr, int fq) const {
        const int row0 = u.pm * BM + wr * 64 + fr, col0 = u.pn * BM + wc * 32 + 8 * fq;
        f32x4 gv[2][2];
#pragma unroll
        for (int bj = 0; bj < 2; ++bj)
#pragma unroll
            for (int n = 0; n < 2; ++n) gv[bj][n] = *(const f32x4*)(g + col0 + bj * HALF + n * 4);
#pragma unroll
        for (int ai = 0; ai < 2; ++ai)
#pragma unroll
            for (int m = 0; m < 4; ++m) { const int row = row0 + ai * HALF + m * 16; const size_t off = (size_t)row * ldc + col0;
                f32x4 bs[2][2];
#pragma unroll
                for (int bj = 0; bj < 2; ++bj)
#pragma unroll
                    for (int n = 0; n < 2; ++n) bs[bj][n] = *(const f32x4*)(base + off + bj * HALF + n * 4);
                float ss = 0.f;
#pragma unroll
                for (int bj = 0; bj < 2; ++bj) { const f32x4 o0 = bs[bj][0] + acc[ai][bj][m][0], o1 = bs[bj][1] + acc[ai][bj][m][1];
                    *(f32x4*)(out + off + bj * HALF) = o0; *(f32x4*)(out + off + bj * HALF + 4) = o1;
                    ss += ((o0[0] * o0[0] + o0[1] * o0[1]) + (o0[2] * o0[2] + o0[3] * o0[3])) + ((o1[0] * o1[0] + o1[1] * o1[1]) + (o1[2] * o1[2] + o1[3] * o1[3]));
                    const f32x4 x0 = o0 * gv[bj][0], x1 = o1 * gv[bj][1];
                    u32x4 w; w.x = cvt_pk_bf16(x0[0], x0[1]); w.y = cvt_pk_bf16(x0[2], x0[3]); w.z = cvt_pk_bf16(x1[0], x1[1]); w.w = cvt_pk_bf16(x1[2], x1[3]);
                    *(u32x4*)(xo + off + bj * HALF) = w; }
                ss += __shfl_xor(ss, 16); ss += __shfl_xor(ss, 32);
                if (fq == 0) ssq[(size_t)row * 16 + u.pn * 4 + wc] = ss;
                asm volatile("" ::: "memory"); }
    }
};
struct EpiPleN {
    static constexpr bool PERM = true, AFTER_DRAIN = false;
    const float* base; float* out; const bf16_t* pw; int ldc; const float* ssq_in; const float* g; bf16_t* xo; float* ssq;
    __device__ __forceinline__ void operator()(const f32x4 (&acc)[2][2][4][2], const Unit& u, int wr, int wc, int fr, int fq) const {
        const int row0 = u.pm * BM + wr * 64 + fr, col0 = u.pn * BM + wc * 32 + 8 * fq;
        f32x4 gv[2][2];
#pragma unroll
        for (int bj = 0; bj < 2; ++bj)
#pragma unroll
            for (int n = 0; n < 2; ++n) gv[bj][n] = *(const f32x4*)(g + col0 + bj * HALF + n * 4);
#pragma unroll
        for (int ai = 0; ai < 2; ++ai)
#pragma unroll
            for (int m = 0; m < 4; ++m) { const int row = row0 + ai * HALF + m * 16; const size_t off = (size_t)row * ldc + col0; const float rs = rs_from8(ssq_in + (size_t)row * 8);
                f32x4 bs[2][2]; u32x4 pv[2];
#pragma unroll
                for (int bj = 0; bj < 2; ++bj) { bs[bj][0] = *(const f32x4*)(base + off + bj * HALF); bs[bj][1] = *(const f32x4*)(base + off + bj * HALF + 4); pv[bj] = *(const u32x4*)(pw + off + bj * HALF); }
                float ss = 0.f;
#pragma unroll
                for (int bj = 0; bj < 2; ++bj) { const f32x4 a0 = acc[ai][bj][m][0] * rs, a1 = acc[ai][bj][m][1] * rs; f32x4 o0, o1;
                    const float p0 = __uint_as_float(pv[bj].x << 16), p1 = __uint_as_float(pv[bj].x & 0xffff0000u), p2 = __uint_as_float(pv[bj].y << 16), p3 = __uint_as_float(pv[bj].y & 0xffff0000u);
                    const float p4 = __uint_as_float(pv[bj].z << 16), p5 = __uint_as_float(pv[bj].z & 0xffff0000u), p6 = __uint_as_float(pv[bj].w << 16), p7 = __uint_as_float(pv[bj].w & 0xffff0000u);
                    o0[0] = bs[bj][0][0] + p0 / (1.0f + __expf(-a0[0])); o0[1] = bs[bj][0][1] + p1 / (1.0f + __expf(-a0[1])); o0[2] = bs[bj][0][2] + p2 / (1.0f + __expf(-a0[2])); o0[3] = bs[bj][0][3] + p3 / (1.0f + __expf(-a0[3]));
                    o1[0] = bs[bj][1][0] + p4 / (1.0f + __expf(-a1[0])); o1[1] = bs[bj][1][1] + p5 / (1.0f + __expf(-a1[1])); o1[2] = bs[bj][1][2] + p6 / (1.0f + __expf(-a1[2])); o1[3] = bs[bj][1][3] + p7 / (1.0f + __expf(-a1[3]));
                    *(f32x4*)(out + off + bj * HALF) = o0; *(f32x4*)(out + off + bj * HALF + 4) = o1;
                    ss += ((o0[0] * o0[0] + o0[1] * o0[1]) + (o0[2] * o0[2] + o0[3] * o0[3])) + ((o1[0] * o1[0] + o1[1] * o1[1]) + (o1[2] * o1[2] + o1[3] * o1[3]));
                    if (xo) { const f32x4 x0 = o0 * gv[bj][0], x1 = o1 * gv[bj][1];
                        u32x4 w; w.x = cvt_pk_bf16(x0[0], x0[1]); w.y = cvt_pk_bf16(x0[2], x0[3]); w.z = cvt_pk_bf16(x1[0], x1[1]); w.w = cvt_pk_bf16(x1[2], x1[3]);
                        *(u32x4*)(xo + off + bj * HALF) = w; } }
                ss += __shfl_xor(ss, 16); ss += __shfl_xor(ss, 32);
                if (fq == 0) ssq[(size_t)row * 16 + u.pn * 4 + wc] = ss;
                asm volatile("" ::: "memory"); }
    }
};
struct EpiBf16P {
    static constexpr bool PERM = true, AFTER_DRAIN = false;
    bf16_t* O; int ldc;
    __device__ __forceinline__ void operator()(const f32x4 (&acc)[2][2][4][2], const Unit& u, int wr, int wc, int fr, int fq) const {
        const int row0 = u.pm * BM + wr * 64 + fr, col0 = u.pn * BM + wc * 32 + 8 * fq;
#pragma unroll
        for (int ai = 0; ai < 2; ++ai)
#pragma unroll
            for (int m = 0; m < 4; ++m) { bf16_t* rowp = O + (size_t)(row0 + ai * HALF + m * 16) * ldc + col0;
#pragma unroll
                for (int bj = 0; bj < 2; ++bj) { const f32x4 v0 = acc[ai][bj][m][0], v1 = acc[ai][bj][m][1];
                    u32x4 w; w.x = cvt_pk_bf16(v0[0], v0[1]); w.y = cvt_pk_bf16(v0[2], v0[3]); w.z = cvt_pk_bf16(v1[0], v1[1]); w.w = cvt_pk_bf16(v1[2], v1[3]);
                    *(u32x4*)(rowp + bj * HALF) = w; } }
    }
};
template <class Epi, class Sched, bool ALIGN_EPI = false, bool SP2 = false>
__device__ __forceinline__ void gemm_phase(PG8_LAS unsigned char* lds, const Gemm g, const Sched& S, const Epi& E, const int tid_in) {
    const int tid = tid_in, wid = __builtin_amdgcn_readfirstlane(tid >> 6), lane = tid & 63, wr = wid >> 2, wc = wid & 3, fr = lane & 15, fq = lane >> 4;
    const int K = g.K, nt = K / BK;
    unsigned voffA[2], voffB[2];
#pragma unroll
    for (int i = 0; i < 2; ++i) { int R, C; stage_rc(tid * 16 + i * 8192, R, C); const int Rb = Epi::PERM ? ((R & ~31) + perm32(R & 31)) : R;
        voffA[i] = (unsigned)(R * K + C) * 2u; voffB[i] = (unsigned)(Rb * K + C) * 2u; }
    const size_t kstep = (size_t)(BK * 2);
    const size_t hstep = (size_t)HALF * K * 2;
    const size_t tstep = 2 * hstep;
    const unsigned ldsw = (unsigned)wid * 1024u;
    const int aoff = lds_byte(wr * 64 + fr, fq * 8), boff = lds_byte(wc * 32 + fr, fq * 8);
#define PG8_SA(b, h) (((b) * 2 + (h)) * HTB)
#define PG8_SB(b, h) ((4 + (b) * 2 + (h)) * HTB)
#define PG8_STAGE(bufoff, gbase, voff) do { _Pragma("unroll") for (int _i = 0; _i < 2; ++_i) \
        __builtin_amdgcn_global_load_lds((const unsigned*)((const char*)(gbase) + (voff)[_i]), (PG8_LAS unsigned*)(lds + (bufoff) + ldsw + _i * 8192), 16, 0, 0); } while (0)
#define PG8_LDA(dst, b, h) do { _Pragma("unroll") for (int m = 0; m < 4; ++m) _Pragma("unroll") for (int k = 0; k < 2; ++k) dst[m][k] = *(const PG8_LAS bf16x8*)(lds + PG8_SA(b, h) + aoff + m * 2048 + k * 1024); } while (0)
#define PG8_LDB(dst, b, h) do { _Pragma("unroll") for (int n = 0; n < 2; ++n) _Pragma("unroll") for (int k = 0; k < 2; ++k) dst[n][k] = *(const PG8_LAS bf16x8*)(lds + PG8_SB(b, h) + boff + n * 2048 + k * 1024); } while (0)
#define PG8_MMA(ai, bj, At, Bt) do { __builtin_amdgcn_s_setprio(1); _Pragma("unroll") for (int m = 0; m < 4; ++m) _Pragma("unroll") for (int n = 0; n < 2; ++n) _Pragma("unroll") for (int k = 0; k < 2; ++k) \
        acc[ai][bj][m][n] = __builtin_amdgcn_mfma_f32_16x16x32_bf16(Bt[n][k], At[m][k], acc[ai][bj][m][n], 0, 0, 0); __builtin_amdgcn_s_setprio(0); } while (0)
#define PG8_WAIT_V(n) asm volatile("s_waitcnt vmcnt(" #n ")" ::: "memory")
#define PG8_WAIT_L(n) asm volatile("s_waitcnt lgkmcnt(" #n ")" ::: "memory")
#define PG8_BAR __builtin_amdgcn_s_barrier()
#define PG8_SCHED __builtin_amdgcn_sched_barrier(0)
    Unit cur, nxt; int ui = 0;
    if (!S.next(0, cur)) return;
    f32x4 acc[2][2][4][2];
#pragma unroll
    for (int a = 0; a < 2; ++a)
#pragma unroll
        for (int b = 0; b < 2; ++b)
#pragma unroll
            for (int m = 0; m < 4; ++m)
#pragma unroll
                for (int n = 0; n < 2; ++n) acc[a][b][m][n] = (f32x4){0.f, 0.f, 0.f, 0.f};
    bf16x8 At[4][2], B0[2][2], B1[2][2];
    const char* cA = (const char*)g.A + (size_t)cur.pm * tstep; const char* cB = (const char*)g.Bt + (size_t)cur.pn * tstep;
    S.a_ready(cur);
    if constexpr (SP2) {
        PG8_STAGE(PG8_SB(0, 0), cB, voffB); PG8_STAGE(PG8_SB(0, 1), cB + hstep, voffB); PG8_STAGE(PG8_SA(0, 0), cA, voffA); PG8_STAGE(PG8_SA(0, 1), cA + hstep, voffA);
        if (wr == 1) PG8_BAR;
        PG8_WAIT_V(2); PG8_BAR;
        PG8_STAGE(PG8_SB(1, 0), cB + kstep, voffB); PG8_STAGE(PG8_SA(1, 0), cA + kstep, voffA); PG8_STAGE(PG8_SB(1, 1), cB + hstep + kstep, voffB);
        PG8_WAIT_V(6); PG8_BAR;
    } else {
        PG8_STAGE(PG8_SB(0, 0), cB, voffB); PG8_STAGE(PG8_SA(0, 0), cA, voffA); PG8_STAGE(PG8_SB(0, 1), cB + hstep, voffB); PG8_STAGE(PG8_SA(0, 1), cA + hstep, voffA);
        if (wr == 1) PG8_BAR;
        PG8_WAIT_V(4); PG8_BAR;
        PG8_STAGE(PG8_SB(1, 0), cB + kstep, voffB); PG8_STAGE(PG8_SA(1, 0), cA + kstep, voffA); PG8_STAGE(PG8_SB(1, 1), cB + hstep + kstep, voffB);
        PG8_WAIT_V(6); PG8_BAR;
    }
    for (;;) {
        const bool has_next = S.next(ui + 1, nxt);
        const char* nA = has_next ? (const char*)g.A + (size_t)nxt.pm * tstep : cA; const char* nB = has_next ? (const char*)g.Bt + (size_t)nxt.pn * tstep : cB;
        for (int t = 0; t < nt; t += 2) {
            const bool last = (t == nt - 2);
            const char* a1 = cA + (size_t)(t + 1) * kstep;
            const char* a2 = last ? nA : cA + (size_t)(t + 2) * kstep; const char* b2 = last ? nB : cB + (size_t)(t + 2) * kstep;
            const char* a3 = a2 + kstep; const char* b3 = b2 + kstep;
            if (last && has_next) S.a_ready(nxt);
            if constexpr (SP2) {
            PG8_LDB(B0, 0, 0); PG8_LDB(B1, 0, 1); PG8_SCHED; PG8_LDA(At, 0, 0); PG8_STAGE(PG8_SA(1, 1), a1 + hstep, voffA);
            PG8_WAIT_V(8); PG8_WAIT_L(0); PG8_BAR; PG8_MMA(0, 0, At, B0); PG8_MMA(0, 1, At, B1); PG8_BAR; PG8_SCHED;
            PG8_LDA(At, 0, 1); PG8_STAGE(PG8_SB(0, 0), b2, voffB); PG8_STAGE(PG8_SB(0, 1), b2 + hstep, voffB); PG8_STAGE(PG8_SA(0, 0), a2, voffA);
            PG8_WAIT_V(8); PG8_WAIT_L(0); PG8_BAR; PG8_MMA(1, 0, At, B0); PG8_MMA(1, 1, At, B1); PG8_BAR; PG8_SCHED;
            PG8_LDB(B0, 1, 0); PG8_LDB(B1, 1, 1); PG8_SCHED; PG8_LDA(At, 1, 0); PG8_STAGE(PG8_SA(0, 1), a2 + hstep, voffA);
            PG8_WAIT_V(8); PG8_WAIT_L(0); PG8_BAR; PG8_MMA(0, 0, At, B0); PG8_MMA(0, 1, At, B1); PG8_BAR; PG8_SCHED;
            PG8_LDA(At, 1, 1); PG8_STAGE(PG8_SB(1, 0), b3, voffB); PG8_STAGE(PG8_SB(1, 1), b3 + hstep, voffB); PG8_STAGE(PG8_SA(1, 0), a3, voffA);
            PG8_WAIT_V(8); PG8_WAIT_L(0); PG8_BAR; PG8_MMA(1, 0, At, B0); PG8_MMA(1, 1, At, B1); PG8_BAR; PG8_SCHED;
            } else {
            PG8_LDB(B0, 0, 0); PG8_SCHED; PG8_LDA(At, 0, 0); PG8_STAGE(PG8_SA(1, 1), a1 + hstep, voffA);
            PG8_WAIT_L(8); PG8_BAR; PG8_WAIT_L(0); PG8_MMA(0, 0, At, B0); PG8_BAR; PG8_SCHED;
            PG8_LDB(B1, 0, 1); PG8_STAGE(PG8_SB(0, 0), b2, voffB);
            PG8_BAR; PG8_WAIT_L(0); PG8_MMA(0, 1, At, B1); PG8_BAR;
            PG8_LDA(At, 0, 1); PG8_STAGE(PG8_SA(0, 0), a2, voffA);
            PG8_BAR; PG8_WAIT_L(0); PG8_MMA(1, 0, At, B0); PG8_BAR; PG8_SCHED;
            PG8_STAGE(PG8_SB(0, 1), b2 + hstep, voffB);
            PG8_WAIT_V(6); PG8_BAR; PG8_MMA(1, 1, At, B1); PG8_BAR;
            PG8_LDB(B0, 1, 0); PG8_SCHED; PG8_LDA(At, 1, 0); PG8_STAGE(PG8_SA(0, 1), a2 + hstep, voffA);
            PG8_WAIT_L(8); PG8_BAR; PG8_WAIT_L(0); PG8_MMA(0, 0, At, B0); PG8_BAR; PG8_SCHED;
            PG8_LDB(B1, 1, 1); PG8_STAGE(PG8_SB(1, 0), b3, voffB);
            PG8_BAR; PG8_WAIT_L(0); PG8_MMA(0, 1, At, B1); PG8_BAR;
            PG8_LDA(At, 1, 1); PG8_STAGE(PG8_SA(1, 0), a3, voffA);
            PG8_BAR; PG8_WAIT_L(0); PG8_MMA(1, 0, At, B0); PG8_BAR; PG8_SCHED;
            PG8_STAGE(PG8_SB(1, 1), b3 + hstep, voffB);
            PG8_WAIT_V(6); PG8_BAR; PG8_MMA(1, 1, At, B1); PG8_BAR;
            }
        }
        if constexpr (ALIGN_EPI) { if (wr == 0) PG8_BAR; }
        if constexpr (!Epi::AFTER_DRAIN) { E(acc, cur, wr, wc, fr, fq); S.done(cur); }
        if (!has_next) break;
#pragma unroll
        for (int a = 0; a < 2; ++a)
#pragma unroll
            for (int b = 0; b < 2; ++b)
#pragma unroll
                for (int m = 0; m < 4; ++m)
#pragma unroll
                    for (int n = 0; n < 2; ++n) acc[a][b][m][n] = (f32x4){0.f, 0.f, 0.f, 0.f};
        cur = nxt; cA = nA; cB = nB; ++ui;
        if constexpr (ALIGN_EPI) { if (wr == 1) PG8_BAR; }
    }
    PG8_WAIT_V(0);
    if constexpr (!ALIGN_EPI) { if (wr == 0) PG8_BAR; }
    PG8_BAR;
    if constexpr (Epi::AFTER_DRAIN) { E.fused(acc, cur, wr, wc, fr, fq, lds, wid, lane); S.done(cur); }
#undef PG8_SA
#undef PG8_SB
#undef PG8_STAGE
#undef PG8_LDA
#undef PG8_LDB
#undef PG8_MMA
#undef PG8_WAIT_V
#undef PG8_WAIT_L
#undef PG8_BAR
#undef PG8_SCHED
}
}

#ifndef MK_N_LAUNCHES
#define MK_N_LAUNCHES 1
#endif
constexpr int NB = 8, SEQ = 4096, DM = 1024, DEPTH = 2, NT = NB * SEQ;
constexpr int PW = 3328;
constexpr int C_GQ = 0, C_GK = 256, C_GV = 512, C_GOG = 1024, C_AQ = 1536, C_AK = 2048, C_AV = 2560, C_GLR = 3072;
constexpr int IN_W = 3088, NEXP = 16384;
constexpr float RMS_EPS = 1e-6f;
constexpr int NWAVES = 8, NTHR = 512;
#ifndef USE_XCD_BARRIER
#define USE_XCD_BARRIER 1
#endif
constexpr int CTL_BAR = 8192, CTL_ZERO_BYTES = 65536;
constexpr int LDS_BYTES = 147456;

constexpr size_t MiB = 1u << 20;
constexpr size_t WS_W = 1 * MiB, W_LAYER = 15 * MiB;
constexpr size_t WO_WIN = 0, WO_WOUT = 6656 * 1024, WO_WQ2 = WO_WOUT + 2 * MiB, WO_WG = WO_WQ2 + 4 * MiB, WO_WP = WO_WG + 2 * MiB;
static_assert(WO_WP + 512 * 1024 <= W_LAYER, "weights per layer");
constexpr size_t WS_A = 32 * MiB;
constexpr size_t WS_XN = 288 * MiB;
constexpr size_t WS_C = 352 * MiB;
constexpr size_t WS_D = 416 * MiB;
constexpr size_t WS_PB = 480 * MiB;
constexpr size_t WS_DEC = 496 * MiB;
constexpr size_t WS_ST = 497 * MiB;
constexpr size_t WS_END = 502 * MiB;

#define DI __device__ __forceinline__
typedef unsigned short bf16;
typedef short bf16x8 __attribute__((ext_vector_type(8)));
typedef float f32x4 __attribute__((ext_vector_type(4)));
typedef float f32x16 __attribute__((ext_vector_type(16)));
typedef unsigned u32x4 __attribute__((ext_vector_type(4)));
typedef unsigned u32x2 __attribute__((ext_vector_type(2)));
#define MFMA32(a, b, c) __builtin_amdgcn_mfma_f32_32x32x16_bf16((a), (b), (c), 0, 0, 0)
DI float bf2f(unsigned v) { return __uint_as_float(v << 16); }
DI unsigned f2bf(float f) { unsigned u = __float_as_uint(f); return (u + 0x7fffu + ((u >> 16) & 1u)) >> 16; }
DI unsigned pk2(float lo, float hi) { return f2bf(lo) | (f2bf(hi) << 16); }
DI int crow(int reg, int h) { return (reg & 3) + 8 * (reg >> 2) + 4 * h; }
DI float wave_sum(float v) {
#pragma unroll
    for (int o = 1; o < 64; o <<= 1) v += __shfl_xor(v, o);
    return v;
}
DI bf16x8 pack8(const f32x16& x, int s) {
    u32x4 p; p.x = pk2(x[8 * s + 0], x[8 * s + 1]); p.y = pk2(x[8 * s + 2], x[8 * s + 3]); p.z = pk2(x[8 * s + 4], x[8 * s + 5]); p.w = pk2(x[8 * s + 6], x[8 * s + 7]);
    return __builtin_bit_cast(bf16x8, p);
}

struct Args { const float* in[18]; float* out; unsigned char* ws; int ph_lo, ph_hi; };
struct Frame {
    unsigned char* lds; int tid, lane, wave, G, bid;
    const float *x, *p, *norm_mix, *w_in, *g_w2, *g_b, *head_norm, *rel_bias, *w_out, *norm_ffn, *peer_wq, *peer_sk, *peer_u, *peer_v, *norm_ple, *w_ple_gate, *w_ple, *final_norm;
    float* out; unsigned char* ws;
};

DI void win_map(int n, int& src, float& sc) {
    sc = 1.f;
    if (n < 256) { src = n; sc = 0.125f; }
    else if (n < 1024) src = n;
    else if (n < 1536) src = n + 16;
    else if (n < 2048) { src = n + 16; sc = 0.125f; }
    else if (n < 3072) src = n + 16;
    else if (n < 3088) src = n - 3072 + 1024;
    else src = -1;
}
DI void transpose_item(const float* W, int N, int K, bf16* WT, int n0, int k0, bool winmap, float* tile, int tid) {
    const int nl = tid & 63, kq = tid >> 6;
    int src = n0 + nl; float sc = 1.f;
    if (winmap) win_map(n0 + nl, src, sc);
#pragma unroll
    for (int kk = 0; kk < 8; ++kk) { const int k = kq * 8 + kk; tile[k * 65 + nl] = src >= 0 ? W[(size_t)(k0 + k) * N + src] * sc : 0.f; }
    __syncthreads();
    const int r = tid >> 3, c = tid & 7;
    u32x4 o;
    o.x = pk2(tile[(c * 8 + 0) * 65 + r], tile[(c * 8 + 1) * 65 + r]); o.y = pk2(tile[(c * 8 + 2) * 65 + r], tile[(c * 8 + 3) * 65 + r]);
    o.z = pk2(tile[(c * 8 + 4) * 65 + r], tile[(c * 8 + 5) * 65 + r]); o.w = pk2(tile[(c * 8 + 6) * 65 + r], tile[(c * 8 + 7) * 65 + r]);
    *(u32x4*)(WT + (size_t)(n0 + r) * K + k0 + c * 8) = o;
    __syncthreads();
}
DI void wq2_item(const float* wq, const float* sk, bf16* WT, int hp, int k0, float* lds, int tid) {
    float* s_sk = lds;
    float* s_wq = lds + 128 * 132;
#pragma unroll
    for (int i = 0; i < 8; ++i) { const int idx = tid + i * 512, n = idx >> 5, d4 = idx & 31; *(f32x4*)(s_sk + n * 132 + d4 * 4) = *(const f32x4*)(sk + (size_t)hp * 16384 + n * 128 + d4 * 4); }
#pragma unroll
    for (int i = 0; i < 4; ++i) { const int idx = tid + i * 512, k = idx >> 5, d4 = idx & 31; *(f32x4*)(s_wq + k * 132 + d4 * 4) = *(const f32x4*)(wq + (size_t)(k0 + k) * 2048 + hp * 128 + d4 * 4); }
    __syncthreads();
    const int tn = tid & 31, tk = tid >> 5;
    float acc[4][4];
#pragma unroll
    for (int a = 0; a < 4; ++a)
#pragma unroll
        for (int b = 0; b < 4; ++b) acc[a][b] = 0.f;
    for (int d4 = 0; d4 < 32; ++d4) {
        f32x4 av[4], bv[4];
#pragma unroll
        for (int a = 0; a < 4; ++a) av[a] = *(const f32x4*)(s_sk + (tn * 4 + a) * 132 + d4 * 4);
#pragma unroll
        for (int b = 0; b < 4; ++b) bv[b] = *(const f32x4*)(s_wq + (tk * 4 + b) * 132 + d4 * 4);
#pragma unroll
        for (int a = 0; a < 4; ++a)
#pragma unroll
            for (int b = 0; b < 4; ++b) acc[a][b] += av[a][0] * bv[b][0] + av[a][1] * bv[b][1] + av[a][2] * bv[b][2] + av[a][3] * bv[b][3];
    }
#pragma unroll
    for (int a = 0; a < 4; ++a) { u32x2 o; o.x = pk2(acc[a][0], acc[a][1]); o.y = pk2(acc[a][2], acc[a][3]);
        *(u32x2*)(WT + (size_t)(hp * 128 + tn * 4 + a) * 1024 + k0 + tk * 4) = o; }
    __syncthreads();
}
DI void phase_prep(Frame& F) {
    float* tile = (float*)F.lds;
    constexpr int I_WIN = 832, I_WOUT = 256, I_WG = 256, I_WP = 64, I_WQ2 = 256, I_L = I_WIN + I_WOUT + I_WG + I_WP + I_WQ2;
    for (int it = F.bid; it < DEPTH * I_L; it += F.G) {
        const int l = it / I_L; int r = it % I_L;
        bf16* wl = (bf16*)(F.ws + WS_W + (size_t)l * W_LAYER);
        if (r < I_WIN) { transpose_item(F.w_in + (size_t)l * DM * IN_W, IN_W, DM, wl + WO_WIN / 2, (r >> 4) * 64, (r & 15) * 64, true, tile, F.tid); continue; } r -= I_WIN;
        if (r < I_WOUT) { transpose_item(F.w_out + (size_t)l * DM * DM, DM, DM, wl + WO_WOUT / 2, (r >> 4) * 64, (r & 15) * 64, false, tile, F.tid); continue; } r -= I_WOUT;
        if (r < I_WG) { transpose_item(F.w_ple_gate + (size_t)l * DM * DM, DM, DM, wl + WO_WG / 2, (r >> 4) * 64, (r & 15) * 64, false, tile, F.tid); continue; } r -= I_WG;
        if (r < I_WP) { transpose_item(F.w_ple + (size_t)l * 256 * DM, DM, 256, wl + WO_WP / 2, (r >> 2) * 64, (r & 3) * 64, false, tile, F.tid); continue; } r -= I_WP;
        wq2_item(F.peer_wq + (size_t)l * DM * 2048, F.peer_sk + (size_t)l * 16 * 16384, wl + WO_WQ2 / 2, r >> 4, (r & 15) * 64, tile, F.tid);
    }
}

DI void rms_row_to_bf16(const float* xrow, const float* g, bf16* orow, int lane) {
    const f32x4* xr = (const f32x4*)xrow + lane; const f32x4* gr = (const f32x4*)g + lane;
    f32x4 v[4]; float s = 0.f;
#pragma unroll
    for (int j = 0; j < 4; ++j) { v[j] = xr[64 * j]; s += (v[j].x * v[j].x + v[j].y * v[j].y) + (v[j].z * v[j].z + v[j].w * v[j].w); }
    const float rs = rsqrtf(wave_sum(s) * (1.f / DM) + RMS_EPS);
    u32x2* o8 = (u32x2*)orow + lane;
#pragma unroll
    for (int j = 0; j < 4; ++j) { const f32x4 gg = gr[64 * j]; u32x2 o; o.x = pk2(v[j].x * rs * gg.x, v[j].y * rs * gg.y); o.y = pk2(v[j].z * rs * gg.z, v[j].w * rs * gg.w); o8[64 * j] = o; }
}
DI void phase_init_rows(Frame& F, const float* src, const float* g, bf16* dst, float* ssq) {
    const int lane = F.lane;
    for (int m = F.bid * NWAVES + F.wave; m < NT; m += F.G * NWAVES) {
        const f32x4* xr = (const f32x4*)(src + (size_t)m * DM) + lane; const f32x4* gr = (const f32x4*)g + lane;
        f32x4 v[4]; float s = 0.f;
#pragma unroll
        for (int j = 0; j < 4; ++j) { v[j] = xr[64 * j]; s += (v[j].x * v[j].x + v[j].y * v[j].y) + (v[j].z * v[j].z + v[j].w * v[j].w); }
        s = wave_sum(s);
        u32x2* o8 = (u32x2*)(dst + (size_t)m * DM) + lane;
#pragma unroll
        for (int j = 0; j < 4; ++j) { const f32x4 gg = gr[64 * j]; u32x2 o; o.x = pk2(v[j].x * gg.x, v[j].y * gg.y); o.y = pk2(v[j].z * gg.z, v[j].w * gg.w); o8[64 * j] = o; }
        if (lane < 16) ssq[(size_t)m * 16 + lane] = lane == 0 ? s : 0.f;
    }
}
DI void phase_norm(Frame& F, const float* src, const float* g, bf16* dst) {
    for (int m = F.bid * NWAVES + F.wave; m < NT; m += F.G * NWAVES) rms_row_to_bf16(src + (size_t)m * DM, g, dst + (size_t)m * DM, F.lane);
}
DI void phase_final_norm(Frame& F, const float* g, const float* ssq) {
    for (int m = F.bid * NWAVES + F.wave; m < NT; m += F.G * NWAVES) {
        f32x4* xr = (f32x4*)(F.out + (size_t)m * DM) + F.lane; const f32x4* gr = (const f32x4*)g + F.lane;
        const float rs = pg8::rs_from16(ssq + (size_t)m * 16);
#pragma unroll
        for (int j = 0; j < 4; ++j) { const f32x4 gg = gr[64 * j]; xr[64 * j] = xr[64 * j] * rs * gg; }
    }
}
DI void convert_bf16(Frame& F, const float* src, bf16* dst, size_t n) {
    const size_t n8 = n >> 3;
    for (size_t i = (size_t)F.bid * NTHR + F.tid; i < n8; i += (size_t)F.G * NTHR) {
        const f32x4 a = ((const f32x4*)src)[2 * i], b = ((const f32x4*)src)[2 * i + 1];
        u32x4 o; o.x = pk2(a.x, a.y); o.y = pk2(a.z, a.w); o.z = pk2(b.x, b.y); o.w = pk2(b.z, b.w);
        ((u32x4*)dst)[i] = o;
    }
}

DI void att_unit(Frame& F, int l, int b, int h, int c, const bf16* proj, bf16* ocat) {
    const int tid = F.tid, lane = F.lane, w = F.wave, r = lane & 31, h2 = lane >> 5, qh = w & 1, kg = w >> 1;
    float* tab = (float*)F.lds;
    float* Ot = (float*)(F.lds + 2048);
    float* ML = (float*)(F.lds + 2048 + 8 * 64 * 33 * 4);
    if (tid < 257) tab[tid] = F.rel_bias[(size_t)l * 8 * 257 + h * 257 + tid];
    __syncthreads();
    const int m0 = b * SEQ + c * 64;
    const bf16* qp = proj + (size_t)(m0 + qh * 32 + r) * PW + C_AQ + h * 64 + h2 * 8;
    bf16x8 qf[4];
#pragma unroll
    for (int s = 0; s < 4; ++s) qf[s] = *(const bf16x8*)(qp + s * 16);
    const int nvc = (c < 8 ? c : 8) + 1, kt0 = 18 - 2 * nvc;
    f32x16 o0, o1;
#pragma unroll
    for (int i = 0; i < 16; ++i) { o0[i] = 0.f; o1[i] = 0.f; }
    float mrun = -1e30f, lrun = 0.f;
    const int iq = qh * 32 + r;
    for (int kt = kt0 + kg; kt < 18; kt += 4) {
        const int krow0 = b * SEQ + (c - 8) * 64 + kt * 32;
        const bf16* kp = proj + (size_t)(krow0 + r) * PW + C_AK + h * 64 + h2 * 8;
        bf16x8 kf[4];
#pragma unroll
        for (int s = 0; s < 4; ++s) kf[s] = *(const bf16x8*)(kp + s * 16);
        const bf16* vp = proj + (size_t)krow0 * PW + C_AV + h * 64 + r;
        bf16x8 vf[2][2];
#pragma unroll
        for (int s = 0; s < 2; ++s)
#pragma unroll
            for (int dt = 0; dt < 2; ++dt)
#pragma unroll
                for (int j = 0; j < 8; ++j) vf[s][dt][j] = (short)vp[(size_t)(16 * s + 8 * (j >> 2) + 4 * h2 + (j & 3)) * PW + dt * 32];
        f32x16 sacc;
#pragma unroll
        for (int i = 0; i < 16; ++i) sacc[i] = 0.f;
#pragma unroll
        for (int s = 0; s < 4; ++s) sacc = MFMA32(kf[s], qf[s], sacc);
        const int jb = kt * 32 + 4 * h2;
        float tmax = -1e30f;
#pragma unroll
        for (int i = 0; i < 16; ++i) { const int j = jb + (i & 3) + 8 * (i >> 2); int rel = iq + 512 - j; rel = rel < -128 ? -128 : (rel > 128 ? 128 : rel);
            sacc[i] += tab[rel + 128]; tmax = fmaxf(tmax, sacc[i]); }
        tmax = fmaxf(tmax, __shfl_xor(tmax, 32));
        const float mnew = fmaxf(mrun, tmax), alpha = __expf(mrun - mnew);
        float psum = 0.f;
#pragma unroll
        for (int i = 0; i < 16; ++i) { const float p = __expf(sacc[i] - mnew); sacc[i] = p; psum += p; }
        lrun = lrun * alpha + psum; mrun = mnew;
#pragma unroll
        for (int i = 0; i < 16; ++i) { o0[i] *= alpha; o1[i] *= alpha; }
#pragma unroll
        for (int s = 0; s < 2; ++s) { const bf16x8 pf = pack8(sacc, s); o0 = MFMA32(vf[s][0], pf, o0); o1 = MFMA32(vf[s][1], pf, o1); }
    }
    lrun += __shfl_xor(lrun, 32);
#pragma unroll
    for (int i = 0; i < 16; ++i) { const int d = crow(i, h2); Ot[(w * 64 + d) * 33 + r] = o0[i]; Ot[(w * 64 + 32 + d) * 33 + r] = o1[i]; }
    if (h2 == 0) { ML[w * 64 + r] = mrun; ML[w * 64 + 32 + r] = lrun; }
    __syncthreads();
    {
        const int q = tid >> 3, dg = tid & 7, qq = q & 31, qhh = q >> 5;
        float mg[4], lg[4], ms = -1e30f;
#pragma unroll
        for (int g = 0; g < 4; ++g) { const int ww = g * 2 + qhh; mg[g] = ML[ww * 64 + qq]; lg[g] = ML[ww * 64 + 32 + qq]; ms = fmaxf(ms, mg[g]); }
        float L = 0.f, wg[4];
#pragma unroll
        for (int g = 0; g < 4; ++g) { wg[g] = __expf(mg[g] - ms); L += wg[g] * lg[g]; }
        const float inv = 1.f / L;
        float ov[8];
#pragma unroll
        for (int dd = 0; dd < 8; ++dd) { float a = 0.f;
#pragma unroll
            for (int g = 0; g < 4; ++g) a += wg[g] * Ot[((g * 2 + qhh) * 64 + dg * 8 + dd) * 33 + qq];
            ov[dd] = a * inv; }
        u32x4 o; o.x = pk2(ov[0], ov[1]); o.y = pk2(ov[2], ov[3]); o.z = pk2(ov[4], ov[5]); o.w = pk2(ov[6], ov[7]);
        *(u32x4*)(ocat + (size_t)(m0 + q) * DM + 512 + h * 64 + dg * 8) = o;
    }
    __syncthreads();
}

constexpr int GL_GLR = 0, GL_W2 = 4096, GL_B2 = 8192, GL_CUM = 8448, GL_TOT = GL_CUM + 16384, GL_VT = GL_TOT + 2048, GL_KS = GL_VT + 128 * 72 * 2, GL_QE = GL_KS + 64 * 72 * 2, GL_KE = GL_QE + 64 * 72 * 2,
              GL_QG = GL_KE + 64 * 72 * 2, GL_OS = GL_QG + 64 * 72 * 2, GL_SSQ = GL_OS + 64 * 132 * 4, GL_END = GL_SSQ + 1024;
static_assert(GL_END <= LDS_BYTES && GL_VT % 16 == 0 && GL_KS % 16 == 0 && GL_QE % 16 == 0 && GL_OS % 16 == 0, "GLA LDS map");
DI float log_sigmoid(float x) { return fminf(x, 0.f) - log1pf(__expf(-fabsf(x))); }
DI void gla_cum(Frame& F, int l, int h, int m0, const bf16* proj) {
    const int tid = F.tid;
    float* Gl = (float*)(F.lds + GL_GLR); float* W2 = (float*)(F.lds + GL_W2); float* B2 = (float*)(F.lds + GL_B2); float* CUM = (float*)(F.lds + GL_CUM); float* TOT = (float*)(F.lds + GL_TOT);
    if (tid < 128) { const int t = tid >> 1, hf = tid & 1; const u32x4 v = *(const u32x4*)(proj + (size_t)(m0 + t) * PW + C_GLR + hf * 8);
        float* g = Gl + t * 16 + hf * 8; g[0] = bf2f(v.x & 0xffffu); g[1] = bf2f(v.x >> 16); g[2] = bf2f(v.y & 0xffffu); g[3] = bf2f(v.y >> 16); g[4] = bf2f(v.z & 0xffffu); g[5] = bf2f(v.z >> 16); g[6] = bf2f(v.w & 0xffffu); g[7] = bf2f(v.w >> 16); }
#pragma unroll
    for (int i = 0; i < 2; ++i) { const int idx = tid + i * 512, rr = idx >> 6, d = idx & 63; W2[idx] = F.g_w2[(size_t)l * 16 * 256 + rr * 256 + h * 64 + d]; }
    if (tid < 64) B2[tid] = F.g_b[(size_t)l * 256 + h * 64 + tid];
    __syncthreads();
    const int d = tid & 63, tq = tid >> 6;
    float w2r[16];
#pragma unroll
    for (int rr = 0; rr < 16; ++rr) w2r[rr] = W2[rr * 64 + d];
    const float bb = B2[d];
    float run = 0.f;
#pragma unroll
    for (int tt = 0; tt < 8; ++tt) { const int t = tq * 8 + tt; float x = bb;
#pragma unroll
        for (int rr = 0; rr < 16; ++rr) x += Gl[t * 16 + rr] * w2r[rr];
        run += log_sigmoid(x) * (1.f / 16.f); CUM[t * 64 + d] = run; }
    TOT[tq * 64 + d] = run;
    __syncthreads();
    float off = 0.f;
    for (int q = 0; q < tq; ++q) off += TOT[q * 64 + d];
#pragma unroll
    for (int tt = 0; tt < 8; ++tt) CUM[(tq * 8 + tt) * 64 + d] += off;
    __syncthreads();
}
DI void gla_stage_vt(Frame& F, int h, int m0, const bf16* proj) {
    const int tid = F.tid, e = tid & 127, cq = tid >> 7;
    bf16* Vt = (bf16*)(F.lds + GL_VT);
    unsigned short v[16];
#pragma unroll
    for (int i = 0; i < 16; ++i) v[i] = proj[(size_t)(m0 + cq * 16 + i) * PW + C_GV + h * 128 + e];
    u32x4 a, b2;
    a.x = v[0] | ((unsigned)v[1] << 16); a.y = v[2] | ((unsigned)v[3] << 16); a.z = v[4] | ((unsigned)v[5] << 16); a.w = v[6] | ((unsigned)v[7] << 16);
    b2.x = v[8] | ((unsigned)v[9] << 16); b2.y = v[10] | ((unsigned)v[11] << 16); b2.z = v[12] | ((unsigned)v[13] << 16); b2.w = v[14] | ((unsigned)v[15] << 16);
    *(u32x4*)(Vt + e * 72 + cq * 16) = a; *(u32x4*)(Vt + e * 72 + cq * 16 + 8) = b2;
}
DI void gla_kv_unit(Frame& F, int l, int b, int h, int c, const bf16* proj, float* KVt, float* dec) {
    const int tid = F.tid, lane = F.lane, w = F.wave, r = lane & 31, h2 = lane >> 5;
    const int m0 = b * SEQ + c * 64, unit = (b * 4 + h) * 64 + c;
    float* CUM = (float*)(F.lds + GL_CUM); bf16* Vt = (bf16*)(F.lds + GL_VT); bf16* Ks = (bf16*)(F.lds + GL_KS);
    gla_cum(F, l, h, m0, proj);
    {
        const int d = tid & 63, tq = tid >> 6; const float last = CUM[63 * 64 + d];
        float kv[8];
#pragma unroll
        for (int tt = 0; tt < 8; ++tt) { const int t = tq * 8 + tt; kv[tt] = bf2f(proj[(size_t)(m0 + t) * PW + C_GK + h * 64 + d]) * __expf(last - CUM[t * 64 + d]); }
        u32x4 o; o.x = pk2(kv[0], kv[1]); o.y = pk2(kv[2], kv[3]); o.z = pk2(kv[4], kv[5]); o.w = pk2(kv[6], kv[7]);
        *(u32x4*)(Ks + d * 72 + tq * 8) = o;
        if (tid < 64) dec[(size_t)unit * 64 + tid] = __expf(last);
    }
    gla_stage_vt(F, h, m0, proj);
    __syncthreads();
    {
        const int et = w >> 1, dt = w & 1;
        f32x16 acc;
#pragma unroll
        for (int i = 0; i < 16; ++i) acc[i] = 0.f;
#pragma unroll
        for (int s = 0; s < 4; ++s) { const bf16x8 a = *(const bf16x8*)(Vt + (et * 32 + r) * 72 + 16 * s + 8 * h2); const bf16x8 bb = *(const bf16x8*)(Ks + (dt * 32 + r) * 72 + 16 * s + 8 * h2); acc = MFMA32(a, bb, acc); }
        float* o = KVt + (size_t)unit * 8192;
#pragma unroll
        for (int i = 0; i < 16; ++i) o[(et * 32 + crow(i, h2)) * 64 + dt * 32 + r] = acc[i];
    }
    __syncthreads();
}
DI void phase_scan(Frame& F, float* __restrict__ KVt, const float* __restrict__ dec) {
    for (int idx = F.bid * NTHR + F.tid; idx < 32 * 8192; idx += F.G * NTHR) {
        const int bh = idx >> 13, ed = idx & 8191, d = ed & 63;
        float* p = KVt + (size_t)bh * 64 * 8192 + ed; const float* dc = dec + (size_t)bh * 64 * 64 + d;
        float S = 0.f;
        for (int n0 = 0; n0 < 64; n0 += 16) {
            float kv[16], dy[16];
#pragma unroll
            for (int i = 0; i < 16; ++i) { kv[i] = p[(size_t)(n0 + i) * 8192]; dy[i] = dc[(n0 + i) * 64]; }
#pragma unroll
            for (int i = 0; i < 16; ++i) { p[(size_t)(n0 + i) * 8192] = S; S = dy[i] * S + kv[i]; }
        }
    }
}
DI void gla_out_unit(Frame& F, int l, int b, int h, int c, const bf16* proj, const float* prevT, bf16* ocat) {
    const int tid = F.tid, lane = F.lane, w = F.wave, r = lane & 31, h2 = lane >> 5;
    const int m0 = b * SEQ + c * 64, unit = (b * 4 + h) * 64 + c;
    float* CUM = (float*)(F.lds + GL_CUM); bf16* Vt = (bf16*)(F.lds + GL_VT); bf16* Qe = (bf16*)(F.lds + GL_QE); bf16* Ke = (bf16*)(F.lds + GL_KE); bf16* Qg = (bf16*)(F.lds + GL_QG);
    float* Os = (float*)(F.lds + GL_OS);
    gla_cum(F, l, h, m0, proj);
    {
        const int d = tid & 63, tq = tid >> 6; const float mid = CUM[32 * 64 + d];
#pragma unroll
        for (int tt = 0; tt < 8; ++tt) { const int t = tq * 8 + tt; const float cm = CUM[t * 64 + d];
            const float q = bf2f(proj[(size_t)(m0 + t) * PW + C_GQ + h * 64 + d]), k = bf2f(proj[(size_t)(m0 + t) * PW + C_GK + h * 64 + d]);
            Qe[t * 72 + d] = (bf16)f2bf(q * __expf(cm - mid)); Ke[t * 72 + d] = (bf16)f2bf(k * __expf(mid - cm)); Qg[t * 72 + d] = (bf16)f2bf(q * __expf(cm)); }
    }
    gla_stage_vt(F, h, m0, proj);
    __syncthreads();
    {
        const int et = w >> 1, it = w & 1;
        f32x16 o;
#pragma unroll
        for (int i = 0; i < 16; ++i) o[i] = 0.f;
        const float* pp = prevT + (size_t)unit * 8192 + (et * 32 + r) * 64 + 8 * h2;
#pragma unroll
        for (int s = 0; s < 4; ++s) { const f32x4 p0 = *(const f32x4*)(pp + 16 * s), p1 = *(const f32x4*)(pp + 16 * s + 4);
            u32x4 pa; pa.x = pk2(p0.x, p0.y); pa.y = pk2(p0.z, p0.w); pa.z = pk2(p1.x, p1.y); pa.w = pk2(p1.z, p1.w);
            const bf16x8 bq = *(const bf16x8*)(Qg + (it * 32 + r) * 72 + 16 * s + 8 * h2);
            o = MFMA32(__builtin_bit_cast(bf16x8, pa), bq, o); }
        for (int jt = 0; jt <= it; ++jt) {
            f32x16 X;
#pragma unroll
            for (int i = 0; i < 16; ++i) X[i] = 0.f;
#pragma unroll
            for (int s = 0; s < 4; ++s) { const bf16x8 a = *(const bf16x8*)(Ke + (jt * 32 + r) * 72 + 16 * s + 8 * h2); const bf16x8 bb = *(const bf16x8*)(Qe + (it * 32 + r) * 72 + 16 * s + 8 * h2); X = MFMA32(a, bb, X); }
            if (jt == it) {
#pragma unroll
                for (int i = 0; i < 16; ++i) if (crow(i, h2) > r) X[i] = 0.f;
            }
#pragma unroll
            for (int s = 0; s < 2; ++s) { const bf16x8 pf = pack8(X, s);
                const u32x2 lo = *(const u32x2*)(Vt + (et * 32 + r) * 72 + jt * 32 + 16 * s + 4 * h2), hi = *(const u32x2*)(Vt + (et * 32 + r) * 72 + jt * 32 + 16 * s + 8 + 4 * h2);
                u32x4 va; va.x = lo.x; va.y = lo.y; va.z = hi.x; va.w = hi.y;
                o = MFMA32(__builtin_bit_cast(bf16x8, va), pf, o); }
        }
#pragma unroll
        for (int i = 0; i < 16; ++i) Os[(it * 32 + r) * 132 + et * 32 + crow(i, h2)] = o[i];
    }
    __syncthreads();
    {
        const int i = tid >> 3, ec = tid & 7, e0 = ec * 16;
        float v[16]; float ss = 0.f;
#pragma unroll
        for (int k = 0; k < 4; ++k) { const f32x4 t = *(const f32x4*)(Os + i * 132 + e0 + 4 * k); v[4 * k] = t.x; v[4 * k + 1] = t.y; v[4 * k + 2] = t.z; v[4 * k + 3] = t.w; ss += (t.x * t.x + t.y * t.y) + (t.z * t.z + t.w * t.w); }
        ss += __shfl_xor(ss, 1); ss += __shfl_xor(ss, 2); ss += __shfl_xor(ss, 4);
        const float rs = rsqrtf(ss * (1.f / 128.f) + RMS_EPS);
        const u32x4 g0 = *(const u32x4*)(proj + (size_t)(m0 + i) * PW + C_GOG + h * 128 + e0), g1 = *(const u32x4*)(proj + (size_t)(m0 + i) * PW + C_GOG + h * 128 + e0 + 8);
        const unsigned gw[8] = {g0.x, g0.y, g0.z, g0.w, g1.x, g1.y, g1.z, g1.w};
        const float* hn = F.head_norm + (size_t)l * 128 + e0;
        unsigned ow[8];
#pragma unroll
        for (int k = 0; k < 8; ++k) { const float ga = bf2f(gw[k] & 0xffffu), gb = bf2f(gw[k] >> 16);
            const float a = v[2 * k] * rs * hn[2 * k] * (ga / (1.f + __expf(-ga))), bq = v[2 * k + 1] * rs * hn[2 * k + 1] * (gb / (1.f + __expf(-gb)));
            ow[k] = pk2(a, bq); }
        u32x4 o0, o1; o0.x = ow[0]; o0.y = ow[1]; o0.z = ow[2]; o0.w = ow[3]; o1.x = ow[4]; o1.y = ow[5]; o1.z = ow[6]; o1.w = ow[7];
        *(u32x4*)(ocat + (size_t)(m0 + i) * DM + h * 128 + e0) = o0; *(u32x4*)(ocat + (size_t)(m0 + i) * DM + h * 128 + e0 + 8) = o1;
    }
    __syncthreads();
}

DI unsigned ord_f32(float v) { const unsigned b = __float_as_uint(v); return (b & 0x80000000u) ? ~b : (b | 0x80000000u); }
#define CE_DESC(a, b) do { const unsigned hi_ = (a) > (b) ? (a) : (b), lo_ = (a) > (b) ? (b) : (a); (a) = hi_; (b) = lo_; } while (0)
DI void bitonic_merge16_desc(unsigned (&v)[16]) {
#pragma unroll
    for (int j = 8; j > 0; j >>= 1)
#pragma unroll
        for (int i = 0; i < 16; ++i) { const int l = i ^ j; if (l > i) CE_DESC(v[i], v[l]); }
}
DI void sort16_desc(unsigned (&v)[16]) {
#pragma unroll
    for (int k = 2; k <= 16; k <<= 1)
#pragma unroll
        for (int j = k >> 1; j > 0; j >>= 1)
#pragma unroll
            for (int i = 0; i < 16; ++i) { const int l = i ^ j; if (l > i) { if ((i & k) == 0 || k == 16) CE_DESC(v[i], v[l]); else CE_DESC(v[l], v[i]); } }
}
DI void merge_top16(unsigned (&a)[16], const unsigned (&b)[16]) {
#pragma unroll
    for (int i = 0; i < 16; ++i) a[i] = a[i] > b[15 - i] ? a[i] : b[15 - i];
    bitonic_merge16_desc(a);
}
struct CandTab { int ci[64], cj[64], n; };
constexpr CandTab make_cand_tab() { CandTab c{}; c.n = 0; for (int i = 0; i < 16; ++i) for (int j = 0; j < 16; ++j) if ((i + 1) * (j + 1) <= 16) { c.ci[c.n] = i; c.cj[c.n] = j; ++c.n; } return c; }
constexpr int TK_PITCH = 132;
DI void topk_load(const float* sc, int tile, int tid, f32x4 (&buf)[16]) {
    const float* src = sc + (size_t)tile * 32768;
#pragma unroll
    for (int i = 0; i < 16; ++i) buf[i] = *(const f32x4*)(src + (size_t)(tid + i * 512) * 4);
}
DI void topk_store_lds(float* S, int tid, const f32x4 (&buf)[16]) {
#pragma unroll
    for (int i = 0; i < 16; ++i) { const int idx = tid + i * 512, R = idx >> 5, c4 = idx & 31; *(f32x4*)(S + R * TK_PITCH + c4 * 4) = buf[i]; }
}
DI void topk_tile(Frame& F, int tile, int next_tile, const float* sc, int* eout, float* gout, f32x4 (&buf)[16]) {
    const int tid = F.tid;
    float* S = (float*)F.lds;
    topk_store_lds(S, tid, buf);
    __syncthreads();
    if (next_tile >= 0) topk_load(sc, next_tile, tid, buf);
    const int R = tid >> 1, jh = tid & 1;
    const float* row = S + R * TK_PITCH + jh * 64;
    unsigned top[16];
#pragma unroll
    for (int gq = 0; gq < 4; ++gq) {
        unsigned v[16];
#pragma unroll
        for (int q = 0; q < 4; ++q) { const f32x4 x = *(const f32x4*)(row + gq * 16 + q * 4); const int n0 = jh * 64 + gq * 16 + q * 4;
            v[4 * q + 0] = (ord_f32(x.x) & ~127u) | (unsigned)(127 - n0); v[4 * q + 1] = (ord_f32(x.y) & ~127u) | (unsigned)(126 - n0);
            v[4 * q + 2] = (ord_f32(x.z) & ~127u) | (unsigned)(125 - n0); v[4 * q + 3] = (ord_f32(x.w) & ~127u) | (unsigned)(124 - n0); }
        sort16_desc(v);
        if (gq == 0) {
#pragma unroll
            for (int k = 0; k < 16; ++k) top[k] = v[k];
        } else merge_top16(top, v);
    }
    {
        unsigned oth[16];
#pragma unroll
        for (int k = 0; k < 16; ++k) oth[k] = (unsigned)__shfl_xor((int)top[k], 1);
        merge_top16(top, oth);
    }
    float tv[8]; int ti[8];
#pragma unroll
    for (int k = 0; k < 8; ++k) { const unsigned msk = 0u - (unsigned)jh, key = (top[8 + k] & msk) | (top[k] & ~msk); ti[k] = 127 - (int)(key & 127u); tv[k] = S[R * TK_PITCH + ti[k]]; }
    __syncthreads();
    float* LV = (float*)F.lds; int* LI = (int*)(F.lds + 16384);
#pragma unroll
    for (int k = 0; k < 8; ++k) { LV[R * 16 + jh * 8 + k] = tv[k]; LI[R * 16 + jh * 8 + k] = ti[k]; }
    __syncthreads();
    if (tid < 128) {
        const int R1 = 2 * tid, R2 = 2 * tid + 1;
        float s1[16], s2[16];
#pragma unroll
        for (int k = 0; k < 16; ++k) { s1[k] = LV[R1 * 16 + k]; s2[k] = LV[R2 * 16 + k]; }
        unsigned tk[16];
#pragma unroll
        for (int grp = 0; grp < 4; ++grp) {
            unsigned v[16];
#pragma unroll
            for (int k = 0; k < 16; ++k) { constexpr CandTab CT = make_cand_tab(); const int idx = grp * 16 + k;
                v[k] = idx < CT.n ? ((ord_f32(s1[CT.ci[idx < CT.n ? idx : 0]] + s2[CT.cj[idx < CT.n ? idx : 0]]) & ~255u) | (unsigned)(255 - (CT.ci[idx < CT.n ? idx : 0] * 16 + CT.cj[idx < CT.n ? idx : 0]))) : 0u; }
            sort16_desc(v);
            if (grp == 0) {
#pragma unroll
                for (int k = 0; k < 16; ++k) tk[k] = v[k];
            } else merge_top16(tk, v);
        }
        float topv[16]; int ee[16]; float mx = -1e30f;
#pragma unroll
        for (int k = 0; k < 16; ++k) { const int cid = 255 - (int)(tk[k] & 255u), i = cid >> 4, j = cid & 15;
            topv[k] = LV[R1 * 16 + i] + LV[R2 * 16 + j]; ee[k] = LI[R1 * 16 + i] * 128 + LI[R2 * 16 + j]; mx = fmaxf(mx, topv[k]); }
        float sum = 0.f;
#pragma unroll
        for (int k = 0; k < 16; ++k) { topv[k] = __expf(topv[k] - mx); sum += topv[k]; }
        const float inv = 1.f / sum;
        const int t = tile * 16 + (tid >> 3), hh = tid & 7;
        int* eo = eout + (size_t)t * 128 + hh * 16; float* go = gout + (size_t)t * 128 + hh * 16;
#pragma unroll
        for (int k = 0; k < 16; ++k) { eo[k] = ee[k]; go[k] = topv[k] * inv; }
    }
    __syncthreads();
}
DI void phase_topk(Frame& F, const float* sc, int* eout, float* gout) {
    f32x4 buf[16];
    int tile = F.bid;
    if (tile < NT / 16) topk_load(sc, tile, F.tid, buf);
    for (; tile < NT / 16; tile += F.G) { const int nxt = tile + F.G < NT / 16 ? tile + F.G : -1; topk_tile(F, tile, nxt, sc, eout, gout, buf); }
}

typedef float f32x2 __attribute__((ext_vector_type(2)));
DI unsigned pack4_fp8(float a, float b, float c, float d) { int w = 0; w = __builtin_amdgcn_cvt_pk_fp8_f32(a, b, w, false); w = __builtin_amdgcn_cvt_pk_fp8_f32(c, d, w, true); return (unsigned)w; }
DI float wave_max(float v) {
#pragma unroll
    for (int o = 1; o < 64; o <<= 1) v = fmaxf(v, __shfl_xor(v, o));
    return v;
}
DI void convert_rows_fp8(Frame& F, const float* src, unsigned char* dst, float* rscale, bool vslice) {
    const int lane = F.lane;
    for (int e = F.bid * NWAVES + F.wave; e < NEXP; e += F.G * NWAVES) {
        const f32x4* r = (const f32x4*)(src + (size_t)e * DM) + lane * 4;
        f32x4 v[4]; float mx = 0.f;
#pragma unroll
        for (int j = 0; j < 4; ++j) { v[j] = r[j]; mx = fmaxf(mx, fmaxf(fmaxf(fabsf(v[j].x), fabsf(v[j].y)), fmaxf(fabsf(v[j].z), fabsf(v[j].w)))); }
        mx = wave_max(mx);
        const float s = mx > 0.f ? 240.f / mx : 1.f, inv = mx > 0.f ? mx * (1.f / 240.f) : 1.f;
        u32x4 o; o.x = pack4_fp8(v[0].x * s, v[0].y * s, v[0].z * s, v[0].w * s); o.y = pack4_fp8(v[1].x * s, v[1].y * s, v[1].z * s, v[1].w * s);
        o.z = pack4_fp8(v[2].x * s, v[2].y * s, v[2].z * s, v[2].w * s); o.w = pack4_fp8(v[3].x * s, v[3].y * s, v[3].z * s, v[3].w * s);
        if (!vslice) *(u32x4*)(dst + (size_t)e * DM + lane * 16) = o;
        else *(u32x4*)(dst + ((size_t)(lane >> 3) * NEXP + e) * 128 + (lane & 7) * 16) = o;
        if (lane == 0) rscale[e] = inv;
    }
}
DI unsigned xcc_id() { return (unsigned)__builtin_amdgcn_s_getreg((3 << 11) | 20) & 7u; }
DI unsigned wave_dequeue(unsigned* ctr, int lane) { unsigned v = 0; if (lane == 0) v = __hip_atomic_fetch_add(ctr, 1u, __ATOMIC_RELAXED, __HIP_MEMORY_SCOPE_AGENT); return (unsigned)__builtin_amdgcn_readfirstlane((int)v); }
constexpr int PEER_ITEM_TOK = 32, PEER_ITEMS = NT / PEER_ITEM_TOK;
struct PeerMetaU { int ea, eb; u32x4 xa, xb; };
struct PeerMetaV { int ea, eb; float ha, hb; f32x2 hv; };
DI PeerMetaU peer_meta_u(int lane, int t, int sl, const bf16* xn, const int* E) {
    PeerMetaU m; m.ea = E[(size_t)t * 128 + lane]; m.eb = E[(size_t)t * 128 + 64 + lane];
    const bf16* xp = xn + (size_t)t * DM + sl * 128 + (lane & 7) * 16; m.xa = *(const u32x4*)xp; m.xb = *(const u32x4*)(xp + 8); return m;
}
DI PeerMetaV peer_meta_v(int lane, int t, int sl, const int* E, const float* hid, const float* h) {
    PeerMetaV m; m.ea = E[(size_t)t * 128 + lane]; m.eb = E[(size_t)t * 128 + 64 + lane]; m.ha = hid[(size_t)t * 128 + lane]; m.hb = hid[(size_t)t * 128 + 64 + lane];
    m.hv = *(const f32x2*)(h + (size_t)t * DM + sl * 128 + (lane & 7) * 16 + (lane >> 3) * 2); return m;
}
struct PeerRows { u32x4 w[16]; };
DI void peer_load_rows(int lane, int sl, int ea, int eb, const unsigned char* T8s, PeerRows& R) {
    const int g = lane >> 3, sub = lane & 7;
    const unsigned tb = (unsigned)sl * (NEXP * 128u) + (unsigned)sub * 16u;
#pragma unroll
    for (int I = 0; I < 16; ++I) { const unsigned ek = (unsigned)__shfl(I < 8 ? ea : eb, (I & 7) * 8 + g); R.w[I] = *(const u32x4*)(T8s + (size_t)(tb + ek * 128u)); }
}
DI void peer_u_visit(int lane, int t, int sl, const PeerMetaU& m, const PeerRows& R, float* part) {
    const int g = lane >> 3;
    f32x2 xp[8];
    { const unsigned wv[8] = {m.xa.x, m.xa.y, m.xa.z, m.xa.w, m.xb.x, m.xb.y, m.xb.z, m.xb.w};
#pragma unroll
      for (int k = 0; k < 8; ++k) { xp[k].x = bf2f(wv[k] & 0xffffu); xp[k].y = __uint_as_float(wv[k] & 0xffff0000u); } }
    float s[16];
#pragma unroll
    for (int I = 0; I < 16; ++I) {
        const unsigned wv[4] = {R.w[I].x, R.w[I].y, R.w[I].z, R.w[I].w};
        f32x2 s2 = {0.f, 0.f};
#pragma unroll
        for (int k = 0; k < 4; ++k) { s2 = __builtin_amdgcn_cvt_pk_f32_fp8((int)wv[k], false) * xp[2 * k] + s2; s2 = __builtin_amdgcn_cvt_pk_f32_fp8((int)wv[k], true) * xp[2 * k + 1] + s2; }
        s[I] = s2.x + s2.y;
    }
    const bool b2 = (lane & 4) != 0, b1 = (lane & 2) != 0, b0 = (lane & 1) != 0;
    float p[8], q[4], r[2];
#pragma unroll
    for (int j = 0; j < 8; ++j) { const float keep = b2 ? s[8 + j] : s[j], send = b2 ? s[j] : s[8 + j]; p[j] = keep + __shfl_xor(send, 4); }
#pragma unroll
    for (int j = 0; j < 4; ++j) { const float keep = b1 ? p[4 + j] : p[j], send = b1 ? p[j] : p[4 + j]; q[j] = keep + __shfl_xor(send, 2); }
#pragma unroll
    for (int j = 0; j < 2; ++j) { const float keep = b0 ? q[2 + j] : q[j], send = b0 ? q[j] : q[2 + j]; r[j] = keep + __shfl_xor(send, 1); }
    const int I0 = (b2 ? 8 : 0) + (b1 ? 4 : 0) + (b0 ? 2 : 0);
    float* pp = part + ((size_t)sl * NT + t) * 128;
#pragma unroll
    for (int j = 0; j < 2; ++j) { const int I = I0 + j; pp[64 * (I >> 3) + 8 * (I & 7) + g] = r[j]; }
}
DI void peer_v_visit(int lane, int t, int sl, const PeerMetaV& m, const PeerRows& R, float* h, f32x2 g2, bf16* xo, float* ssq) {
    const int g = lane >> 3, sub = lane & 7;
    float hk[16];
#pragma unroll
    for (int I = 0; I < 16; ++I) hk[I] = __shfl(I < 8 ? m.ha : m.hb, (I & 7) * 8 + g);
    f32x2 o[8];
#pragma unroll
    for (int k = 0; k < 8; ++k) o[k] = (f32x2){0.f, 0.f};
#pragma unroll
    for (int I = 0; I < 16; ++I) {
        const unsigned wv[4] = {R.w[I].x, R.w[I].y, R.w[I].z, R.w[I].w}; const f32x2 h2 = {hk[I], hk[I]};
#pragma unroll
        for (int k = 0; k < 4; ++k) { o[2 * k] = __builtin_amdgcn_cvt_pk_f32_fp8((int)wv[k], false) * h2 + o[2 * k]; o[2 * k + 1] = __builtin_amdgcn_cvt_pk_f32_fp8((int)wv[k], true) * h2 + o[2 * k + 1]; }
    }
    const bool b5 = (lane & 32) != 0, b4 = (lane & 16) != 0, b3 = (lane & 8) != 0;
    f32x2 p[4];
#pragma unroll
    for (int k = 0; k < 4; ++k) { const f32x2 keep = b5 ? o[4 + k] : o[k], send = b5 ? o[k] : o[4 + k]; f32x2 rc; rc.x = __shfl_xor(send.x, 32); rc.y = __shfl_xor(send.y, 32); p[k] = keep + rc; }
    f32x2 q[2];
#pragma unroll
    for (int k = 0; k < 2; ++k) { const f32x2 keep = b4 ? p[2 + k] : p[k], send = b4 ? p[k] : p[2 + k]; f32x2 rc; rc.x = __shfl_xor(send.x, 16); rc.y = __shfl_xor(send.y, 16); q[k] = keep + rc; }
    f32x2 r1;
    { const f32x2 keep = b3 ? q[1] : q[0], send = b3 ? q[0] : q[1]; f32x2 rc; rc.x = __shfl_xor(send.x, 8); rc.y = __shfl_xor(send.y, 8); r1 = keep + rc; }
    const f32x2 hn = m.hv + r1;
    *(f32x2*)(h + (size_t)t * DM + sl * 128 + sub * 16 + g * 2) = hn;
    *(unsigned*)(xo + (size_t)t * DM + sl * 128 + sub * 16 + g * 2) = pk2(hn.x * g2.x, hn.y * g2.y);
    const float ss = wave_sum(hn.x * hn.x + hn.y * hn.y);
    if (lane == 0) ssq[(size_t)t * 8 + sl] = ss;
}
template <bool VSIDE>
DI void phase_peer(Frame& F, unsigned* ctr  , const bf16* xn, const int* E, const unsigned char* T8s, const float* hid, float* part, float* hbuf, const float* gnext, bf16* xo, float* ssq) {
    const unsigned xcc = xcc_id(); const int lane = F.lane;
    for (int so = 0; so < 8; ++so) {
        const int sl = (int)((xcc + (unsigned)so) & 7u);
        for (;;) {
            const unsigned item = wave_dequeue(ctr + 64 * sl, lane);
            if (item >= (unsigned)PEER_ITEMS) break;
            const int t0 = (int)item * PEER_ITEM_TOK;
            f32x2 g2 = {0.f, 0.f}; if (VSIDE) g2 = *(const f32x2*)(gnext + sl * 128 + (lane & 7) * 16 + (lane >> 3) * 2);
#define PEER_CL(x) ((x) < PEER_ITEM_TOK ? (x) : PEER_ITEM_TOK - 1)
            if (VSIDE) {
                PeerMetaV m0 = peer_meta_v(lane, t0, sl, E, hid, hbuf), m1 = peer_meta_v(lane, t0 + 1, sl, E, hid, hbuf);
                PeerRows ra, rb; peer_load_rows(lane, sl, m0.ea, m0.eb, T8s, ra);
                for (int tt = 0; tt < PEER_ITEM_TOK; tt += 2) {
                    const PeerMetaV m2 = peer_meta_v(lane, t0 + PEER_CL(tt + 2), sl, E, hid, hbuf);
                    peer_load_rows(lane, sl, m1.ea, m1.eb, T8s, rb); __builtin_amdgcn_sched_barrier(0);
                    peer_v_visit(lane, t0 + tt, sl, m0, ra, hbuf, g2, xo, ssq); __builtin_amdgcn_sched_barrier(0);
                    const PeerMetaV m3 = peer_meta_v(lane, t0 + PEER_CL(tt + 3), sl, E, hid, hbuf);
                    peer_load_rows(lane, sl, m2.ea, m2.eb, T8s, ra); __builtin_amdgcn_sched_barrier(0);
                    peer_v_visit(lane, t0 + tt + 1, sl, m1, rb, hbuf, g2, xo, ssq); __builtin_amdgcn_sched_barrier(0);
                    m0 = m2; m1 = m3;
                }
            } else {
                PeerMetaU m0 = peer_meta_u(lane, t0, sl, xn, E), m1 = peer_meta_u(lane, t0 + 1, sl, xn, E);
                PeerRows ra, rb; peer_load_rows(lane, sl, m0.ea, m0.eb, T8s, ra);
                for (int tt = 0; tt < PEER_ITEM_TOK; tt += 2) {
                    const PeerMetaU m2 = peer_meta_u(lane, t0 + PEER_CL(tt + 2), sl, xn, E);
                    peer_load_rows(lane, sl, m1.ea, m1.eb, T8s, rb); __builtin_amdgcn_sched_barrier(0);
                    peer_u_visit(lane, t0 + tt, sl, m0, ra, part); __builtin_amdgcn_sched_barrier(0);
                    const PeerMetaU m3 = peer_meta_u(lane, t0 + PEER_CL(tt + 3), sl, xn, E);
                    peer_load_rows(lane, sl, m2.ea, m2.eb, T8s, ra); __builtin_amdgcn_sched_barrier(0);
                    peer_u_visit(lane, t0 + tt + 1, sl, m1, rb, part); __builtin_amdgcn_sched_barrier(0);
                    m0 = m2; m1 = m3;
                }
            }
        }
    }
}
DI void phase_peer_hid(Frame& F, const int* E, const float* Gt, const float* part, const float* usc, const float* vsc, const float* ssq, float* hid) {
    const int lane = F.lane;
    for (int t = F.bid * NWAVES + F.wave; t < NT; t += F.G * NWAVES) {
        const float rs = pg8::rs_from16(ssq + (size_t)t * 16);
#pragma unroll
        for (int hf = 0; hf < 2; ++hf) { const size_t i = (size_t)t * 128 + hf * 64 + lane;
            float a = 0.f;
#pragma unroll
            for (int sl = 0; sl < 8; ++sl) a += part[(size_t)sl * NT * 128 + i];
            const int e = E[i]; a *= usc[e] * rs;
            hid[i] = Gt[i] * (0.5f * a * (1.f + erff(a * 0.70710678118654752f))) * vsc[e]; }
    }
}

#define LAS __attribute__((address_space(3)))
#define XB_TMO      128
#define XB_XCNT(j)  (256  + 64 * (j))
#define XB_XSUB(j)  (1280 + 64 * (j))
#define XB_XGEN(j)  (2304 + 64 * (j))
#define XB_TOP      3328
#define XB_TOPGEN   3392
#define XCD_BAR_WORDS 3456
#define XB_SPIN_CAP (1u << 18)

__device__ __forceinline__ unsigned xb_ld(unsigned* p)              { return __hip_atomic_load(p, __ATOMIC_RELAXED, __HIP_MEMORY_SCOPE_AGENT); }
__device__ __forceinline__ unsigned xb_add(unsigned* p, unsigned v) { return __hip_atomic_fetch_add(p, v, __ATOMIC_RELAXED, __HIP_MEMORY_SCOPE_AGENT); }
__device__ __forceinline__ unsigned xb_xcc_id() { return (unsigned)__builtin_amdgcn_s_getreg((3 << 11) | 20) & 0xFu; }
#define XB_SPIN(cond, bar) do { unsigned _sp = 0; while (cond) { __builtin_amdgcn_s_sleep(1); \
    if ((++_sp & 255u) == 0u) { if (xb_ld(&(bar)[XB_TMO])) break; if (_sp > XB_SPIN_CAP) { atomicAdd(&(bar)[XB_TMO], 1u); break; } } } } while (0)

struct XcdBarrier {
    unsigned* bar; unsigned x;
    volatile LAS unsigned* st;
};

__device__ __forceinline__ XcdBarrier xcd_barrier_post(unsigned* bar, volatile LAS unsigned* st) {
    XcdBarrier b; b.bar = bar; b.x = xb_xcc_id(); b.st = st;
    if (threadIdx.x == 0) (void)xb_add(&bar[XB_XCNT(b.x)], 1u);
    return b;
}
__device__ __forceinline__ void xcd_barrier_complete(unsigned* bar, unsigned x, unsigned& nloc, unsigned& nx) {
    const unsigned G = gridDim.x * gridDim.y * gridDim.z;
    unsigned sum, cnt, mine, sp = 0u;
    for (;;) {
        sum = 0u; cnt = 0u; mine = 0u;
#pragma unroll
        for (unsigned j = 0; j < 16; ++j) { const unsigned c = xb_ld(&bar[XB_XCNT(j)]); sum += c; cnt += (c > 0u) ? 1u : 0u; mine = (j == x) ? c : mine; }
        if (sum == G) break;
        __builtin_amdgcn_s_sleep(1);
        if ((++sp & 255u) == 0u) { if (xb_ld(&bar[XB_TMO])) break; if (sp > XB_SPIN_CAP) { atomicAdd(&bar[XB_TMO], 1u); break; } }
    }
    nloc = mine > 0u ? mine : 1u; nx = cnt > 0u ? cnt : 1u;
}

__device__ __forceinline__ void xcd_barrier(const XcdBarrier& b) {
    asm volatile("s_waitcnt vmcnt(0)" ::: "memory");
    __syncthreads();
    if (threadIdx.x == 0) {
        unsigned* bar = b.bar;
        __builtin_amdgcn_s_waitcnt(0);
        unsigned nloc = b.st[0], nx = b.st[1];
        if (nloc == 0u) { xcd_barrier_complete(bar, b.x, nloc, nx); b.st[0] = nloc; b.st[1] = nx; }
        const unsigned old = xb_add(&bar[XB_XSUB(b.x)], 1u);
        const unsigned gen = old / nloc;
        if (old + 1u == (gen + 1u) * nloc) {
            __builtin_amdgcn_fence(__ATOMIC_RELEASE, "agent");
            asm volatile("s_waitcnt vmcnt(0)" ::: "memory");
            const unsigned og = xb_add(&bar[XB_TOP], 1u);
            const unsigned tg = og / nx;
            if (og + 1u == (tg + 1u) * nx) xb_add(&bar[XB_TOPGEN], 1u);
            else XB_SPIN(xb_ld(&bar[XB_TOPGEN]) == tg, bar);
            __builtin_amdgcn_fence(__ATOMIC_ACQUIRE, "agent");
            xb_add(&bar[XB_XGEN(b.x)], 1u);
            asm volatile("s_waitcnt vmcnt(0)" ::: "memory");
        } else {
            XB_SPIN(xb_ld(&bar[XB_XGEN(b.x)]) == gen, bar);
            __builtin_amdgcn_fence(__ATOMIC_ACQUIRE, "agent");
            asm volatile("s_waitcnt vmcnt(0)" ::: "memory");
        }
    }
    __syncthreads();
}

#ifndef PHMASK
#define PHMASK 0xFFFF
#endif
#define EN(n) if constexpr (((PHMASK) >> (n)) & 1)
#ifndef PROBE_DUP
#define PROBE_DUP -1
#endif
constexpr int NPH = 25;

__global__ void __launch_bounds__(NTHR, 2) hybrid_fwd(Args args) {
    extern __shared__ __attribute__((aligned(16))) unsigned char lds[];
    unsigned char* ws = args.ws;
    bf16* proj = (bf16*)(ws + WS_A); float* sc = (float*)(ws + WS_A);
    bf16* xn = (bf16*)(ws + WS_XN);
    bf16* ocat = (bf16*)(ws + WS_C); int* eids = (int*)(ws + WS_C); float* gates = (float*)(ws + WS_C + 16 * MiB); float* hid = (float*)(ws + WS_C + 32 * MiB); unsigned* ctl = (unsigned*)ws;
    float* kvt = (float*)(ws + WS_D); unsigned char* u8 = ws + WS_D; unsigned char* v8 = ws + WS_D + 16 * MiB; float* usc = (float*)(ws + WS_D + 32 * MiB); float* vsc = (float*)(ws + WS_D + 33 * MiB);
    bf16* pb = (bf16*)(ws + WS_PB); float* dec = (float*)(ws + WS_DEC);
    cg::grid_group grid = cg::this_grid();
    volatile LAS unsigned* misc = (volatile LAS unsigned*)((LAS unsigned char*)lds + (LDS_BYTES - 64));
    if (threadIdx.x < 16) misc[threadIdx.x] = 0u;
    __syncthreads();
    XcdBarrier xbar = xcd_barrier_post((unsigned*)args.ws + CTL_BAR, misc);
    PG8_LAS unsigned char* gl = (PG8_LAS unsigned char*)lds;

    float* ssqA = (float*)(ws + WS_ST); float* ssqB = (float*)(ws + WS_ST + 2 * MiB); float* ssqC = (float*)(ws + WS_ST + 3 * MiB);
    bf16* xnC = (bf16*)(ws + WS_C);
    bf16* pw = (bf16*)(ws + WS_A + 128 * MiB);
#ifndef PROBE_TMASK
#define PROBE_TMASK 0u
#endif
    unsigned long long pt_acc = 0ull;
    for (int ph = args.ph_lo, rep = 0; ph < args.ph_hi;) {
        const unsigned long long pt_t0 = (PROBE_TMASK != 0u) ? __builtin_amdgcn_s_memrealtime() : 0ull; const int pt_ph = ph;
        int tid_ = threadIdx.x; asm volatile("" : "+v"(tid_));
        Frame F;
        F.lds = lds; F.tid = tid_; F.lane = F.tid & 63; F.wave = __builtin_amdgcn_readfirstlane(F.tid >> 6); F.G = gridDim.x; F.bid = blockIdx.x;
        F.x = args.in[0]; F.p = args.in[1]; F.norm_mix = args.in[2]; F.w_in = args.in[3]; F.g_w2 = args.in[4]; F.g_b = args.in[5]; F.head_norm = args.in[6]; F.rel_bias = args.in[7]; F.w_out = args.in[8];
        F.norm_ffn = args.in[9]; F.peer_wq = args.in[10]; F.peer_sk = args.in[11]; F.peer_u = args.in[12]; F.peer_v = args.in[13]; F.norm_ple = args.in[14]; F.w_ple_gate = args.in[15]; F.w_ple = args.in[16]; F.final_norm = args.in[17];
        F.out = args.out; F.ws = args.ws;
        int l = 0, sp = -1;
        if (ph >= 1 && ph <= 12) { l = 0; sp = ph - 1; } else if (ph >= 13 && ph < NPH - 1) { l = 1; sp = ph - 12; }
        if (ph == 0) { EN(14) { phase_prep(F); } }
        else if (ph == NPH - 1) { EN(15) phase_final_norm(F, F.final_norm, ssqC); }
        else {
            const pg8::bf16_t* wl = (const pg8::bf16_t*)(ws + WS_W + (size_t)l * W_LAYER);
            const float* hsrc = (l == 0) ? F.x : F.out;
            switch (sp) {
            case 0: EN(0) {
                phase_init_rows(F, F.x, F.norm_mix, xn, ssqC);
            } break;
            case 1: EN(1) {
                pg8::Gemm g{(const pg8::bf16_t*)(l == 0 ? xn : xnC), wl + WO_WIN / 2, NT, PW, DM}; pg8::StaticOrder S; S.init(NT, PW, F.G, F.bid);
                pg8::EpiBf16RS E{(pg8::bf16_t*)proj, PW, ssqC};
                pg8::gemm_phase<pg8::EpiBf16RS, pg8::StaticOrder, true, true>(gl, g, S, E, F.tid);
            } break;
            case 2: EN(2) {
                for (int u = F.bid; u < NB * 8 * 64; u += F.G) { const int c = ((u & 63) + (u >> 6)) & 63, h = (u >> 6) & 7, b = u >> 9; att_unit(F, l, b, h, c, proj, ocat); }
                for (int u = F.bid; u < NB * 4 * 64; u += F.G) { const int c = u & 63, h = (u >> 6) & 3, b = u >> 8; gla_kv_unit(F, l, b, h, c, proj, kvt, dec); }
            } break;
            case 3: EN(3) { phase_scan(F, rep ? (float*)xn : kvt, dec); convert_bf16(F, F.p + (size_t)l * NT * 256, pb, (size_t)NT * 256); } break;
            case 4: EN(4) {
                for (int u = F.bid; u < NB * 4 * 64; u += F.G) { const int c = u & 63, h = (u >> 6) & 3, b = u >> 8; gla_out_unit(F, l, b, h, c, proj, kvt, ocat); }
            } break;
            case 5: EN(5) {
                pg8::Gemm g{(const pg8::bf16_t*)ocat, wl + WO_WOUT / 2, NT, DM, DM}; pg8::StaticOrder S; S.init(NT, DM, F.G, F.bid);
                pg8::EpiResidN E{hsrc, rep ? (float*)(ws + WS_A) : F.out, DM, F.norm_ffn + (size_t)l * DM, rep ? (pg8::bf16_t*)(ws + WS_A + 128 * MiB) : (pg8::bf16_t*)xn, rep ? ssqC : ssqA};
                pg8::gemm_phase<pg8::EpiResidN, pg8::StaticOrder, true, true>(gl, g, S, E, F.tid);
                convert_rows_fp8(F, F.peer_u + (size_t)l * NEXP * DM, u8, usc, true);
                convert_rows_fp8(F, F.peer_v + (size_t)l * NEXP * DM, v8, vsc, true);
            } break;
            case 6: EN(6) {
                pg8::Gemm g{(const pg8::bf16_t*)xn, wl + WO_WQ2 / 2, NT, 2048, DM}; pg8::StaticOrder S; S.init(NT, 2048, F.G, F.bid);
                pg8::EpiF32RS E{sc, 2048, ssqA};
                pg8::gemm_phase<pg8::EpiF32RS, pg8::StaticOrder, true, true>(gl, g, S, E, F.tid);
            } break;
            case 7: EN(7) { phase_topk(F, sc, eids, gates); } break;
            case 8: EN(8) { phase_peer<false>(F, ctl + 64 * (16 * l + 32 * rep), xn, eids, u8, hid, (float*)(ws + WS_A), nullptr, nullptr, nullptr, nullptr); } break;
            case 9: EN(9) {
                phase_peer_hid(F, eids, gates, (const float*)(ws + WS_A), usc, vsc, ssqA, hid);
                int kp = 256; asm volatile("" : "+s"(kp));
                pg8::Gemm g{(const pg8::bf16_t*)pb, wl + WO_WP / 2, NT, DM, kp}; pg8::StaticOrder S; S.init(NT, DM, F.G, F.bid);
                pg8::EpiBf16P E{(pg8::bf16_t*)pw, DM};
                pg8::gemm_phase<pg8::EpiBf16P, pg8::StaticOrder, true, true>(gl, g, S, E, F.tid);
            } break;
            case 10: EN(10) { phase_peer<true>(F, ctl + 64 * (16 * l + 8 + 32 * rep), xn, eids, v8, hid, nullptr, rep ? (float*)(ws + WS_A) : F.out, F.norm_ple + (size_t)l * DM, rep ? (bf16*)(ws + WS_A + 192 * MiB) : xn, rep ? ssqA : ssqB); } break;
            case 11: EN(11) {
                pg8::Gemm g{(const pg8::bf16_t*)xn, wl + WO_WG / 2, NT, DM, DM}; pg8::StaticOrder S; S.init(NT, DM, F.G, F.bid);
                pg8::EpiPleN E{F.out, rep ? (float*)(ws + WS_A) : F.out, (const pg8::bf16_t*)pw, DM, ssqB, F.norm_mix + (size_t)(l + 1 < DEPTH ? l + 1 : l) * DM, l + 1 < DEPTH ? (rep ? (pg8::bf16_t*)(ws + WS_A + 192 * MiB) : (pg8::bf16_t*)xnC) : nullptr, rep ? ssqA : ssqC};
                pg8::gemm_phase<pg8::EpiPleN, pg8::StaticOrder, true, true>(gl, g, S, E, F.tid);
            } break;
            }
        }
        bool adv = true;
        if (PROBE_DUP >= 0 && (sp == PROBE_DUP || (PROBE_DUP == 100 && ph == 0) || (PROBE_DUP == 101 && ph == NPH - 1)) && rep == 0) { rep = 1; adv = false; }
        if (adv) { rep = 0; ++ph; }
        if (ph < args.ph_hi) { if (USE_XCD_BARRIER && ph > 1) { xcd_barrier(xbar); if (PROBE_DUP == 200) xcd_barrier(xbar); } else grid.sync(); }
        if (PROBE_TMASK != 0u && ((PROBE_TMASK >> pt_ph) & 1u)) pt_acc += __builtin_amdgcn_s_memrealtime() - pt_t0;
    }
    if (PROBE_TMASK != 0u && blockIdx.x == 0 && threadIdx.x == 0) { const unsigned long long t0 = __builtin_amdgcn_s_memrealtime(); while (__builtin_amdgcn_s_memrealtime() - t0 < pt_acc) __builtin_amdgcn_s_sleep(8); }
}

extern "C" void kernel_launch(void* const* d_in, const int* in_sizes, int n_in, void* d_out, int out_size, void* d_ws, size_t ws_size, hipStream_t stream) {
    static int grid = 0;
    if (grid == 0) {
        if (n_in != 18 || in_sizes[0] != NT * DM || out_size != NT * DM || ws_size < WS_END) { fprintf(stderr, "kernel_launch: unexpected shapes (n_in %d, in0 %d, out %d, ws %zu); nothing launched\n", n_in, n_in > 0 ? in_sizes[0] : -1, out_size, ws_size); grid = -1; return; }
        int dev = 0, cus = 0, per_cu = 0;
        if (hipGetDevice(&dev) != hipSuccess || hipDeviceGetAttribute(&cus, hipDeviceAttributeMultiprocessorCount, dev) != hipSuccess) { fprintf(stderr, "kernel_launch: device query failed\n"); grid = -1; return; }
        if (hipFuncSetAttribute((const void*)hybrid_fwd, hipFuncAttributeMaxDynamicSharedMemorySize, LDS_BYTES) != hipSuccess) { fprintf(stderr, "kernel_launch: hipFuncSetAttribute failed\n"); grid = -1; return; }
        if (hipOccupancyMaxActiveBlocksPerMultiprocessor(&per_cu, (const void*)hybrid_fwd, NTHR, LDS_BYTES) != hipSuccess || per_cu < 1) { fprintf(stderr, "kernel_launch: occupancy query says %d blocks per CU\n", per_cu); (void)hipGetLastError(); grid = -1; return; }
        grid = cus * 1;
    }
    if (grid < 0) return;
    if (hipMemsetAsync(d_ws, 0, CTL_ZERO_BYTES, stream) != hipSuccess) { fprintf(stderr, "kernel_launch: hipMemsetAsync failed\n"); return; }
    Args a{};
    for (int i = 0; i < 18; ++i) a.in[i] = (const float*)d_in[i];
    a.out = (float*)d_out; a.ws = (unsigned char*)d_ws;
#if MK_N_LAUNCHES == 1
    a.ph_lo = 0; a.ph_hi = NPH;
    void* kargs[] = {&a};
    hipError_t e = hipLaunchCooperativeKernel((const void*)hybrid_fwd, dim3(grid), dim3(NTHR), kargs, LDS_BYTES, stream);
    if (e != hipSuccess) fprintf(stderr, "kernel_launch: cooperative launch failed: %s (grid %d)\n", hipGetErrorString(e), grid);
#else
    for (int ph = 0; ph < NPH; ++ph) { a.ph_lo = ph; a.ph_hi = ph + 1; hipLaunchKernelGGL(hybrid_fwd, dim3(grid), dim3(NTHR), LDS_BYTES, stream, a); }
#endif
}
```

```cpp
#include <hip/hip_runtime.h>
#include <hip/hip_cooperative_groups.h>
#include <cstdio>
#include <cstdint>
namespace cg = cooperative_groups;
#define MK_N_LAUNCHES 1
namespace pg8 {
#define PG8_LAS __attribute__((address_space(3)))
typedef unsigned short bf16_t;
typedef short bf16x8 __attribute__((ext_vector_type(8)));
typedef float f32x4 __attribute__((ext_vector_type(4)));
typedef unsigned u32x4 __attribute__((ext_vector_type(4)));
constexpr int BM = 256, BK = 64, HALF = 128, HTB = HALF * BK * 2  , STAGE_BYTES = 8 * HTB, NXCD = 8, WGM = 8;

__host__ __device__ __forceinline__ int lds_byte(int r, int c) { const int st = (r >> 4) * 2 + (c >> 5), rr = r & 15, cc = c & 31, ob = rr * 64 + cc * 2; return st * 1024 + (ob ^ (((ob >> 9) & 1) << 5)); }
__host__ __device__ __forceinline__ void stage_rc(int b, int& R, int& C) { const int st = b / 1024, sb = b % 1024, swz = sb ^ (((sb >> 9) & 1) << 5); R = (st >> 1) * 16 + swz / 64; C = (st & 1) * 32 + (swz % 64) / 2; }
__host__ __device__ __forceinline__ int perm32(int rho) { const int n = rho >> 4, i = rho & 15; return 8 * (i >> 2) + 4 * n + (i & 3); }

struct Unit { int pm, pn; };
struct Gemm { const bf16_t* A; const bf16_t* Bt; int M, N, K; };

struct StaticOrder {
    int nM, nN, nwg, G, c;
    __host__ __device__ void init(int M, int N, int G_, int c_) { nM = M / BM; nN = N / BM; nwg = nM * nN; G = G_; c = c_; }
    __host__ __device__ bool next(int i, Unit& u) const {
        const long L = (long)i * G + c; if (L >= nwg) return false;
        int wgid = (int)L; { const int q = nwg / NXCD, r = nwg % NXCD, xcd = wgid % NXCD, off = wgid / NXCD; wgid = (xcd < r ? xcd * (q + 1) : r * (q + 1) + (xcd - r) * q) + off; }
        const int nig = WGM * nN, gid = wgid / nig, fm = gid * WGM, gsz = (nM - fm) < WGM ? (nM - fm) : WGM;
        u.pm = fm + ((wgid % nig) % gsz); u.pn = (wgid % nig) / gsz; return true;
    }
    __device__ __forceinline__ void a_ready(const Unit&) const {}
    __device__ __forceinline__ void done(const Unit&) const {}
};

__device__ __forceinline__ unsigned cvt_pk_bf16(float lo, float hi) { unsigned r; asm volatile("v_cvt_pk_bf16_f32 %0, %1, %2" : "=v"(r) : "v"(lo), "v"(hi)); return r; }
typedef float f32x2 __attribute__((ext_vector_type(2)));
__device__ __forceinline__ f32x2 gelu_pk(f32x2 v) {
    const f32x2 av = __builtin_elementwise_abs(v), d = av * 0.2316418882f + 1.0f;
    f32x2 t; t.x = __builtin_amdgcn_rcpf(d.x); t.y = __builtin_amdgcn_rcpf(d.y);
    f32x2 q = t * 0.5307027145f + (-0.7265760135f); q = q * t + 0.7107068705f; q = q * t + (-0.142248368f); q = q * t + 0.127414796f; q = q * t;
    const f32x2 s = (v * v) * (-0.72134752044f);
    f32x2 e; e.x = __builtin_amdgcn_exp2f(s.x); e.y = __builtin_amdgcn_exp2f(s.y);
    const f32x2 m = v * (q * e), r = v - m;
    f32x2 o; o.x = v.x < 0.f ? m.x : r.x; o.y = v.y < 0.f ? m.y : r.y; return o;
}

template <int ACT  > struct EpiBf16 {
    static constexpr bool PERM = true, AFTER_DRAIN = false; static_assert(ACT == 0 || ACT == 1, "EpiBf16: ACT is 0 (none) or 1 (gelu_pk)");
    bf16_t* O; int ldc; const float* bias; int split_cols; size_t split_stride; float scale0;
    __device__ __forceinline__ void operator()(const f32x4 (&acc)[2][2][4][2], const Unit& u, int wr, int wc, int fr, int fq) const {
        const int row0 = u.pm * BM + wr * 64 + fr; int colt = u.pn * BM; bf16_t* base = O;
        float sc = 1.f; if (split_cols) { const int t = colt / split_cols; base += (size_t)t * split_stride; colt -= t * split_cols; if (t == 0) sc = scale0; }
        const int col0 = colt + wc * 32 + 8 * fq, bcol0 = u.pn * BM + wc * 32 + 8 * fq;
        f32x4 bv[2][2];
#pragma unroll
        for (int bj = 0; bj < 2; ++bj)
#pragma unroll
            for (int n = 0; n < 2; ++n) bv[bj][n] = bias ? *(const f32x4*)(bias + bcol0 + bj * HALF + 4 * n) : (f32x4){0.f, 0.f, 0.f, 0.f};
#pragma unroll
        for (int ai = 0; ai < 2; ++ai)
#pragma unroll
            for (int m = 0; m < 4; ++m) { bf16_t* rowp = base + (size_t)(row0 + ai * HALF + m * 16) * ldc + col0;
#pragma unroll
                for (int bj = 0; bj < 2; ++bj) { f32x4 v0 = acc[ai][bj][m][0] + bv[bj][0], v1 = acc[ai][bj][m][1] + bv[bj][1];
                    if (ACT == 1) { f32x2 a = gelu_pk((f32x2){v0[0], v0[1]}), b = gelu_pk((f32x2){v0[2], v0[3]}), c = gelu_pk((f32x2){v1[0], v1[1]}), d = gelu_pk((f32x2){v1[2], v1[3]});
                        v0 = (f32x4){a.x, a.y, b.x, b.y}; v1 = (f32x4){c.x, c.y, d.x, d.y}; }
                    v0 = v0 * sc; v1 = v1 * sc; u32x4 w; w.x = cvt_pk_bf16(v0[0], v0[1]); w.y = cvt_pk_bf16(v0[2], v0[3]); w.z = cvt_pk_bf16(v1[0], v1[1]); w.w = cvt_pk_bf16(v1[2], v1[3]);
                    *(u32x4*)(rowp + bj * HALF) = w; } }
    }
};

struct EpiF32Store {
    static constexpr bool PERM = false, AFTER_DRAIN = false;
    float* C; int ldc;
    __device__ __forceinline__ void operator()(const f32x4 (&acc)[2][2][4][2], const Unit& u, int wr, int wc, int fr, int fq) const {
        const int row0 = u.pm * BM + wr * 64 + fr, col0 = u.pn * BM + wc * 32 + 4 * fq;
#pragma unroll
        for (int ai = 0; ai < 2; ++ai)
#pragma unroll
            for (int m = 0; m < 4; ++m) { float* rowp = C + (size_t)(row0 + ai * HALF + m * 16) * ldc + col0;
#pragma unroll
                for (int bj = 0; bj < 2; ++bj)
#pragma unroll
                    for (int n = 0; n < 2; ++n) *(f32x4*)(rowp + bj * HALF + n * 16) = acc[ai][bj][m][n]; }
    }
};
struct EpiResid {
    static constexpr bool PERM = false, AFTER_DRAIN = false;
    const float* base; float* out; int ldc;
    __device__ __forceinline__ void operator()(const f32x4 (&acc)[2][2][4][2], const Unit& u, int wr, int wc, int fr, int fq) const {
        const int row0 = u.pm * BM + wr * 64 + fr, col0 = u.pn * BM + wc * 32 + 4 * fq;
#pragma unroll
        for (int ai = 0; ai < 2; ++ai)
#pragma unroll
            for (int m = 0; m < 4; ++m) { const size_t off = (size_t)(row0 + ai * HALF + m * 16) * ldc + col0;
                f32x4 bs[2][2];
#pragma unroll
                for (int bj = 0; bj < 2; ++bj)
#pragma unroll
                    for (int n = 0; n < 2; ++n) bs[bj][n] = *(const f32x4*)(base + off + bj * HALF + n * 16);
#pragma unroll
                for (int bj = 0; bj < 2; ++bj)
#pragma unroll
                    for (int n = 0; n < 2; ++n) *(f32x4*)(out + off + bj * HALF + n * 16) = bs[bj][n] + acc[ai][bj][m][n];
                asm volatile("" ::: "memory"); }
    }
};
struct EpiPle {
    static constexpr bool PERM = false, AFTER_DRAIN = false;
    const float* base; float* out; const bf16_t* pw; int ldc;
    __device__ __forceinline__ void operator()(const f32x4 (&acc)[2][2][4][2], const Unit& u, int wr, int wc, int fr, int fq) const {
        typedef unsigned u32x2v __attribute__((ext_vector_type(2)));
        const int row0 = u.pm * BM + wr * 64 + fr, col0 = u.pn * BM + wc * 32 + 4 * fq;
#pragma unroll
        for (int ai = 0; ai < 2; ++ai)
#pragma unroll
            for (int m = 0; m < 4; ++m) { const size_t off = (size_t)(row0 + ai * HALF + m * 16) * ldc + col0;
                f32x4 bs[2][2]; u32x2v pv[2][2];
#pragma unroll
                for (int bj = 0; bj < 2; ++bj)
#pragma unroll
                    for (int n = 0; n < 2; ++n) { bs[bj][n] = *(const f32x4*)(base + off + bj * HALF + n * 16); pv[bj][n] = *(const u32x2v*)(pw + off + bj * HALF + n * 16); }
#pragma unroll
                for (int bj = 0; bj < 2; ++bj)
#pragma unroll
                    for (int n = 0; n < 2; ++n) { const f32x4 a = acc[ai][bj][m][n]; f32x4 o;
                        const float p0 = __uint_as_float(pv[bj][n].x << 16), p1 = __uint_as_float(pv[bj][n].x & 0xffff0000u), p2 = __uint_as_float(pv[bj][n].y << 16), p3 = __uint_as_float(pv[bj][n].y & 0xffff0000u);
                        o[0] = bs[bj][n][0] + p0 / (1.0f + __expf(-a[0])); o[1] = bs[bj][n][1] + p1 / (1.0f + __expf(-a[1]));
                        o[2] = bs[bj][n][2] + p2 / (1.0f + __expf(-a[2])); o[3] = bs[bj][n][3] + p3 / (1.0f + __expf(-a[3]));
                        *(f32x4*)(out + off + bj * HALF + n * 16) = o; }
                asm volatile("" ::: "memory"); }
    }
};

__device__ __forceinline__ float rs_from16(const float* ss) { const f32x4 a = ((const f32x4*)ss)[0], b = ((const f32x4*)ss)[1], c = ((const f32x4*)ss)[2], d = ((const f32x4*)ss)[3];
    const f32x4 s = (a + b) + (c + d); return rsqrtf(((s[0] + s[1]) + (s[2] + s[3])) * (1.0f / 1024.0f) + 1e-6f); }
__device__ __forceinline__ float rs_from8(const float* ss) { const f32x4 a = ((const f32x4*)ss)[0], b = ((const f32x4*)ss)[1];
    const f32x4 s = a + b; return rsqrtf(((s[0] + s[1]) + (s[2] + s[3])) * (1.0f / 1024.0f) + 1e-6f); }
struct EpiBf16RS {
    static constexpr bool PERM = true, AFTER_DRAIN = false;
    bf16_t* O; int ldc; const float* ssq;
    __device__ __forceinline__ void operator()(const f32x4 (&acc)[2][2][4][2], const Unit& u, int wr, int wc, int fr, int fq) const {
        const int row0 = u.pm * BM + wr * 64 + fr, col0 = u.pn * BM + wc * 32 + 8 * fq;
#pragma unroll
        for (int ai = 0; ai < 2; ++ai)
#pragma unroll
            for (int m = 0; m < 4; ++m) { const int row = row0 + ai * HALF + m * 16; const float sc = rs_from16(ssq + (size_t)row * 16); bf16_t* rowp = O + (size_t)row * ldc + col0;
#pragma unroll
                for (int bj = 0; bj < 2; ++bj) { const f32x4 v0 = acc[ai][bj][m][0] * sc, v1 = acc[ai][bj][m][1] * sc;
                    u32x4 w; w.x = cvt_pk_bf16(v0[0], v0[1]); w.y = cvt_pk_bf16(v0[2], v0[3]); w.z = cvt_pk_bf16(v1[0], v1[1]); w.w = cvt_pk_bf16(v1[2], v1[3]);
                    *(u32x4*)(rowp + bj * HALF) = w; } }
    }
};
struct EpiF32RS {
    static constexpr bool PERM = false, AFTER_DRAIN = false;
    float* C; int ldc; const float* ssq;
    __device__ __forceinline__ void operator()(const f32x4 (&acc)[2][2][4][2], const Unit& u, int wr, int wc, int fr, int fq) const {
        const int row0 = u.pm * BM + wr * 64 + fr, col0 = u.pn * BM + wc * 32 + 4 * fq;
#pragma unroll
        for (int ai = 0; ai < 2; ++ai)
#pragma unroll
            for (int m = 0; m < 4; ++m) { const int row = row0 + ai * HALF + m * 16; const float sc = rs_from16(ssq + (size_t)row * 16); float* rowp = C + (size_t)row * ldc + col0;
#pragma unroll
                for (int bj = 0; bj < 2; ++bj)
#pragma unroll
                    for (int n = 0; n < 2; ++n) *(f32x4*)(rowp + bj * HALF + n * 16) = acc[ai][bj][m][n] * sc; }
    }
};
struct EpiResidN {
    static constexpr bool PERM = true, AFTER_DRAIN = false;
    const float* base; float* out; int ldc; const float* g; bf16_t* xo; float* ssq;
    __device__ __forceinline__ void operator()(const f32x4 (&acc)[2][2][4][2], const Unit& u, int wr, int wc, int fr, int fq) const {
        const int row0 = u.pm * BM + wr * 64 + fr, col0 = u.pn * BM + wc * 32 + 8 * fq;
        f32x4 gv[2][2];
#pragma unroll
        for (int bj = 0; bj < 2; ++bj)
#pragma unroll
            for (int n = 0; n < 2; ++n) gv[bj][n] = *(const f32x4*)(g + col0 + bj * HALF + n * 4);
#pragma unroll
        for (int ai = 0; ai < 2; ++ai)
#pragma unroll
            for (int m = 0; m < 4; ++m) { const int row = row0 + ai * HALF + m * 16; const size_t off = (size_t)row * ldc + col0;
                f32x4 bs[2][2];
#pragma unroll
                for (int bj = 0; bj < 2; ++bj)
#pragma unroll
                    for (int n = 0; n < 2; ++n) bs[bj][n] = *(const f32x4*)(base + off + bj * HALF + n * 4);
                float ss = 0.f;
#pragma unroll
                for (int bj = 0; bj < 2; ++bj) { const f32x4 o0 = bs[bj][0] + acc[ai][bj][m][0], o1 = bs[bj][1] + acc[ai][bj][m][1];
                    *(f32x4*)(out + off + bj * HALF) = o0; *(f32x4*)(out + off + bj * HALF + 4) = o1;
                    ss += ((o0[0] * o0[0] + o0[1] * o0[1]) + (o0[2] * o0[2] + o0[3] * o0[3])) + ((o1[0] * o1[0] + o1[1] * o1[1]) + (o1[2] * o1[2] + o1[3] * o1[3]));
                    const f32x4 x0 = o0 * gv[bj][0], x1 = o1 * gv[bj][1];
                    u32x4 w; w.x = cvt_pk_bf16(x0[0], x0[1]); w.y = cvt_pk_bf16(x0[2], x0[3]); w.z = cvt_pk_bf16(x1[0], x1[1]); w.w = cvt_pk_bf16(x1[2], x1[3]);
                    *(u32x4*)(xo + off + bj * HALF) = w; }
                ss += __shfl_xor(ss, 16); ss += __shfl_xor(ss, 32);
                if (fq == 0) ssq[(size_t)row * 16 + u.pn * 4 + wc] = ss;
                asm volatile("" ::: "memory"); }
    }
};
struct EpiPleN {
    static constexpr bool PERM = true, AFTER_DRAIN = false;
    const float* base; float* out; const bf16_t* pw; int ldc; const float* ssq_in; const float* g; bf16_t* xo; float* ssq;
    __device__ __forceinline__ void operator()(const f32x4 (&acc)[2][2][4][2], const Unit& u, int wr, int wc, int fr, int fq) const {
        const int row0 = u.pm * BM + wr * 64 + fr, col0 = u.pn * BM + wc * 32 + 8 * fq;
        f32x4 gv[2][2];
#pragma unroll
        for (int bj = 0; bj < 2; ++bj)
#pragma unroll
            for (int n = 0; n < 2; ++n) gv[bj][n] = *(const f32x4*)(g + col0 + bj * HALF + n * 4);
#pragma unroll
        for (int ai = 0; ai < 2; ++ai)
#pragma unroll
            for (int m = 0; m < 4; ++m) { const int row = row0 + ai * HALF + m * 16; const size_t off = (size_t)row * ldc + col0; const float rs = rs_from8(ssq_in + (size_t)row * 8);
                f32x4 bs[2][2]; u32x4 pv[2];
#pragma unroll
                for (int bj = 0; bj < 2; ++bj) { bs[bj][0] = *(const f32x4*)(base + off + bj * HALF); bs[bj][1] = *(const f32x4*)(base + off + bj * HALF + 4); pv[bj] = *(const u32x4*)(pw + off + bj * HALF); }
                float ss = 0.f;
#pragma unroll
                for (int bj = 0; bj < 2; ++bj) { const f32x4 a0 = acc[ai][bj][m][0] * rs, a1 = acc[ai][bj][m][1] * rs; f32x4 o0, o1;
                    const float p0 = __uint_as_float(pv[bj].x << 16), p1 = __uint_as_float(pv[bj].x & 0xffff0000u), p2 = __uint_as_float(pv[bj].y << 16), p3 = __uint_as_float(pv[bj].y & 0xffff0000u);
                    const float p4 = __uint_as_float(pv[bj].z << 16), p5 = __uint_as_float(pv[bj].z & 0xffff0000u), p6 = __uint_as_float(pv[bj].w << 16), p7 = __uint_as_float(pv[bj].w & 0xffff0000u);
                    o0[0] = bs[bj][0][0] + p0 / (1.0f + __expf(-a0[0])); o0[1] = bs[bj][0][1] + p1 / (1.0f + __expf(-a0[1])); o0[2] = bs[bj][0][2] + p2 / (1.0f + __expf(-a0[2])); o0[3] = bs[bj][0][3] + p3 / (1.0f + __expf(-a0[3]));
                    o1[0] = bs[bj][1][0] + p4 / (1.0f + __expf(-a1[0])); o1[1] = bs[bj][1][1] + p5 / (1.0f + __expf(-a1[1])); o1[2] = bs[bj][1][2] + p6 / (1.0f + __expf(-a1[2])); o1[3] = bs[bj][1][3] + p7 / (1.0f + __expf(-a1[3]));
                    *(f32x4*)(out + off + bj * HALF) = o0; *(f32x4*)(out + off + bj * HALF + 4) = o1;
                    ss += ((o0[0] * o0[0] + o0[1] * o0[1]) + (o0[2] * o0[2] + o0[3] * o0[3])) + ((o1[0] * o1[0] + o1[1] * o1[1]) + (o1[2] * o1[2] + o1[3] * o1[3]));
                    if (xo) { const f32x4 x0 = o0 * gv[bj][0], x1 = o1 * gv[bj][1];
                        u32x4 w; w.x = cvt_pk_bf16(x0[0], x0[1]); w.y = cvt_pk_bf16(x0[2], x0[3]); w.z = cvt_pk_bf16(x1[0], x1[1]); w.w = cvt_pk_bf16(x1[2], x1[3]);
                        *(u32x4*)(xo + off + bj * HALF) = w; } }
                ss += __shfl_xor(ss, 16); ss += __shfl_xor(ss, 32);
                if (fq == 0) ssq[(size_t)row * 16 + u.pn * 4 + wc] = ss;
                asm volatile("" ::: "memory"); }
    }
};
struct EpiBf16P {
    static constexpr bool PERM = true, AFTER_DRAIN = false;
    bf16_t* O; int ldc;
    __device__ __forceinline__ void operator()(const f32x4 (&acc)[2][2][4][2], const Unit& u, int wr, int wc, int fr, int fq) const {
        const int row0 = u.pm * BM + wr * 64 + fr, col0 = u.pn * BM + wc * 32 + 8 * fq;
#pragma unroll
        for (int ai = 0; ai < 2; ++ai)
#pragma unroll
            for (int m = 0; m < 4; ++m) { bf16_t* rowp = O + (size_t)(row0 + ai * HALF + m * 16) * ldc + col0;
#pragma unroll
                for (int bj = 0; bj < 2; ++bj) { const f32x4 v0 = acc[ai][bj][m][0], v1 = acc[ai][bj][m][1];
                    u32x4 w; w.x = cvt_pk_bf16(v0[0], v0[1]); w.y = cvt_pk_bf16(v0[2], v0[3]); w.z = cvt_pk_bf16(v1[0], v1[1]); w.w = cvt_pk_bf16(v1[2], v1[3]);
                    *(u32x4*)(rowp + bj * HALF) = w; } }
    }
};
template <class Epi, class Sched, bool ALIGN_EPI = false, bool SP2 = false>
__device__ __forceinline__ void gemm_phase(PG8_LAS unsigned char* lds, const Gemm g, const Sched& S, const Epi& E, const int tid_in) {
    const int tid = tid_in, wid = __builtin_amdgcn_readfirstlane(tid >> 6), lane = tid & 63, wr = wid >> 2, wc = wid & 3, fr = lane & 15, fq = lane >> 4;
    const int K = g.K, nt = K / BK;
    unsigned voffA[2], voffB[2];
#pragma unroll
    for (int i = 0; i < 2; ++i) { int R, C; stage_rc(tid * 16 + i * 8192, R, C); const int Rb = Epi::PERM ? ((R & ~31) + perm32(R & 31)) : R;
        voffA[i] = (unsigned)(R * K + C) * 2u; voffB[i] = (unsigned)(Rb * K + C) * 2u; }
    const size_t kstep = (size_t)(BK * 2);
    const size_t hstep = (size_t)HALF * K * 2;
    const size_t tstep = 2 * hstep;
    const unsigned ldsw = (unsigned)wid * 1024u;
    const int aoff = lds_byte(wr * 64 + fr, fq * 8), boff = lds_byte(wc * 32 + fr, fq * 8);
#define PG8_SA(b, h) (((b) * 2 + (h)) * HTB)
#define PG8_SB(b, h) ((4 + (b) * 2 + (h)) * HTB)
#define PG8_STAGE(bufoff, gbase, voff) do { _Pragma("unroll") for (int _i = 0; _i < 2; ++_i) \
        __builtin_amdgcn_global_load_lds((const unsigned*)((const char*)(gbase) + (voff)[_i]), (PG8_LAS unsigned*)(lds + (bufoff) + ldsw + _i * 8192), 16, 0, 0); } while (0)
#define PG8_LDA(dst, b, h) do { _Pragma("unroll") for (int m = 0; m < 4; ++m) _Pragma("unroll") for (int k = 0; k < 2; ++k) dst[m][k] = *(const PG8_LAS bf16x8*)(lds + PG8_SA(b, h) + aoff + m * 2048 + k * 1024); } while (0)
#define PG8_LDB(dst, b, h) do { _Pragma("unroll") for (int n = 0; n < 2; ++n) _Pragma("unroll") for (int k = 0; k < 2; ++k) dst[n][k] = *(const PG8_LAS bf16x8*)(lds + PG8_SB(b, h) + boff + n * 2048 + k * 1024); } while (0)
#define PG8_MMA(ai, bj, At, Bt) do { __builtin_amdgcn_s_setprio(1); _Pragma("unroll") for (int m = 0; m < 4; ++m) _Pragma("unroll") for (int n = 0; n < 2; ++n) _Pragma("unroll") for (int k = 0; k < 2; ++k) \
        acc[ai][bj][m][n] = __builtin_amdgcn_mfma_f32_16x16x32_bf16(Bt[n][k], At[m][k], acc[ai][bj][m][n], 0, 0, 0); __builtin_amdgcn_s_setprio(0); } while (0)
#define PG8_WAIT_V(n) asm volatile("s_waitcnt vmcnt(" #n ")" ::: "memory")
#define PG8_WAIT_L(n) asm volatile("s_waitcnt lgkmcnt(" #n ")" ::: "memory")
#define PG8_BAR __builtin_amdgcn_s_barrier()
#define PG8_SCHED __builtin_amdgcn_sched_barrier(0)
    Unit cur, nxt; int ui = 0;
    if (!S.next(0, cur)) return;
    f32x4 acc[2][2][4][2];
#pragma unroll
    for (int a = 0; a < 2; ++a)
#pragma unroll
        for (int b = 0; b < 2; ++b)
#pragma unroll
            for (int m = 0; m < 4; ++m)
#pragma unroll
                for (int n = 0; n < 2; ++n) acc[a][b][m][n] = (f32x4){0.f, 0.f, 0.f, 0.f};
    bf16x8 At[4][2], B0[2][2], B1[2][2];
    const char* cA = (const char*)g.A + (size_t)cur.pm * tstep; const char* cB = (const char*)g.Bt + (size_t)cur.pn * tstep;
    S.a_ready(cur);
    if constexpr (SP2) {
        PG8_STAGE(PG8_SB(0, 0), cB, voffB); PG8_STAGE(PG8_SB(0, 1), cB + hstep, voffB); PG8_STAGE(PG8_SA(0, 0), cA, voffA); PG8_STAGE(PG8_SA(0, 1), cA + hstep, voffA);
        if (wr == 1) PG8_BAR;
        PG8_WAIT_V(2); PG8_BAR;
        PG8_STAGE(PG8_SB(1, 0), cB + kstep, voffB); PG8_STAGE(PG8_SA(1, 0), cA + kstep, voffA); PG8_STAGE(PG8_SB(1, 1), cB + hstep + kstep, voffB);
        PG8_WAIT_V(6); PG8_BAR;
    } else {
        PG8_STAGE(PG8_SB(0, 0), cB, voffB); PG8_STAGE(PG8_SA(0, 0), cA, voffA); PG8_STAGE(PG8_SB(0, 1), cB + hstep, voffB); PG8_STAGE(PG8_SA(0, 1), cA + hstep, voffA);
        if (wr == 1) PG8_BAR;
        PG8_WAIT_V(4); PG8_BAR;
        PG8_STAGE(PG8_SB(1, 0), cB + kstep, voffB); PG8_STAGE(PG8_SA(1, 0), cA + kstep, voffA); PG8_STAGE(PG8_SB(1, 1), cB + hstep + kstep, voffB);
        PG8_WAIT_V(6); PG8_BAR;
    }
    for (;;) {
        const bool has_next = S.next(ui + 1, nxt);
        const char* nA = has_next ? (const char*)g.A + (size_t)nxt.pm * tstep : cA; const char* nB = has_next ? (const char*)g.Bt + (size_t)nxt.pn * tstep : cB;
        for (int t = 0; t < nt; t += 2) {
            const bool last = (t == nt - 2);
            const char* a1 = cA + (size_t)(t + 1) * kstep;
            const char* a2 = last ? nA : cA + (size_t)(t + 2) * kstep; const char* b2 = last ? nB : cB + (size_t)(t + 2) * kstep;
            const char* a3 = a2 + kstep; const char* b3 = b2 + kstep;
            if (last && has_next) S.a_ready(nxt);
            if constexpr (SP2) {
            PG8_LDB(B0, 0, 0); PG8_LDB(B1, 0, 1); PG8_SCHED; PG8_LDA(At, 0, 0); PG8_STAGE(PG8_SA(1, 1), a1 + hstep, voffA);
            PG8_WAIT_V(8); PG8_WAIT_L(0); PG8_BAR; PG8_MMA(0, 0, At, B0); PG8_MMA(0, 1, At, B1); PG8_BAR; PG8_SCHED;
            PG8_LDA(At, 0, 1); PG8_STAGE(PG8_SB(0, 0), b2, voffB); PG8_STAGE(PG8_SB(0, 1), b2 + hstep, voffB); PG8_STAGE(PG8_SA(0, 0), a2, voffA);
            PG8_WAIT_V(8); PG8_WAIT_L(0); PG8_BAR; PG8_MMA(1, 0, At, B0); PG8_MMA(1, 1, At, B1); PG8_BAR; PG8_SCHED;
            PG8_LDB(B0, 1, 0); PG8_LDB(B1, 1, 1); PG8_SCHED; PG8_LDA(At, 1, 0); PG8_STAGE(PG8_SA(0, 1), a2 + hstep, voffA);
            PG8_WAIT_V(8); PG8_WAIT_L(0); PG8_BAR; PG8_MMA(0, 0, At, B0); PG8_MMA(0, 1, At, B1); PG8_BAR; PG8_SCHED;
            PG8_LDA(At, 1, 1); PG8_STAGE(PG8_SB(1, 0), b3, voffB); PG8_STAGE(PG8_SB(1, 1), b3 + hstep, voffB); PG8_STAGE(PG8_SA(1, 0), a3, voffA);
            PG8_WAIT_V(8); PG8_WAIT_L(0); PG8_BAR; PG8_MMA(1, 0, At, B0); PG8_MMA(1, 1, At, B1); PG8_BAR; PG8_SCHED;
            } else {
            PG8_LDB(B0, 0, 0); PG8_SCHED; PG8_LDA(At, 0, 0); PG8_STAGE(PG8_SA(1, 1), a1 + hstep, voffA);
            PG8_WAIT_L(8); PG8_BAR; PG8_WAIT_L(0); PG8_MMA(0, 0, At, B0); PG8_BAR; PG8_SCHED;
            PG8_LDB(B1, 0, 1); PG8_STAGE(PG8_SB(0, 0), b2, voffB);
            PG8_BAR; PG8_WAIT_L(0); PG8_MMA(0, 1, At, B1); PG8_BAR;
            PG8_LDA(At, 0, 1); PG8_STAGE(PG8_SA(0, 0), a2, voffA);
            PG8_BAR; PG8_WAIT_L(0); PG8_MMA(1, 0, At, B0); PG8_BAR; PG8_SCHED;
            PG8_STAGE(PG8_SB(0, 1), b2 + hstep, voffB);
            PG8_WAIT_V(6); PG8_BAR; PG8_MMA(1, 1, At, B1); PG8_BAR;
            PG8_LDB(B0, 1, 0); PG8_SCHED; PG8_LDA(At, 1, 0); PG8_STAGE(PG8_SA(0, 1), a2 + hstep, voffA);
            PG8_WAIT_L(8); PG8_BAR; PG8_WAIT_L(0); PG8_MMA(0, 0, At, B0); PG8_BAR; PG8_SCHED;
            PG8_LDB(B1, 1, 1); PG8_STAGE(PG8_SB(1, 0), b3, voffB);
            PG8_BAR; PG8_WAIT_L(0); PG8_MMA(0, 1, At, B1); PG8_BAR;
            PG8_LDA(At, 1, 1); PG8_STAGE(PG8_SA(1, 0), a3, voffA);
            PG8_BAR; PG8_WAIT_L(0); PG8_MMA(1, 0, At, B0); PG8_BAR; PG8_SCHED;
            PG8_STAGE(PG8_SB(1, 1), b3 + hstep, voffB);
            PG8_WAIT_V(6); PG8_BAR; PG8_MMA(1, 1, At, B1); PG8_BAR;
            }
        }
        if constexpr (ALIGN_EPI) { if (wr == 0) PG8_BAR; }
        if constexpr (!Epi::AFTER_DRAIN) { E(acc, cur, wr, wc, fr, fq); S.done(cur); }
        if (!has_next) break;
#pragma unroll
        for (int a = 0; a < 2; ++a)
#pragma unroll
            for (int b = 0; b < 2; ++b)
#pragma unroll
                for (int m = 0; m < 4; ++m)
#pragma unroll
                    for (int n = 0; n < 2; ++n) acc[a][b][m][n] = (f32x4){0.f, 0.f, 0.f, 0.f};
        cur = nxt; cA = nA; cB = nB; ++ui;
        if constexpr (ALIGN_EPI) { if (wr == 1) PG8_BAR; }
    }
    PG8_WAIT_V(0);
    if constexpr (!ALIGN_EPI) { if (wr == 0) PG8_BAR; }
    PG8_BAR;
    if constexpr (Epi::AFTER_DRAIN) { E.fused(acc, cur, wr, wc, fr, fq, lds, wid, lane); S.done(cur); }
#undef PG8_SA
#undef PG8_SB
#undef PG8_STAGE
#undef PG8_LDA
#undef PG8_LDB
#undef PG8_MMA
#undef PG8_WAIT_V
#undef PG8_WAIT_L
#undef PG8_BAR
#undef PG8_SCHED
}
}

#ifndef MK_N_LAUNCHES
#define MK_N_LAUNCHES 1
#endif
constexpr int NB = 8, SEQ = 4096, DM = 1024, DEPTH = 2, NT = NB * SEQ;
constexpr int PW = 3328;
constexpr int C_GQ = 0, C_GK = 256, C_GV = 512, C_GOG = 1024, C_AQ = 1536, C_AK = 2048, C_AV = 2560, C_GLR = 3072;
constexpr int IN_W = 3088, NEXP = 16384;
constexpr float RMS_EPS = 1e-6f;
constexpr int NWAVES = 8, NTHR = 512;
#ifndef USE_XCD_BARRIER
#define USE_XCD_BARRIER 1
#endif
constexpr int CTL_BAR = 8192, CTL_ZERO_BYTES = 65536;
constexpr int LDS_BYTES = 147456;

constexpr size_t MiB = 1u << 20;
constexpr size_t WS_W = 1 * MiB, W_LAYER = 15 * MiB;
constexpr size_t WO_WIN = 0, WO_WOUT = 6656 * 1024, WO_WQ2 = WO_WOUT + 2 * MiB, WO_WG = WO_WQ2 + 4 * MiB, WO_WP = WO_WG + 2 * MiB;
static_assert(WO_WP + 512 * 1024 <= W_LAYER, "weights per layer");
constexpr size_t WS_A = 32 * MiB;
constexpr size_t WS_XN = 288 * MiB;
constexpr size_t WS_C = 352 * MiB;
constexpr size_t WS_D = 416 * MiB;
constexpr size_t WS_PB = 480 * MiB;
constexpr size_t WS_DEC = 496 * MiB;
constexpr size_t WS_ST = 497 * MiB;
constexpr size_t WS_END = 502 * MiB;

#define DI __device__ __forceinline__
typedef unsigned short bf16;
typedef short bf16x8 __attribute__((ext_vector_type(8)));
typedef float f32x4 __attribute__((ext_vector_type(4)));
typedef float f32x16 __attribute__((ext_vector_type(16)));
typedef unsigned u32x4 __attribute__((ext_vector_type(4)));
typedef unsigned u32x2 __attribute__((ext_vector_type(2)));
#define MFMA32(a, b, c) __builtin_amdgcn_mfma_f32_32x32x16_bf16((a), (b), (c), 0, 0, 0)
DI float bf2f(unsigned v) { return __uint_as_float(v << 16); }
DI unsigned f2bf(float f) { unsigned u = __float_as_uint(f); return (u + 0x7fffu + ((u >> 16) & 1u)) >> 16; }
typedef float f32x2 __attribute__((ext_vector_type(2))); typedef __bf16 bf16x2_t __attribute__((ext_vector_type(2)));
DI unsigned pk2(float lo, float hi) { const f32x2 v = {lo, hi}; return __builtin_bit_cast(unsigned, __builtin_convertvector(v, bf16x2_t)); }
DI int crow(int reg, int h) { return (reg & 3) + 8 * (reg >> 2) + 4 * h; }
DI float wave_sum(float v) {
#pragma unroll
    for (int o = 1; o < 64; o <<= 1) v += __shfl_xor(v, o);
    return v;
}
DI bf16x8 pack8(const f32x16& x, int s) {
    u32x4 p; p.x = pk2(x[8 * s + 0], x[8 * s + 1]); p.y = pk2(x[8 * s + 2], x[8 * s + 3]); p.z = pk2(x[8 * s + 4], x[8 * s + 5]); p.w = pk2(x[8 * s + 6], x[8 * s + 7]);
    return __builtin_bit_cast(bf16x8, p);
}

struct Args { const float* in[18]; float* out; unsigned char* ws; int ph_lo, ph_hi; };
struct Frame {
    unsigned char* lds; int tid, lane, wave, G, bid;
    const float *x, *p, *norm_mix, *w_in, *g_w2, *g_b, *head_norm, *rel_bias, *w_out, *norm_ffn, *peer_wq, *peer_sk, *peer_u, *peer_v, *norm_ple, *w_ple_gate, *w_ple, *final_norm;
    float* out; unsigned char* ws;
};

DI void win_map(int n, int& src, float& sc) {
    sc = 1.f;
    if (n < 256) { src = n; sc = 0.125f; }
    else if (n < 1024) src = n;
    else if (n < 1536) src = n + 16;
    else if (n < 2048) { src = n + 16; sc = 0.125f; }
    else if (n < 3072) src = n + 16;
    else if (n < 3088) src = n - 3072 + 1024;
    else src = -1;
}
DI void transpose_item(const float* W, int N, int K, bf16* WT, int n0, int k0, bool winmap, float* tile, int tid) {
    const int nl = tid & 63, kq = tid >> 6;
    int src = n0 + nl; float sc = 1.f;
    if (winmap) win_map(n0 + nl, src, sc);
#pragma unroll
    for (int kk = 0; kk < 8; ++kk) { const int k = kq * 8 + kk; tile[k * 65 + nl] = src >= 0 ? W[(size_t)(k0 + k) * N + src] * sc : 0.f; }
    __syncthreads();
    const int r = tid >> 3, c = tid & 7;
    u32x4 o;
    o.x = pk2(tile[(c * 8 + 0) * 65 + r], tile[(c * 8 + 1) * 65 + r]); o.y = pk2(tile[(c * 8 + 2) * 65 + r], tile[(c * 8 + 3) * 65 + r]);
    o.z = pk2(tile[(c * 8 + 4) * 65 + r], tile[(c * 8 + 5) * 65 + r]); o.w = pk2(tile[(c * 8 + 6) * 65 + r], tile[(c * 8 + 7) * 65 + r]);
    *(u32x4*)(WT + (size_t)(n0 + r) * K + k0 + c * 8) = o;
    __syncthreads();
}
DI void wq2_item(const float* wq, const float* sk, bf16* WT, int hp, int k0, float* lds, int tid) {
    float* s_sk = lds;
    float* s_wq = lds + 128 * 132;
#pragma unroll
    for (int i = 0; i < 8; ++i) { const int idx = tid + i * 512, n = idx >> 5, d4 = idx & 31; *(f32x4*)(s_sk + n * 132 + d4 * 4) = *(const f32x4*)(sk + (size_t)hp * 16384 + n * 128 + d4 * 4); }
#pragma unroll
    for (int i = 0; i < 4; ++i) { const int idx = tid + i * 512, k = idx >> 5, d4 = idx & 31; *(f32x4*)(s_wq + k * 132 + d4 * 4) = *(const f32x4*)(wq + (size_t)(k0 + k) * 2048 + hp * 128 + d4 * 4); }
    __syncthreads();
    const int tn = tid & 31, tk = tid >> 5;
    float acc[4][4];
#pragma unroll
    for (int a = 0; a < 4; ++a)
#pragma unroll
        for (int b = 0; b < 4; ++b) acc[a][b] = 0.f;
    for (int d4 = 0; d4 < 32; ++d4) {
        f32x4 av[4], bv[4];
#pragma unroll
        for (int a = 0; a < 4; ++a) av[a] = *(const f32x4*)(s_sk + (tn * 4 + a) * 132 + d4 * 4);
#pragma unroll
        for (int b = 0; b < 4; ++b) bv[b] = *(const f32x4*)(s_wq + (tk * 4 + b) * 132 + d4 * 4);
#pragma unroll
        for (int a = 0; a < 4; ++a)
#pragma unroll
            for (int b = 0; b < 4; ++b) acc[a][b] += av[a][0] * bv[b][0] + av[a][1] * bv[b][1] + av[a][2] * bv[b][2] + av[a][3] * bv[b][3];
    }
#pragma unroll
    for (int a = 0; a < 4; ++a) { u32x2 o; o.x = pk2(acc[a][0], acc[a][1]); o.y = pk2(acc[a][2], acc[a][3]);
        *(u32x2*)(WT + (size_t)(hp * 128 + tn * 4 + a) * 1024 + k0 + tk * 4) = o; }
    __syncthreads();
}
DI void phase_prep(Frame& F) {
    float* tile = (float*)F.lds;
    constexpr int I_WIN = 832, I_WOUT = 256, I_WG = 256, I_WP = 64, I_WQ2 = 256, I_L = I_WIN + I_WOUT + I_WG + I_WP + I_WQ2;
    for (int it = F.bid; it < DEPTH * I_L; it += F.G) {
        const int l = it / I_L; int r = it % I_L;
        bf16* wl = (bf16*)(F.ws + WS_W + (size_t)l * W_LAYER);
        if (r < I_WIN) { transpose_item(F.w_in + (size_t)l * DM * IN_W, IN_W, DM, wl + WO_WIN / 2, (r >> 4) * 64, (r & 15) * 64, true, tile, F.tid); continue; } r -= I_WIN;
        if (r < I_WOUT) { transpose_item(F.w_out + (size_t)l * DM * DM, DM, DM, wl + WO_WOUT / 2, (r >> 4) * 64, (r & 15) * 64, false, tile, F.tid); continue; } r -= I_WOUT;
        if (r < I_WG) { transpose_item(F.w_ple_gate + (size_t)l * DM * DM, DM, DM, wl + WO_WG / 2, (r >> 4) * 64, (r & 15) * 64, false, tile, F.tid); continue; } r -= I_WG;
        if (r < I_WP) { transpose_item(F.w_ple + (size_t)l * 256 * DM, DM, 256, wl + WO_WP / 2, (r >> 2) * 64, (r & 3) * 64, false, tile, F.tid); continue; } r -= I_WP;
        wq2_item(F.peer_wq + (size_t)l * DM * 2048, F.peer_sk + (size_t)l * 16 * 16384, wl + WO_WQ2 / 2, r >> 4, (r & 15) * 64, tile, F.tid);
    }
}

DI void rms_row_to_bf16(const float* xrow, const float* g, bf16* orow, int lane) {
    const f32x4* xr = (const f32x4*)xrow + lane; const f32x4* gr = (const f32x4*)g + lane;
    f32x4 v[4]; float s = 0.f;
#pragma unroll
    for (int j = 0; j < 4; ++j) { v[j] = xr[64 * j]; s += (v[j].x * v[j].x + v[j].y * v[j].y) + (v[j].z * v[j].z + v[j].w * v[j].w); }
    const float rs = rsqrtf(wave_sum(s) * (1.f / DM) + RMS_EPS);
    u32x2* o8 = (u32x2*)orow + lane;
#pragma unroll
    for (int j = 0; j < 4; ++j) { const f32x4 gg = gr[64 * j]; u32x2 o; o.x = pk2(v[j].x * rs * gg.x, v[j].y * rs * gg.y); o.y = pk2(v[j].z * rs * gg.z, v[j].w * rs * gg.w); o8[64 * j] = o; }
}
DI void phase_init_rows(Frame& F, const float* src, const float* g, bf16* dst, float* ssq) {
    const int lane = F.lane;
    for (int m = F.bid * NWAVES + F.wave; m < NT; m += F.G * NWAVES) {
        const f32x4* xr = (const f32x4*)(src + (size_t)m * DM) + lane; const f32x4* gr = (const f32x4*)g + lane;
        f32x4 v[4]; float s = 0.f;
#pragma unroll
        for (int j = 0; j < 4; ++j) { v[j] = xr[64 * j]; s += (v[j].x * v[j].x + v[j].y * v[j].y) + (v[j].z * v[j].z + v[j].w * v[j].w); }
        s = wave_sum(s);
        u32x2* o8 = (u32x2*)(dst + (size_t)m * DM) + lane;
#pragma unroll
        for (int j = 0; j < 4; ++j) { const f32x4 gg = gr[64 * j]; u32x2 o; o.x = pk2(v[j].x * gg.x, v[j].y * gg.y); o.y = pk2(v[j].z * gg.z, v[j].w * gg.w); o8[64 * j] = o; }
        if (lane < 16) ssq[(size_t)m * 16 + lane] = lane == 0 ? s : 0.f;
    }
}
DI void phase_norm(Frame& F, const float* src, const float* g, bf16* dst) {
    for (int m = F.bid * NWAVES + F.wave; m < NT; m += F.G * NWAVES) rms_row_to_bf16(src + (size_t)m * DM, g, dst + (size_t)m * DM, F.lane);
}
DI void phase_final_norm(Frame& F, const float* g, const float* ssq) {
    for (int m = F.bid * NWAVES + F.wave; m < NT; m += F.G * NWAVES) {
        f32x4* xr = (f32x4*)(F.out + (size_t)m * DM) + F.lane; const f32x4* gr = (const f32x4*)g + F.lane;
        const float rs = pg8::rs_from16(ssq + (size_t)m * 16);
#pragma unroll
        for (int j = 0; j < 4; ++j) { const f32x4 gg = gr[64 * j]; xr[64 * j] = xr[64 * j] * rs * gg; }
    }
}
DI void convert_bf16(Frame& F, const float* src, bf16* dst, size_t n) {
    const size_t n8 = n >> 3;
    for (size_t i = (size_t)F.bid * NTHR + F.tid; i < n8; i += (size_t)F.G * NTHR) {
        const f32x4 a = ((const f32x4*)src)[2 * i], b = ((const f32x4*)src)[2 * i + 1];
        u32x4 o; o.x = pk2(a.x, a.y); o.y = pk2(a.z, a.w); o.z = pk2(b.x, b.y); o.w = pk2(b.z, b.w);
        ((u32x4*)dst)[i] = o;
    }
}

constexpr int AT_BUF = 2048, AT_KP = 144, AT_KB = 128 * AT_KP, AT_STAGE = 2 * AT_KB, AT_OT = AT_BUF, AT_ML = AT_OT + 8 * 64 * 33 * 4;
static_assert(AT_BUF + 2 * AT_STAGE <= LDS_BYTES - 64 && AT_ML + 2048 <= AT_BUF + 2 * AT_STAGE, "attention LDS map");
typedef short v4i16_t __attribute__((ext_vector_type(4)));
DI u32x2 lds_tr16(const unsigned char* p) { return __builtin_bit_cast(u32x2, __builtin_amdgcn_ds_read_tr16_b64_v4i16((__attribute__((address_space(3))) v4i16_t*)p)); }
DI void phase_att(Frame& F, int l, const bf16* proj, bf16* ocat) {
    const int tid = F.tid, lane = F.lane, w = F.wave, r = lane & 31, h2 = lane >> 5, qh = w & 1, kq = w >> 1;
    const int h = F.bid & 7, jb8 = F.bid >> 3, nunits = (NB * 8 * 64) / F.G;
    float* tab = (float*)F.lds;
    float* Ot = (float*)(F.lds + AT_OT);
    float* ML = (float*)(F.lds + AT_ML);
    if (tid < 257) tab[tid] = F.rel_bias[(size_t)l * 8 * 257 + h * 257 + tid];
    const int key_a = tid >> 3, ch = tid & 7;
    const int iq = qh * 32 + r;
    const int g16 = lane >> 4, i16 = lane & 15, tq = i16 >> 2, tp = i16 & 3;
    const int koff = (kq * 32 + r) * AT_KP + h2 * 16;
    const int voff = AT_KB + (kq * 32 + 4 * h2 + tq) * AT_KP + ((g16 & 1) * 16 + 4 * tp) * 2;
    u32x4 kreg[2], vreg[2];
    bf16x8 qf[4], qn[4];
#define AT_LOADG(ROW0, ROWLAST) do { \
        _Pragma("unroll") for (int i = 0; i < 2; ++i) { int row_ = (ROW0) + key_a + 64 * i; row_ = row_ > (ROWLAST) ? (ROWLAST) : row_; const bf16* g_ = proj + (size_t)row_ * PW + h * 64 + ch * 8; \
            kreg[i] = *(const u32x4*)(g_ + C_AK); vreg[i] = *(const u32x4*)(g_ + C_AV); } } while (0)
#define AT_STORE(BUF) do { unsigned char* d_ = F.lds + AT_BUF + (BUF) * AT_STAGE + key_a * AT_KP + ch * 16; \
        _Pragma("unroll") for (int i = 0; i < 2; ++i) { *(u32x4*)(d_ + i * 64 * AT_KP) = kreg[i]; *(u32x4*)(d_ + AT_KB + i * 64 * AT_KP) = vreg[i]; } } while (0)
#define AT_UNIT(K, B_, C_) do { B_ = (K) >> 1; C_ = (32 * ((K) & 1) + jb8 + 8 * B_) & 63; } while (0)
#define AT_LOADQ(DST, M0) do { const bf16* qp_ = proj + (size_t)((M0) + qh * 32 + r) * PW + C_AQ + h * 64 + h2 * 8; _Pragma("unroll") for (int s_ = 0; s_ < 4; ++s_) DST[s_] = *(const bf16x8*)(qp_ + s_ * 16); } while (0)
    int b, c; AT_UNIT(0, b, c);
    { const int m0_ = b * SEQ + c * 64, kt0_ = 18 - 2 * ((c < 8 ? c : 8) + 1); AT_LOADQ(qn, m0_); AT_LOADG(b * SEQ + (c - 8) * 64 + kt0_ * 32, m0_ + 63); }
    for (int k = 0; k < nunits; ++k) {
        const int m0 = b * SEQ + c * 64, kt0 = 18 - 2 * ((c < 8 ? c : 8) + 1), nsteps = (18 - kt0 + 3) >> 2;
        int bn, cn; AT_UNIT(k + 1 < nunits ? k + 1 : k, bn, cn);
        const int m0n = bn * SEQ + cn * 64, kt0n = 18 - 2 * ((cn < 8 ? cn : 8) + 1);
#pragma unroll
        for (int s = 0; s < 4; ++s) qf[s] = qn[s];
        AT_STORE(0);
        __syncthreads();
        f32x16 o0, o1;
#pragma unroll
        for (int i = 0; i < 16; ++i) { o0[i] = 0.f; o1[i] = 0.f; }
        float mrun = -1e30f, lrun = 0.f;
        for (int s = 0; s < nsteps; ++s) {
            const bool lastp = s + 1 >= nsteps;
            {
                const int row0 = lastp ? bn * SEQ + (cn - 8) * 64 + kt0n * 32 : b * SEQ + (c - 8) * 64 + (kt0 + 4 * (s + 1)) * 32, rlast = lastp ? m0n + 63 : m0 + 63;
                AT_LOADG(row0, rlast);
            }
            const int kt = kt0 + 4 * s + kq;
            if (kt < 18) {
                const unsigned char* sb = F.lds + AT_BUF + (s & 1) * AT_STAGE;
                bf16x8 kf[4];
#pragma unroll
                for (int ks = 0; ks < 4; ++ks) kf[ks] = *(const bf16x8*)(sb + koff + ks * 32);
                f32x16 sacc;
#pragma unroll
                for (int i = 0; i < 16; ++i) sacc[i] = 0.f;
#pragma unroll
                for (int ks = 0; ks < 4; ++ks) sacc = MFMA32(kf[ks], qf[ks], sacc);
                float tmax = -1e30f;
                if (kt < 12) {
                    const float bc = tab[256];
#pragma unroll
                    for (int i = 0; i < 16; ++i) { sacc[i] += bc; tmax = fmaxf(tmax, sacc[i]); }
                } else {
                    const int jb = kt * 32 + 4 * h2;
#pragma unroll
                    for (int i = 0; i < 16; ++i) { const int j = jb + (i & 3) + 8 * (i >> 2); int rel = iq + 512 - j; rel = rel < -128 ? -128 : (rel > 128 ? 128 : rel);
                        sacc[i] += tab[rel + 128]; tmax = fmaxf(tmax, sacc[i]); }
                }
                tmax = fmaxf(tmax, __shfl_xor(tmax, 32));
                const float mnew = fmaxf(mrun, tmax), alpha = __expf(mrun - mnew);
                float psum = 0.f;
#pragma unroll
                for (int i = 0; i < 16; ++i) { const float p = __expf(sacc[i] - mnew); sacc[i] = p; psum += p; }
                lrun = lrun * alpha + psum; mrun = mnew;
#pragma unroll
                for (int i = 0; i < 16; ++i) { o0[i] *= alpha; o1[i] *= alpha; }
#pragma unroll
                for (int ks = 0; ks < 2; ++ks) {
                    const bf16x8 pf = pack8(sacc, ks);
#pragma unroll
                    for (int dt = 0; dt < 2; ++dt) {
                        const u32x2 lo = lds_tr16(sb + voff + ks * 16 * AT_KP + dt * 64), hi = lds_tr16(sb + voff + (ks * 16 + 8) * AT_KP + dt * 64);
                        u32x4 va; va.x = lo.x; va.y = lo.y; va.z = hi.x; va.w = hi.y;
                        if (dt == 0) o0 = MFMA32(__builtin_bit_cast(bf16x8, va), pf, o0); else o1 = MFMA32(__builtin_bit_cast(bf16x8, va), pf, o1);
                    }
                }
            }
            if (!lastp) AT_STORE((s + 1) & 1);
            __syncthreads();
        }
        AT_LOADQ(qn, m0n);
        lrun += __shfl_xor(lrun, 32);
#pragma unroll
        for (int i = 0; i < 16; ++i) { const int d = crow(i, h2); Ot[(w * 64 + d) * 33 + r] = o0[i]; Ot[(w * 64 + 32 + d) * 33 + r] = o1[i]; }
        if (h2 == 0) { ML[w * 64 + r] = mrun; ML[w * 64 + 32 + r] = lrun; }
        __syncthreads();
        {
            const int q = tid >> 3, dg = tid & 7, qq = q & 31, qhh = q >> 5;
            float mg[4], lg[4], ms = -1e30f;
#pragma unroll
            for (int g = 0; g < 4; ++g) { const int ww = g * 2 + qhh; mg[g] = ML[ww * 64 + qq]; lg[g] = ML[ww * 64 + 32 + qq]; ms = fmaxf(ms, mg[g]); }
            float L = 0.f, wg[4];
#pragma unroll
            for (int g = 0; g < 4; ++g) { wg[g] = __expf(mg[g] - ms); L += wg[g] * lg[g]; }
            const float inv = 1.f / L;
            float ov[8];
#pragma unroll
            for (int dd = 0; dd < 8; ++dd) { float a = 0.f;
#pragma unroll
                for (int g = 0; g < 4; ++g) a += wg[g] * Ot[((g * 2 + qhh) * 64 + dg * 8 + dd) * 33 + qq];
                ov[dd] = a * inv; }
            u32x4 o; o.x = pk2(ov[0], ov[1]); o.y = pk2(ov[2], ov[3]); o.z = pk2(ov[4], ov[5]); o.w = pk2(ov[6], ov[7]);
            *(u32x4*)(ocat + (size_t)(m0 + q) * DM + 512 + h * 64 + dg * 8) = o;
        }
        __syncthreads();
        b = bn; c = cn;
    }
#undef AT_LOADG
#undef AT_STORE
#undef AT_UNIT
#undef AT_LOADQ
}

constexpr int GL_GLR = 0, GL_W2 = 4096, GL_B2 = 8192, GL_CUM = 8448, GL_TOT = GL_CUM + 16384, GL_VR = GL_TOT + 2048, GL_VP = 272, GL_KS = GL_VR + 64 * GL_VP, GL_QE = GL_KS + 64 * 144, GL_KE = GL_QE + 64 * 144,
              GL_QG = GL_KE + 64 * 144, GL_OS = GL_QG + 64 * 144, GL_END = GL_OS + 64 * 132 * 4;
static_assert(GL_END <= LDS_BYTES - 64 && GL_VR % 16 == 0 && GL_KS % 16 == 0 && GL_QE % 16 == 0 && GL_OS % 16 == 0, "GLA LDS map");
DI float log_sigmoid(float x) { return fminf(x, 0.f) - log1pf(__expf(-fabsf(x))); }
struct GlaRegs { u32x4 glr, q, k, v0, v1, g0, g1, p[4]; };
DI void gla_load(Frame& F, int h, int m0, int unit, const bf16* proj, const bf16* prevb, bool want_k, bool want_q, GlaRegs& R) {
    const int tid = F.tid, t = tid >> 3, j = tid & 7;
    const bf16* row = proj + (size_t)(m0 + t) * PW;
    { const int tg = tid < 128 ? tid : 127; R.glr = *(const u32x4*)(proj + (size_t)(m0 + (tg >> 1)) * PW + C_GLR + (tg & 1) * 8); }
    if (want_k) R.k = *(const u32x4*)(row + C_GK + h * 64 + j * 8);
    R.v0 = *(const u32x4*)(row + C_GV + h * 128 + j * 16); R.v1 = *(const u32x4*)(row + C_GV + h * 128 + j * 16 + 8);
    if (want_q) {
        R.q = *(const u32x4*)(row + C_GQ + h * 64 + j * 8);
        R.g0 = *(const u32x4*)(row + C_GOG + h * 128 + j * 16); R.g1 = *(const u32x4*)(row + C_GOG + h * 128 + j * 16 + 8);
        const int r = F.lane & 31, h2 = F.lane >> 5, et = F.wave >> 1;
        const bf16* pp = prevb + (size_t)unit * 8192 + (et * 32 + r) * 64 + 8 * h2;
#pragma unroll
        for (int s = 0; s < 4; ++s) R.p[s] = *(const u32x4*)(pp + 16 * s);
    }
}
DI void gla_cum(Frame& F, const GlaRegs& R) {
    const int tid = F.tid;
    float* Gl = (float*)(F.lds + GL_GLR); float* W2 = (float*)(F.lds + GL_W2); float* B2 = (float*)(F.lds + GL_B2); float* CUM = (float*)(F.lds + GL_CUM); float* TOT = (float*)(F.lds + GL_TOT);
    if (tid < 128) { const int t = tid >> 1, hf = tid & 1; const u32x4 v = R.glr;
        float* g = Gl + t * 16 + hf * 8; g[0] = bf2f(v.x & 0xffffu); g[1] = bf2f(v.x >> 16); g[2] = bf2f(v.y & 0xffffu); g[3] = bf2f(v.y >> 16); g[4] = bf2f(v.z & 0xffffu); g[5] = bf2f(v.z >> 16); g[6] = bf2f(v.w & 0xffffu); g[7] = bf2f(v.w >> 16); }
    { unsigned char* vr = F.lds + GL_VR + (tid >> 3) * GL_VP + (tid & 7) * 32; *(u32x4*)vr = R.v0; *(u32x4*)(vr + 16) = R.v1; }
    __syncthreads();
    const int d = tid & 63, tq = tid >> 6;
    float w2r[16];
#pragma unroll
    for (int rr = 0; rr < 16; ++rr) w2r[rr] = W2[rr * 64 + d];
    const float bb = B2[d];
    float run = 0.f;
#pragma unroll
    for (int tt = 0; tt < 8; ++tt) { const int t = tq * 8 + tt; float x = bb;
#pragma unroll
        for (int rr = 0; rr < 16; ++rr) x += Gl[t * 16 + rr] * w2r[rr];
        run += log_sigmoid(x) * (1.f / 16.f); CUM[t * 64 + d] = run; }
    TOT[tq * 64 + d] = run;
    __syncthreads();
    float off = 0.f;
    for (int q = 0; q < tq; ++q) off += TOT[q * 64 + d];
#pragma unroll
    for (int tt = 0; tt < 8; ++tt) CUM[(tq * 8 + tt) * 64 + d] += off;
    __syncthreads();
}
DI void gla_phase_consts(Frame& F, int l, int h) {
    const int tid = F.tid; float* W2 = (float*)(F.lds + GL_W2); float* B2 = (float*)(F.lds + GL_B2);
#pragma unroll
    for (int i = 0; i < 2; ++i) { const int idx = tid + i * 512, rr = idx >> 6, d = idx & 63; W2[idx] = F.g_w2[(size_t)l * 16 * 256 + rr * 256 + h * 64 + d]; }
    if (tid < 64) B2[tid] = F.g_b[(size_t)l * 256 + h * 64 + tid];
}
DI void unpack8(const u32x4& v, float (&f)[8]) { f[0] = bf2f(v.x & 0xffffu); f[1] = __uint_as_float(v.x & 0xffff0000u); f[2] = bf2f(v.y & 0xffffu); f[3] = __uint_as_float(v.y & 0xffff0000u);
    f[4] = bf2f(v.z & 0xffffu); f[5] = __uint_as_float(v.z & 0xffff0000u); f[6] = bf2f(v.w & 0xffffu); f[7] = __uint_as_float(v.w & 0xffff0000u); }
DI void phase_gla_kv(Frame& F, int l, const bf16* proj, float* KVt, float* dec) {
    const int tid = F.tid, lane = F.lane, w = F.wave, r = lane & 31, h2 = lane >> 5;
    const int c = F.bid & 63, h = (F.bid >> 6) & 3, nunits = (NB * 4 * 64) / F.G;
    float* CUM = (float*)(F.lds + GL_CUM);
    gla_phase_consts(F, l, h);
    GlaRegs R, Rn;
    gla_load(F, h, 0 * SEQ + c * 64, 0, proj, nullptr, true, false, Rn);
    const int g16 = lane >> 4, i16 = lane & 15, tq4 = i16 >> 2, tp = i16 & 3, et = w >> 1, dt = w & 1;
    for (int k = 0; k < nunits; ++k) {
        const int b = k, m0 = b * SEQ + c * 64, unit = (b * 4 + h) * 64 + c, bn = k + 1 < nunits ? k + 1 : k;
        R = Rn;
        gla_load(F, h, bn * SEQ + c * 64, 0, proj, nullptr, true, false, Rn);
        gla_cum(F, R);
        {
            const int t = tid >> 3, j = tid & 7; float kf[8]; unpack8(R.k, kf);
            float o[8];
#pragma unroll
            for (int i = 0; i < 8; ++i) { const int d = j * 8 + i; o[i] = kf[i] * __expf(CUM[63 * 64 + d] - CUM[t * 64 + d]); }
            u32x4 pk; pk.x = pk2(o[0], o[1]); pk.y = pk2(o[2], o[3]); pk.z = pk2(o[4], o[5]); pk.w = pk2(o[6], o[7]);
            *(u32x4*)(F.lds + GL_KS + t * 144 + j * 16) = pk;
            if (tid < 64) dec[(size_t)unit * 64 + tid] = __expf(CUM[63 * 64 + tid]);
        }
        __syncthreads();
        {
            f32x16 acc;
#pragma unroll
            for (int i = 0; i < 16; ++i) acc[i] = 0.f;
            const unsigned char* va = F.lds + GL_VR + (8 * h2 + tq4) * GL_VP + (et * 32 + (g16 & 1) * 16 + 4 * tp) * 2;
            const unsigned char* kb = F.lds + GL_KS + (8 * h2 + tq4) * 144 + (dt * 32 + (g16 & 1) * 16 + 4 * tp) * 2;
#pragma unroll
            for (int s = 0; s < 4; ++s) {
                const u32x2 a0 = lds_tr16(va + 16 * s * GL_VP), a1 = lds_tr16(va + (16 * s + 4) * GL_VP), b0 = lds_tr16(kb + 16 * s * 144), b1 = lds_tr16(kb + (16 * s + 4) * 144);
                u32x4 av, bv; av.x = a0.x; av.y = a0.y; av.z = a1.x; av.w = a1.y; bv.x = b0.x; bv.y = b0.y; bv.z = b1.x; bv.w = b1.y;
                acc = MFMA32(__builtin_bit_cast(bf16x8, av), __builtin_bit_cast(bf16x8, bv), acc);
            }
            float* o = KVt + (size_t)unit * 8192;
#pragma unroll
            for (int i = 0; i < 16; ++i) o[(et * 32 + crow(i, h2)) * 64 + dt * 32 + r] = acc[i];
        }
        __syncthreads();
    }
}
DI void phase_scan(Frame& F, const float* __restrict__ KVt, const float* __restrict__ dec, bf16* __restrict__ prevb) {
    for (int idx = F.bid * NTHR + F.tid; idx < 32 * 8192; idx += F.G * NTHR) {
        const int bh = idx >> 13, ed = idx & 8191, d = ed & 63;
        const float* p = KVt + (size_t)bh * 64 * 8192 + ed; const float* dc = dec + (size_t)bh * 64 * 64 + d; bf16* o = prevb + (size_t)bh * 64 * 8192 + ed;
        float S = 0.f;
        for (int n0 = 0; n0 < 64; n0 += 16) {
            float kv[16], dy[16];
#pragma unroll
            for (int i = 0; i < 16; ++i) { kv[i] = p[(size_t)(n0 + i) * 8192]; dy[i] = dc[(n0 + i) * 64]; }
#pragma unroll
            for (int i = 0; i < 16; ++i) { o[(size_t)(n0 + i) * 8192] = (bf16)f2bf(S); S = dy[i] * S + kv[i]; }
        }
    }
}
DI void phase_gla_out(Frame& F, int l, const bf16* proj, const bf16* prevb, bf16* ocat) {
    const int tid = F.tid, lane = F.lane, w = F.wave, r = lane & 31, h2 = lane >> 5;
    const int c = F.bid & 63, h = (F.bid >> 6) & 3, nunits = (NB * 4 * 64) / F.G;
    float* CUM = (float*)(F.lds + GL_CUM); float* Os = (float*)(F.lds + GL_OS);
    bf16* Qe = (bf16*)(F.lds + GL_QE); bf16* Ke = (bf16*)(F.lds + GL_KE); bf16* Qg = (bf16*)(F.lds + GL_QG);
    gla_phase_consts(F, l, h);
    GlaRegs R, Rn;
    gla_load(F, h, c * 64, (0 * 4 + h) * 64 + c, proj, prevb, true, true, Rn);
    const int g16 = lane >> 4, i16 = lane & 15, tq4 = i16 >> 2, tp = i16 & 3, et = w >> 1, it = w & 1;
    float hn[16];
    { const float* hp = F.head_norm + (size_t)l * 128 + (tid & 7) * 16;
#pragma unroll
      for (int i = 0; i < 16; ++i) hn[i] = hp[i]; }
    for (int k = 0; k < nunits; ++k) {
        const int b = k, m0 = b * SEQ + c * 64, bn = k + 1 < nunits ? k + 1 : k;
        R = Rn;
        gla_load(F, h, bn * SEQ + c * 64, (bn * 4 + h) * 64 + c, proj, prevb, true, true, Rn);
        gla_cum(F, R);
        {
            const int t = tid >> 3, j = tid & 7; float qf[8], kf[8]; unpack8(R.q, qf); unpack8(R.k, kf);
            float a[8], bq[8], cg[8];
#pragma unroll
            for (int i = 0; i < 8; ++i) { const int d = j * 8 + i; const float cm = CUM[t * 64 + d], mid = CUM[32 * 64 + d];
                a[i] = qf[i] * __expf(cm - mid); bq[i] = kf[i] * __expf(mid - cm); cg[i] = qf[i] * __expf(cm); }
            u32x4 pa, pb, pc; pa.x = pk2(a[0], a[1]); pa.y = pk2(a[2], a[3]); pa.z = pk2(a[4], a[5]); pa.w = pk2(a[6], a[7]);
            pb.x = pk2(bq[0], bq[1]); pb.y = pk2(bq[2], bq[3]); pb.z = pk2(bq[4], bq[5]); pb.w = pk2(bq[6], bq[7]);
            pc.x = pk2(cg[0], cg[1]); pc.y = pk2(cg[2], cg[3]); pc.z = pk2(cg[4], cg[5]); pc.w = pk2(cg[6], cg[7]);
            *(u32x4*)(Qe + t * 72 + j * 8) = pa; *(u32x4*)(Ke + t * 72 + j * 8) = pb; *(u32x4*)(Qg + t * 72 + j * 8) = pc;
        }
        __syncthreads();
        {
            f32x16 o;
#pragma unroll
            for (int i = 0; i < 16; ++i) o[i] = 0.f;
#pragma unroll
            for (int s = 0; s < 4; ++s) { const bf16x8 bq = *(const bf16x8*)(Qg + (it * 32 + r) * 72 + 16 * s + 8 * h2); o = MFMA32(__builtin_bit_cast(bf16x8, R.p[s]), bq, o); }
            for (int jt = 0; jt <= it; ++jt) {
                f32x16 X;
#pragma unroll
                for (int i = 0; i < 16; ++i) X[i] = 0.f;
#pragma unroll
                for (int s = 0; s < 4; ++s) { const bf16x8 a = *(const bf16x8*)(Ke + (jt * 32 + r) * 72 + 16 * s + 8 * h2); const bf16x8 bb = *(const bf16x8*)(Qe + (it * 32 + r) * 72 + 16 * s + 8 * h2); X = MFMA32(a, bb, X); }
                if (jt == it) {
#pragma unroll
                    for (int i = 0; i < 16; ++i) if (crow(i, h2) > r) X[i] = 0.f;
                }
                const unsigned char* va = F.lds + GL_VR + (jt * 32 + 4 * h2 + tq4) * GL_VP + (et * 32 + (g16 & 1) * 16 + 4 * tp) * 2;
#pragma unroll
                for (int s = 0; s < 2; ++s) { const bf16x8 pf = pack8(X, s);
                    const u32x2 lo = lds_tr16(va + 16 * s * GL_VP), hi = lds_tr16(va + (16 * s + 8) * GL_VP);
                    u32x4 vv; vv.x = lo.x; vv.y = lo.y; vv.z = hi.x; vv.w = hi.y;
                    o = MFMA32(__builtin_bit_cast(bf16x8, vv), pf, o); }
            }
#pragma unroll
            for (int i = 0; i < 16; ++i) Os[(it * 32 + r) * 132 + et * 32 + crow(i, h2)] = o[i];
        }
        __syncthreads();
        {
            const int i = tid >> 3, ec = tid & 7, e0 = ec * 16;
            float v[16]; float ss = 0.f;
#pragma unroll
            for (int q = 0; q < 4; ++q) { const f32x4 x = *(const f32x4*)(Os + i * 132 + e0 + 4 * q); v[4 * q] = x.x; v[4 * q + 1] = x.y; v[4 * q + 2] = x.z; v[4 * q + 3] = x.w; ss += (x.x * x.x + x.y * x.y) + (x.z * x.z + x.w * x.w); }
            ss += __shfl_xor(ss, 1); ss += __shfl_xor(ss, 2); ss += __shfl_xor(ss, 4);
            const float rs = rsqrtf(ss * (1.f / 128.f) + RMS_EPS);
            float ga[8], gb[8]; unpack8(R.g0, ga); unpack8(R.g1, gb);
            unsigned ow[8];
#pragma unroll
            for (int q = 0; q < 4; ++q) { const float g0 = ga[2 * q], g1 = ga[2 * q + 1]; ow[q] = pk2(v[2 * q] * rs * hn[2 * q] * (g0 / (1.f + __expf(-g0))), v[2 * q + 1] * rs * hn[2 * q + 1] * (g1 / (1.f + __expf(-g1)))); }
#pragma unroll
            for (int q = 0; q < 4; ++q) { const float g0 = gb[2 * q], g1 = gb[2 * q + 1]; ow[4 + q] = pk2(v[8 + 2 * q] * rs * hn[8 + 2 * q] * (g0 / (1.f + __expf(-g0))), v[8 + 2 * q + 1] * rs * hn[8 + 2 * q + 1] * (g1 / (1.f + __expf(-g1)))); }
            u32x4 o0, o1; o0.x = ow[0]; o0.y = ow[1]; o0.z = ow[2]; o0.w = ow[3]; o1.x = ow[4]; o1.y = ow[5]; o1.z = ow[6]; o1.w = ow[7];
            *(u32x4*)(ocat + (size_t)(m0 + i) * DM + h * 128 + e0) = o0; *(u32x4*)(ocat + (size_t)(m0 + i) * DM + h * 128 + e0 + 8) = o1;
        }
        __syncthreads();
    }
}

DI unsigned ord_f32(float v) { const unsigned b = __float_as_uint(v); return (b & 0x80000000u) ? ~b : (b | 0x80000000u); }
#define CE_DESC(a, b) do { const unsigned hi_ = (a) > (b) ? (a) : (b), lo_ = (a) > (b) ? (b) : (a); (a) = hi_; (b) = lo_; } while (0)
DI void bitonic_merge16_desc(unsigned (&v)[16]) {
#pragma unroll
    for (int j = 8; j > 0; j >>= 1)
#pragma unroll
        for (int i = 0; i < 16; ++i) { const int l = i ^ j; if (l > i) CE_DESC(v[i], v[l]); }
}
DI void sort16_desc(unsigned (&v)[16]) {
#pragma unroll
    for (int k = 2; k <= 16; k <<= 1)
#pragma unroll
        for (int j = k >> 1; j > 0; j >>= 1)
#pragma unroll
            for (int i = 0; i < 16; ++i) { const int l = i ^ j; if (l > i) { if ((i & k) == 0 || k == 16) CE_DESC(v[i], v[l]); else CE_DESC(v[l], v[i]); } }
}
DI void merge_top16(unsigned (&a)[16], const unsigned (&b)[16]) {
#pragma unroll
    for (int i = 0; i < 16; ++i) a[i] = a[i] > b[15 - i] ? a[i] : b[15 - i];
    bitonic_merge16_desc(a);
}
struct CandTab { int ci[64], cj[64], n; };
constexpr CandTab make_cand_tab() { CandTab c{}; c.n = 0; for (int i = 0; i < 16; ++i) for (int j = 0; j < 16; ++j) if ((i + 1) * (j + 1) <= 16) { c.ci[c.n] = i; c.cj[c.n] = j; ++c.n; } return c; }
constexpr int TK_PITCH = 132;
DI void topk_load(const float* sc, int tile, int tid, f32x4 (&buf)[16]) {
    const float* src = sc + (size_t)tile * 32768;
#pragma unroll
    for (int i = 0; i < 16; ++i) buf[i] = *(const f32x4*)(src + (size_t)(tid + i * 512) * 4);
}
DI void topk_store_lds(float* S, int tid, const f32x4 (&buf)[16]) {
#pragma unroll
    for (int i = 0; i < 16; ++i) { const int idx = tid + i * 512, R = idx >> 5, c4 = idx & 31; *(f32x4*)(S + R * TK_PITCH + c4 * 4) = buf[i]; }
}
DI void topk_tile(Frame& F, int tile, int next_tile, const float* sc, int* eout, float* gout, f32x4 (&buf)[16]) {
    int tid = F.tid; asm volatile("" : "+v"(tid));
    float* S = (float*)F.lds;
    topk_store_lds(S, tid, buf);
    __syncthreads();
    if (next_tile >= 0) topk_load(sc, next_tile, tid, buf);
    const int R = tid >> 1, jh = tid & 1;
    const float* row = S + R * TK_PITCH + jh * 64;
    unsigned top[16];
#pragma unroll
    for (int gq = 0; gq < 4; ++gq) {
        unsigned v[16];
#pragma unroll
        for (int q = 0; q < 4; ++q) { const f32x4 x = *(const f32x4*)(row + gq * 16 + q * 4); const int n0 = jh * 64 + gq * 16 + q * 4;
            v[4 * q + 0] = (ord_f32(x.x) & ~127u) | (unsigned)(127 - n0); v[4 * q + 1] = (ord_f32(x.y) & ~127u) | (unsigned)(126 - n0);
            v[4 * q + 2] = (ord_f32(x.z) & ~127u) | (unsigned)(125 - n0); v[4 * q + 3] = (ord_f32(x.w) & ~127u) | (unsigned)(124 - n0); }
        sort16_desc(v);
        if (gq == 0) {
#pragma unroll
            for (int k = 0; k < 16; ++k) top[k] = v[k];
        } else merge_top16(top, v);
        __builtin_amdgcn_sched_barrier(0);
    }
    {
        unsigned oth[16];
#pragma unroll
        for (int k = 0; k < 16; ++k) oth[k] = (unsigned)__shfl_xor((int)top[k], 1);
        merge_top16(top, oth);
    }
    __builtin_amdgcn_sched_barrier(0);
    float tv[8]; int ti[8];
#pragma unroll
    for (int k = 0; k < 8; ++k) { const unsigned msk = 0u - (unsigned)jh, key = (top[8 + k] & msk) | (top[k] & ~msk); ti[k] = 127 - (int)(key & 127u); tv[k] = S[R * TK_PITCH + ti[k]]; }
    __syncthreads();
    float* LV = (float*)F.lds; int* LI = (int*)(F.lds + 16384);
#pragma unroll
    for (int k = 0; k < 8; ++k) { LV[R * 16 + jh * 8 + k] = tv[k]; LI[R * 16 + jh * 8 + k] = ti[k]; }
    __syncthreads();
    __builtin_amdgcn_sched_barrier(0);
    if (tid < 128) {
        const int R1 = 2 * tid, R2 = 2 * tid + 1;
        float s1[16], s2[16];
#pragma unroll
        for (int k = 0; k < 16; ++k) { s1[k] = LV[R1 * 16 + k]; s2[k] = LV[R2 * 16 + k]; }
        unsigned tk[16];
#pragma unroll
        for (int grp = 0; grp < 4; ++grp) {
            unsigned v[16];
#pragma unroll
            for (int k = 0; k < 16; ++k) { constexpr CandTab CT = make_cand_tab(); const int idx = grp * 16 + k;
                v[k] = idx < CT.n ? ((ord_f32(s1[CT.ci[idx < CT.n ? idx : 0]] + s2[CT.cj[idx < CT.n ? idx : 0]]) & ~255u) | (unsigned)(255 - (CT.ci[idx < CT.n ? idx : 0] * 16 + CT.cj[idx < CT.n ? idx : 0]))) : 0u; }
            sort16_desc(v);
            if (grp == 0) {
#pragma unroll
                for (int k = 0; k < 16; ++k) tk[k] = v[k];
            } else merge_top16(tk, v);
        }
        float topv[16]; int ee[16]; float mx = -1e30f;
#pragma unroll
        for (int k = 0; k < 16; ++k) { const int cid = 255 - (int)(tk[k] & 255u), i = cid >> 4, j = cid & 15;
            topv[k] = LV[R1 * 16 + i] + LV[R2 * 16 + j]; ee[k] = LI[R1 * 16 + i] * 128 + LI[R2 * 16 + j]; mx = fmaxf(mx, topv[k]); }
        float sum = 0.f;
#pragma unroll
        for (int k = 0; k < 16; ++k) { topv[k] = __expf(topv[k] - mx); sum += topv[k]; }
        const float inv = 1.f / sum;
        const int t = tile * 16 + (tid >> 3), hh = tid & 7;
        int* eo = eout + (size_t)t * 128 + hh * 16; float* go = gout + (size_t)t * 128 + hh * 16;
#pragma unroll
        for (int k = 0; k < 16; ++k) { eo[k] = ee[k]; go[k] = topv[k] * inv; }
    }
    __syncthreads();
}
DI void phase_topk(Frame& F, const float* sc, int* eout, float* gout) {
    f32x4 buf[16];
    int tile = F.bid;
    if (tile < NT / 16) topk_load(sc, tile, F.tid, buf);
    for (; tile < NT / 16; tile += F.G) { const int nxt = tile + F.G < NT / 16 ? tile + F.G : -1; topk_tile(F, tile, nxt, sc, eout, gout, buf); }
}

DI unsigned pack4_fp8(float a, float b, float c, float d) { int w = 0; w = __builtin_amdgcn_cvt_pk_fp8_f32(a, b, w, false); w = __builtin_amdgcn_cvt_pk_fp8_f32(c, d, w, true); return (unsigned)w; }
DI float wave_max(float v) {
#pragma unroll
    for (int o = 1; o < 64; o <<= 1) v = fmaxf(v, __shfl_xor(v, o));
    return v;
}
DI void convert_rows_fp8(Frame& F, const float* src, unsigned char* dst, float* rscale, bool vslice) {
    const int lane = F.lane;
    for (int e = F.bid * NWAVES + F.wave; e < NEXP; e += F.G * NWAVES) {
        const f32x4* r = (const f32x4*)(src + (size_t)e * DM) + lane * 4;
        f32x4 v[4]; float mx = 0.f;
#pragma unroll
        for (int j = 0; j < 4; ++j) { v[j] = r[j]; mx = fmaxf(mx, fmaxf(fmaxf(fabsf(v[j].x), fabsf(v[j].y)), fmaxf(fabsf(v[j].z), fabsf(v[j].w)))); }
        mx = wave_max(mx);
        const float s = mx > 0.f ? 240.f / mx : 1.f, inv = mx > 0.f ? mx * (1.f / 240.f) : 1.f;
        u32x4 o; o.x = pack4_fp8(v[0].x * s, v[0].y * s, v[0].z * s, v[0].w * s); o.y = pack4_fp8(v[1].x * s, v[1].y * s, v[1].z * s, v[1].w * s);
        o.z = pack4_fp8(v[2].x * s, v[2].y * s, v[2].z * s, v[2].w * s); o.w = pack4_fp8(v[3].x * s, v[3].y * s, v[3].z * s, v[3].w * s);
        if (!vslice) *(u32x4*)(dst + (size_t)e * DM + lane * 16) = o;
        else *(u32x4*)(dst + ((size_t)(lane >> 3) * NEXP + e) * 128 + (lane & 7) * 16) = o;
        if (lane == 0) rscale[e] = inv;
    }
}
DI unsigned xcc_id() { return (unsigned)__builtin_amdgcn_s_getreg((3 << 11) | 20) & 7u; }
DI unsigned wave_dequeue(unsigned* ctr, int lane) { unsigned v = 0; if (lane == 0) v = __hip_atomic_fetch_add(ctr, 1u, __ATOMIC_RELAXED, __HIP_MEMORY_SCOPE_AGENT); return (unsigned)__builtin_amdgcn_readfirstlane((int)v); }
constexpr int PEER_ITEM_TOK = 32, PEER_ITEMS = NT / PEER_ITEM_TOK;
struct PeerMetaU { int ea, eb; u32x4 xa, xb; };
struct PeerMetaV { int ea, eb; float ha, hb; f32x2 hv; };
DI PeerMetaU peer_meta_u(int lane, int t, int sl, const bf16* xn, const int* E) {
    PeerMetaU m; m.ea = E[(size_t)t * 128 + lane]; m.eb = E[(size_t)t * 128 + 64 + lane];
    const bf16* xp = xn + (size_t)t * DM + sl * 128 + (lane & 7) * 16; m.xa = *(const u32x4*)xp; m.xb = *(const u32x4*)(xp + 8); return m;
}
DI PeerMetaV peer_meta_v(int lane, int t, int sl, const int* E, const float* hid, const float* h) {
    PeerMetaV m; m.ea = E[(size_t)t * 128 + lane]; m.eb = E[(size_t)t * 128 + 64 + lane]; m.ha = hid[(size_t)t * 128 + lane]; m.hb = hid[(size_t)t * 128 + 64 + lane];
    m.hv = *(const f32x2*)(h + (size_t)t * DM + sl * 128 + (lane & 7) * 16 + (lane >> 3) * 2); return m;
}
struct PeerRows { u32x4 w[16]; };
DI void peer_load_rows(int lane, int sl, int ea, int eb, const unsigned char* T8s, PeerRows& R) {
    const int g = lane >> 3, sub = lane & 7;
    const unsigned tb = (unsigned)sl * (NEXP * 128u) + (unsigned)sub * 16u;
#pragma unroll
    for (int I = 0; I < 16; ++I) { const unsigned ek = (unsigned)__shfl(I < 8 ? ea : eb, (I & 7) * 8 + g); R.w[I] = *(const u32x4*)(T8s + (size_t)(tb + ek * 128u)); }
}
DI void peer_u_visit(int lane, int t, int sl, const PeerMetaU& m, const PeerRows& R, float* part) {
    const int g = lane >> 3;
    f32x2 xp[8];
    { const unsigned wv[8] = {m.xa.x, m.xa.y, m.xa.z, m.xa.w, m.xb.x, m.xb.y, m.xb.z, m.xb.w};
#pragma unroll
      for (int k = 0; k < 8; ++k) { xp[k].x = bf2f(wv[k] & 0xffffu); xp[k].y = __uint_as_float(wv[k] & 0xffff0000u); } }
    float s[16];
#pragma unroll
    for (int I = 0; I < 16; ++I) {
        const unsigned wv[4] = {R.w[I].x, R.w[I].y, R.w[I].z, R.w[I].w};
        f32x2 s2 = {0.f, 0.f};
#pragma unroll
        for (int k = 0; k < 4; ++k) { s2 = __builtin_amdgcn_cvt_pk_f32_fp8((int)wv[k], false) * xp[2 * k] + s2; s2 = __builtin_amdgcn_cvt_pk_f32_fp8((int)wv[k], true) * xp[2 * k + 1] + s2; }
        s[I] = s2.x + s2.y;
    }
    const bool b2 = (lane & 4) != 0, b1 = (lane & 2) != 0, b0 = (lane & 1) != 0;
    float p[8], q[4], r[2];
#pragma unroll
    for (int j = 0; j < 8; ++j) { const float keep = b2 ? s[8 + j] : s[j], send = b2 ? s[j] : s[8 + j]; p[j] = keep + __shfl_xor(send, 4); }
#pragma unroll
    for (int j = 0; j < 4; ++j) { const float keep = b1 ? p[4 + j] : p[j], send = b1 ? p[j] : p[4 + j]; q[j] = keep + __shfl_xor(send, 2); }
#pragma unroll
    for (int j = 0; j < 2; ++j) { const float keep = b0 ? q[2 + j] : q[j], send = b0 ? q[j] : q[2 + j]; r[j] = keep + __shfl_xor(send, 1); }
    const int I0 = (b2 ? 8 : 0) + (b1 ? 4 : 0) + (b0 ? 2 : 0);
    float* pp = part + ((size_t)sl * NT + t) * 128;
#pragma unroll
    for (int j = 0; j < 2; ++j) { const int I = I0 + j; pp[64 * (I >> 3) + 8 * (I & 7) + g] = r[j]; }
}
DI void peer_v_visit(int lane, int t, int sl, const PeerMetaV& m, const PeerRows& R, float* h, f32x2 g2, bf16* xo, float* ssq) {
    const int g = lane >> 3, sub = lane & 7;
    float hk[16];
#pragma unroll
    for (int I = 0; I < 16; ++I) hk[I] = __shfl(I < 8 ? m.ha : m.hb, (I & 7) * 8 + g);
    f32x2 o[8];
#pragma unroll
    for (int k = 0; k < 8; ++k) o[k] = (f32x2){0.f, 0.f};
#pragma unroll
    for (int I = 0; I < 16; ++I) {
        const unsigned wv[4] = {R.w[I].x, R.w[I].y, R.w[I].z, R.w[I].w}; const f32x2 h2 = {hk[I], hk[I]};
#pragma unroll
        for (int k = 0; k < 4; ++k) { o[2 * k] = __builtin_amdgcn_cvt_pk_f32_fp8((int)wv[k], false) * h2 + o[2 * k]; o[2 * k + 1] = __builtin_amdgcn_cvt_pk_f32_fp8((int)wv[k], true) * h2 + o[2 * k + 1]; }
    }
    const bool b5 = (lane & 32) != 0, b4 = (lane & 16) != 0, b3 = (lane & 8) != 0;
    f32x2 p[4];
#pragma unroll
    for (int k = 0; k < 4; ++k) { const f32x2 keep = b5 ? o[4 + k] : o[k], send = b5 ? o[k] : o[4 + k]; f32x2 rc; rc.x = __shfl_xor(send.x, 32); rc.y = __shfl_xor(send.y, 32); p[k] = keep + rc; }
    f32x2 q[2];
#pragma unroll
    for (int k = 0; k < 2; ++k) { const f32x2 keep = b4 ? p[2 + k] : p[k], send = b4 ? p[k] : p[2 + k]; f32x2 rc; rc.x = __shfl_xor(send.x, 16); rc.y = __shfl_xor(send.y, 16); q[k] = keep + rc; }
    f32x2 r1;
    { const f32x2 keep = b3 ? q[1] : q[0], send = b3 ? q[0] : q[1]; f32x2 rc; rc.x = __shfl_xor(send.x, 8); rc.y = __shfl_xor(send.y, 8); r1 = keep + rc; }
    const f32x2 hn = m.hv + r1;
    *(f32x2*)(h + (size_t)t * DM + sl * 128 + sub * 16 + g * 2) = hn;
    *(unsigned*)(xo + (size_t)t * DM + sl * 128 + sub * 16 + g * 2) = pk2(hn.x * g2.x, hn.y * g2.y);
    const float ss = wave_sum(hn.x * hn.x + hn.y * hn.y);
    if (lane == 0) ssq[(size_t)t * 8 + sl] = ss;
}
template <bool VSIDE>
DI void phase_peer(Frame& F, unsigned* ctr  , const bf16* xn, const int* E, const unsigned char* T8s, const float* hid, float* part, float* hbuf, const float* gnext, bf16* xo, float* ssq) {
    const unsigned xcc = xcc_id(); const int lane = F.lane;
    for (int so = 0; so < 8; ++so) {
        const int sl = (int)((xcc + (unsigned)so) & 7u);
        for (;;) {
            const unsigned item = wave_dequeue(ctr + 64 * sl, lane);
            if (item >= (unsigned)PEER_ITEMS) break;
            const int t0 = (int)item * PEER_ITEM_TOK;
            f32x2 g2 = {0.f, 0.f}; if (VSIDE) g2 = *(const f32x2*)(gnext + sl * 128 + (lane & 7) * 16 + (lane >> 3) * 2);
#define PEER_CL(x) ((x) < PEER_ITEM_TOK ? (x) : PEER_ITEM_TOK - 1)
            if (VSIDE) {
                PeerMetaV m0 = peer_meta_v(lane, t0, sl, E, hid, hbuf), m1 = peer_meta_v(lane, t0 + 1, sl, E, hid, hbuf);
                PeerRows ra, rb; peer_load_rows(lane, sl, m0.ea, m0.eb, T8s, ra);
                for (int tt = 0; tt < PEER_ITEM_TOK; tt += 2) {
                    const PeerMetaV m2 = peer_meta_v(lane, t0 + PEER_CL(tt + 2), sl, E, hid, hbuf);
                    peer_load_rows(lane, sl, m1.ea, m1.eb, T8s, rb); __builtin_amdgcn_sched_barrier(0);
                    peer_v_visit(lane, t0 + tt, sl, m0, ra, hbuf, g2, xo, ssq); __builtin_amdgcn_sched_barrier(0);
                    const PeerMetaV m3 = peer_meta_v(lane, t0 + PEER_CL(tt + 3), sl, E, hid, hbuf);
                    peer_load_rows(lane, sl, m2.ea, m2.eb, T8s, ra); __builtin_amdgcn_sched_barrier(0);
                    peer_v_visit(lane, t0 + tt + 1, sl, m1, rb, hbuf, g2, xo, ssq); __builtin_amdgcn_sched_barrier(0);
                    m0 = m2; m1 = m3;
                }
            } else {
                PeerMetaU m0 = peer_meta_u(lane, t0, sl, xn, E), m1 = peer_meta_u(lane, t0 + 1, sl, xn, E);
                PeerRows ra, rb; peer_load_rows(lane, sl, m0.ea, m0.eb, T8s, ra);
                for (int tt = 0; tt < PEER_ITEM_TOK; tt += 2) {
                    const PeerMetaU m2 = peer_meta_u(lane, t0 + PEER_CL(tt + 2), sl, xn, E);
                    peer_load_rows(lane, sl, m1.ea, m1.eb, T8s, rb); __builtin_amdgcn_sched_barrier(0);
                    peer_u_visit(lane, t0 + tt, sl, m0, ra, part); __builtin_amdgcn_sched_barrier(0);
                    const PeerMetaU m3 = peer_meta_u(lane, t0 + PEER_CL(tt + 3), sl, xn, E);
                    peer_load_rows(lane, sl, m2.ea, m2.eb, T8s, ra); __builtin_amdgcn_sched_barrier(0);
                    peer_u_visit(lane, t0 + tt + 1, sl, m1, rb, part); __builtin_amdgcn_sched_barrier(0);
                    m0 = m2; m1 = m3;
                }
            }
        }
    }
}
DI void phase_peer_hid(Frame& F, const int* E, const float* Gt, const float* part, const float* usc, const float* vsc, const float* ssq, float* hid) {
    const int lane = F.lane;
    for (int t = F.bid * NWAVES + F.wave; t < NT; t += F.G * NWAVES) {
        const float rs = pg8::rs_from16(ssq + (size_t)t * 16);
#pragma unroll
        for (int hf = 0; hf < 2; ++hf) { const size_t i = (size_t)t * 128 + hf * 64 + lane;
            float a = 0.f;
#pragma unroll
            for (int sl = 0; sl < 8; ++sl) a += part[(size_t)sl * NT * 128 + i];
            const int e = E[i]; a *= usc[e] * rs;
            hid[i] = Gt[i] * (0.5f * a * (1.f + erff(a * 0.70710678118654752f))) * vsc[e]; }
    }
}

#define LAS __attribute__((address_space(3)))
#define XB_TMO      128
#define XB_XCNT(j)  (256  + 64 * (j))
#define XB_XSUB(j)  (1280 + 64 * (j))
#define XB_XGEN(j)  (2304 + 64 * (j))
#define XB_TOP      3328
#define XB_TOPGEN   3392
#define XCD_BAR_WORDS 3456
#define XB_SPIN_CAP (1u << 18)

__device__ __forceinline__ unsigned xb_ld(unsigned* p)              { return __hip_atomic_load(p, __ATOMIC_RELAXED, __HIP_MEMORY_SCOPE_AGENT); }
__device__ __forceinline__ unsigned xb_add(unsigned* p, unsigned v) { return __hip_atomic_fetch_add(p, v, __ATOMIC_RELAXED, __HIP_MEMORY_SCOPE_AGENT); }
__device__ __forceinline__ unsigned xb_xcc_id() { return (unsigned)__builtin_amdgcn_s_getreg((3 << 11) | 20) & 0xFu; }
#define XB_SPIN(cond, bar) do { unsigned _sp = 0; while (cond) { __builtin_amdgcn_s_sleep(1); \
    if ((++_sp & 255u) == 0u) { if (xb_ld(&(bar)[XB_TMO])) break; if (_sp > XB_SPIN_CAP) { atomicAdd(&(bar)[XB_TMO], 1u); break; } } } } while (0)

struct XcdBarrier {
    unsigned* bar; unsigned x;
    volatile LAS unsigned* st;
};

__device__ __forceinline__ XcdBarrier xcd_barrier_post(unsigned* bar, volatile LAS unsigned* st) {
    XcdBarrier b; b.bar = bar; b.x = xb_xcc_id(); b.st = st;
    if (threadIdx.x == 0) (void)xb_add(&bar[XB_XCNT(b.x)], 1u);
    return b;
}
__device__ __forceinline__ void xcd_barrier_complete(unsigned* bar, unsigned x, unsigned& nloc, unsigned& nx) {
    const unsigned G = gridDim.x * gridDim.y * gridDim.z;
    unsigned sum, cnt, mine, sp = 0u;
    for (;;) {
        sum = 0u; cnt = 0u; mine = 0u;
#pragma unroll
        for (unsigned j = 0; j < 16; ++j) { const unsigned c = xb_ld(&bar[XB_XCNT(j)]); sum += c; cnt += (c > 0u) ? 1u : 0u; mine = (j == x) ? c : mine; }
        if (sum == G) break;
        __builtin_amdgcn_s_sleep(1);
        if ((++sp & 255u) == 0u) { if (xb_ld(&bar[XB_TMO])) break; if (sp > XB_SPIN_CAP) { atomicAdd(&bar[XB_TMO], 1u); break; } }
    }
    nloc = mine > 0u ? mine : 1u; nx = cnt > 0u ? cnt : 1u;
}

__device__ __forceinline__ void xcd_barrier(const XcdBarrier& b) {
    asm volatile("s_waitcnt vmcnt(0)" ::: "memory");
    __syncthreads();
    if (threadIdx.x == 0) {
        unsigned* bar = b.bar;
        __builtin_amdgcn_s_waitcnt(0);
        unsigned nloc = b.st[0], nx = b.st[1];
        if (nloc == 0u) { xcd_barrier_complete(bar, b.x, nloc, nx); b.st[0] = nloc; b.st[1] = nx; }
        const unsigned old = xb_add(&bar[XB_XSUB(b.x)], 1u);
        const unsigned gen = old / nloc;
        if (old + 1u == (gen + 1u) * nloc) {
            __builtin_amdgcn_fence(__ATOMIC_RELEASE, "agent");
            asm volatile("s_waitcnt vmcnt(0)" ::: "memory");
            const unsigned og = xb_add(&bar[XB_TOP], 1u);
            const unsigned tg = og / nx;
            if (og + 1u == (tg + 1u) * nx) xb_add(&bar[XB_TOPGEN], 1u);
            else XB_SPIN(xb_ld(&bar[XB_TOPGEN]) == tg, bar);
            __builtin_amdgcn_fence(__ATOMIC_ACQUIRE, "agent");
            xb_add(&bar[XB_XGEN(b.x)], 1u);
            asm volatile("s_waitcnt vmcnt(0)" ::: "memory");
        } else {
            XB_SPIN(xb_ld(&bar[XB_XGEN(b.x)]) == gen, bar);
            __builtin_amdgcn_fence(__ATOMIC_ACQUIRE, "agent");
            asm volatile("s_waitcnt vmcnt(0)" ::: "memory");
        }
    }
    __syncthreads();
}

#ifndef PHMASK
#define PHMASK 0xFFFF
#endif
#define EN(n) if constexpr (((PHMASK) >> (n)) & 1)
#ifndef PROBE_DUP
#define PROBE_DUP -1
#endif
constexpr int NPH = 25;

__global__ void __launch_bounds__(NTHR, 2) hybrid_fwd(Args args) {
    extern __shared__ __attribute__((aligned(16))) unsigned char lds[];
    unsigned char* ws = args.ws;
    bf16* proj = (bf16*)(ws + WS_A); float* sc = (float*)(ws + WS_A);
    bf16* xn = (bf16*)(ws + WS_XN);
    bf16* ocat = (bf16*)(ws + WS_C); int* eids = (int*)(ws + WS_C); float* gates = (float*)(ws + WS_C + 16 * MiB); float* hid = (float*)(ws + WS_C + 32 * MiB); unsigned* ctl = (unsigned*)ws;
    float* kvt = (float*)(ws + WS_D); unsigned char* u8 = ws + WS_D; unsigned char* v8 = ws + WS_D + 16 * MiB; float* usc = (float*)(ws + WS_D + 32 * MiB); float* vsc = (float*)(ws + WS_D + 33 * MiB);
    bf16* pb = (bf16*)(ws + WS_PB); float* dec = (float*)(ws + WS_DEC);
    cg::grid_group grid = cg::this_grid();
    volatile LAS unsigned* misc = (volatile LAS unsigned*)((LAS unsigned char*)lds + (LDS_BYTES - 64));
    if (threadIdx.x < 16) misc[threadIdx.x] = 0u;
    __syncthreads();
    XcdBarrier xbar; xbar.bar = (unsigned*)args.ws + CTL_BAR; xbar.x = xb_xcc_id(); xbar.st = misc;
    PG8_LAS unsigned char* gl = (PG8_LAS unsigned char*)lds;

    float* ssqA = (float*)(ws + WS_ST); float* ssqB = (float*)(ws + WS_ST + 2 * MiB); float* ssqC = (float*)(ws + WS_ST + 3 * MiB);
    bf16* prevb = (bf16*)(ws + WS_XN);
    bf16* xnC = (bf16*)(ws + WS_C);
    bf16* pw = (bf16*)(ws + WS_A + 128 * MiB);
#ifndef PROBE_TMASK
#define PROBE_TMASK 0u
#endif
    unsigned long long pt_acc = 0ull;
    for (int ph = args.ph_lo, rep = 0; ph < args.ph_hi;) {
        const unsigned long long pt_t0 = (PROBE_TMASK != 0u) ? __builtin_amdgcn_s_memrealtime() : 0ull; const int pt_ph = ph;
        int tid_ = threadIdx.x; asm volatile("" : "+v"(tid_));
        Frame F;
        F.lds = lds; F.tid = tid_; F.lane = F.tid & 63; F.wave = __builtin_amdgcn_readfirstlane(F.tid >> 6); F.G = gridDim.x; F.bid = blockIdx.x;
        F.x = args.in[0]; F.p = args.in[1]; F.norm_mix = args.in[2]; F.w_in = args.in[3]; F.g_w2 = args.in[4]; F.g_b = args.in[5]; F.head_norm = args.in[6]; F.rel_bias = args.in[7]; F.w_out = args.in[8];
        F.norm_ffn = args.in[9]; F.peer_wq = args.in[10]; F.peer_sk = args.in[11]; F.peer_u = args.in[12]; F.peer_v = args.in[13]; F.norm_ple = args.in[14]; F.w_ple_gate = args.in[15]; F.w_ple = args.in[16]; F.final_norm = args.in[17];
        F.out = args.out; F.ws = args.ws;
        int l = 0, sp = -1;
        if (ph >= 1 && ph <= 12) { l = 0; sp = ph - 1; } else if (ph >= 13 && ph < NPH - 1) { l = 1; sp = ph - 12; }
        if (ph == 0) { EN(14) { if (F.bid == 0) { for (int i = F.tid; i < CTL_ZERO_BYTES / 4; i += NTHR) ctl[i] = 0u; } phase_prep(F); } }
        else if (ph == NPH - 1) { EN(15) phase_final_norm(F, F.final_norm, ssqC); }
        else {
            const pg8::bf16_t* wl = (const pg8::bf16_t*)(ws + WS_W + (size_t)l * W_LAYER);
            const float* hsrc = (l == 0) ? F.x : F.out;
            switch (sp) {
            case 0: EN(0) {
                phase_init_rows(F, F.x, F.norm_mix, xn, ssqC);
            } break;
            case 1: EN(1) {
                pg8::Gemm g{(const pg8::bf16_t*)(l == 0 ? xn : xnC), wl + WO_WIN / 2, NT, PW, DM}; pg8::StaticOrder S; S.init(NT, PW, F.G, F.bid);
                pg8::EpiBf16RS E{(pg8::bf16_t*)proj, PW, ssqC};
                pg8::gemm_phase<pg8::EpiBf16RS, pg8::StaticOrder, true, true>(gl, g, S, E, F.tid);
            } break;
            case 2: EN(2) {
                for (int rr = 0; rr < (PROBE_DUP == 20 ? 2 : 1); ++rr) phase_att(F, l, proj, ocat);
                for (int rr = 0; rr < (PROBE_DUP == 21 ? 2 : 1); ++rr) phase_gla_kv(F, l, proj, kvt, dec);
            } break;
            case 3: EN(3) { phase_scan(F, kvt, dec, rep ? (bf16*)(ws + WS_A + 208 * MiB) : prevb); convert_bf16(F, F.p + (size_t)l * NT * 256, pb, (size_t)NT * 256); } break;
            case 4: EN(4) { phase_gla_out(F, l, proj, prevb, ocat); } break;
            case 5: EN(5) {
                pg8::Gemm g{(const pg8::bf16_t*)ocat, wl + WO_WOUT / 2, NT, DM, DM}; pg8::StaticOrder S; S.init(NT, DM, F.G, F.bid);
                pg8::EpiResidN E{hsrc, rep ? (float*)(ws + WS_A) : F.out, DM, F.norm_ffn + (size_t)l * DM, rep ? (pg8::bf16_t*)(ws + WS_A + 128 * MiB) : (pg8::bf16_t*)xn, rep ? ssqC : ssqA};
                pg8::gemm_phase<pg8::EpiResidN, pg8::StaticOrder, true, true>(gl, g, S, E, F.tid);
                convert_rows_fp8(F, F.peer_u + (size_t)l * NEXP * DM, u8, usc, true);
                convert_rows_fp8(F, F.peer_v + (size_t)l * NEXP * DM, v8, vsc, true);
            } break;
            case 6: EN(6) {
                pg8::Gemm g{(const pg8::bf16_t*)xn, wl + WO_WQ2 / 2, NT, 2048, DM}; pg8::StaticOrder S; S.init(NT, 2048, F.G, F.bid);
                pg8::EpiF32RS E{sc, 2048, ssqA};
                pg8::gemm_phase<pg8::EpiF32RS, pg8::StaticOrder, true, true>(gl, g, S, E, F.tid);
            } break;
            case 7: EN(7) { phase_topk(F, sc, eids, gates); } break;
            case 8: EN(8) { phase_peer<false>(F, ctl + 64 * (16 * l + 32 * rep), xn, eids, u8, hid, (float*)(ws + WS_A), nullptr, nullptr, nullptr, nullptr); } break;
            case 9: EN(9) {
                phase_peer_hid(F, eids, gates, (const float*)(ws + WS_A), usc, vsc, ssqA, hid);
                int kp = 256; asm volatile("" : "+s"(kp));
                pg8::Gemm g{(const pg8::bf16_t*)pb, wl + WO_WP / 2, NT, DM, kp}; pg8::StaticOrder S; S.init(NT, DM, F.G, F.bid);
                pg8::EpiBf16P E{(pg8::bf16_t*)pw, DM};
                pg8::gemm_phase<pg8::EpiBf16P, pg8::StaticOrder, true, true>(gl, g, S, E, F.tid);
            } break;
            case 10: EN(10) { phase_peer<true>(F, ctl + 64 * (16 * l + 8 + 32 * rep), xn, eids, v8, hid, nullptr, rep ? (float*)(ws + WS_A) : F.out, F.norm_ple + (size_t)l * DM, rep ? (bf16*)(ws + WS_A + 192 * MiB) : xn, rep ? ssqA : ssqB); } break;
            case 11: EN(11) {
                pg8::Gemm g{(const pg8::bf16_t*)xn, wl + WO_WG / 2, NT, DM, DM}; pg8::StaticOrder S; S.init(NT, DM, F.G, F.bid);
                pg8::EpiPleN E{F.out, rep ? (float*)(ws + WS_A) : F.out, (const pg8::bf16_t*)pw, DM, ssqB, F.norm_mix + (size_t)(l + 1 < DEPTH ? l + 1 : l) * DM, l + 1 < DEPTH ? (rep ? (pg8::bf16_t*)(ws + WS_A + 192 * MiB) : (pg8::bf16_t*)xnC) : nullptr, rep ? ssqA : ssqC};
                pg8::gemm_phase<pg8::EpiPleN, pg8::StaticOrder, true, true>(gl, g, S, E, F.tid);
            } break;
            }
        }
        bool adv = true;
        if (PROBE_DUP >= 0 && (sp == PROBE_DUP || (PROBE_DUP == 100 && ph == 0) || (PROBE_DUP == 101 && ph == NPH - 1)) && rep == 0) { rep = 1; adv = false; }
        if (adv) { rep = 0; ++ph; }
        if (ph < args.ph_hi) { if (USE_XCD_BARRIER && ph > 1) { xcd_barrier(xbar); if (PROBE_DUP == 200) xcd_barrier(xbar); } else { grid.sync(); if (threadIdx.x == 0) (void)xb_add(&xbar.bar[XB_XCNT(xbar.x)], 1u); } }
        if (PROBE_TMASK != 0u && ((PROBE_TMASK >> pt_ph) & 1u)) pt_acc += __builtin_amdgcn_s_memrealtime() - pt_t0;
    }
    if (PROBE_TMASK != 0u && blockIdx.x == 0 && threadIdx.x == 0) { const unsigned long long t0 = __builtin_amdgcn_s_memrealtime(); while (__builtin_amdgcn_s_memrealtime() - t0 < pt_acc) __builtin_amdgcn_s_sleep(8); }
}

extern "C" void kernel_launch(void* const* d_in, const int* in_sizes, int n_in, void* d_out, int out_size, void* d_ws, size_t ws_size, hipStream_t stream) {
    static int grid = 0;
    if (grid == 0) {
        if (n_in != 18 || in_sizes[0] != NT * DM || out_size != NT * DM || ws_size < WS_END) { fprintf(stderr, "kernel_launch: unexpected shapes (n_in %d, in0 %d, out %d, ws %zu); nothing launched\n", n_in, n_in > 0 ? in_sizes[0] : -1, out_size, ws_size); grid = -1; return; }
        int dev = 0, cus = 0, per_cu = 0;
        if (hipGetDevice(&dev) != hipSuccess || hipDeviceGetAttribute(&cus, hipDeviceAttributeMultiprocessorCount, dev) != hipSuccess) { fprintf(stderr, "kernel_launch: device query failed\n"); grid = -1; return; }
        if (hipFuncSetAttribute((const void*)hybrid_fwd, hipFuncAttributeMaxDynamicSharedMemorySize, LDS_BYTES) != hipSuccess) { fprintf(stderr, "kernel_launch: hipFuncSetAttribute failed\n"); grid = -1; return; }
        if (hipOccupancyMaxActiveBlocksPerMultiprocessor(&per_cu, (const void*)hybrid_fwd, NTHR, LDS_BYTES) != hipSuccess || per_cu < 1) { fprintf(stderr, "kernel_launch: occupancy query says %d blocks per CU\n", per_cu); (void)hipGetLastError(); grid = -1; return; }
        if (cus != 256) { fprintf(stderr, "kernel_launch: built for a 256-CU device (the attention / GLA unit maps assume a 256-workgroup grid); found %d CUs; nothing launched\n", cus); grid = -1; return; }
        grid = cus * 1;
    }
    if (grid < 0) return;
    Args a{};
    for (int i = 0; i < 18; ++i) a.in[i] = (const float*)d_in[i];
    a.out = (float*)d_out; a.ws = (unsigned char*)d_ws;
#if MK_N_LAUNCHES == 1
    a.ph_lo = 0; a.ph_hi = NPH;
    void* kargs[] = {&a};
    hipError_t e = hipLaunchCooperativeKernel((const void*)hybrid_fwd, dim3(grid), dim3(NTHR), kargs, LDS_BYTES, stream);
    if (e != hipSuccess) fprintf(stderr, "kernel_launch: cooperative launch failed: %s (grid %d)\n", hipGetErrorString(e), grid);
#else
    for (int ph = 0; ph < NPH; ++ph) { a.ph_lo = ph; a.ph_hi = ph + 1; hipLaunchKernelGGL(hybrid_fwd, dim3(grid), dim3(NTHR), LDS_BYTES, stream, a); }
#endif
}
```
